# Optimizing an MI355X kernel written in HIP

```python
import math
import jax, jax.numpy as jnp
from jax import lax
import numpy as np

D_MODEL = 2048
BATCH = 4
SEQ = 2048
DEPTH = 1
DEC_BATCH = 8
DEC_SEQ = 8
PAST_LEN = 16384
PAGE_SIZE = 128

SB_HEADS = 8
SB_HEAD_DIM = 128
SB_WIDTH = SB_HEADS * SB_HEAD_DIM
SB_BIAS_HI = -1.0
SB_BIAS_LO = -10.0
SSD_HEADS = 8
SSD_HEAD_DIM = 64
SSD_WIDTH = SSD_HEADS * SSD_HEAD_DIM
SSD_GROUPS = 2
SSD_STATE = 128
CONV_WIDTH = 4
SSD_CHUNK = 128
XBC_WIDTH = SSD_WIDTH + 2 * SSD_GROUPS * SSD_STATE
MEM_TOKENS = 256
MEM_HEADS = 4
MEM_HEAD_DIM = 128
MEM_WIDTH = MEM_HEADS * MEM_HEAD_DIM
MIX_WIDTH = SB_WIDTH + SSD_WIDTH + MEM_WIDTH
Q_BLOCK = 128
EPS = 1e-6
IN_WIDTHS = (SB_WIDTH, SB_WIDTH, SB_WIDTH, SB_WIDTH, SSD_WIDTH, XBC_WIDTH, SSD_HEADS, MEM_WIDTH, MEM_WIDTH)
IN_WIDTH = 4 * SB_WIDTH + SSD_WIDTH + XBC_WIDTH + SSD_HEADS + 2 * MEM_WIDTH

kernel_name = "hymba_stickbreak_ssd_memory_step"


def rmsnorm(x, w):
    x32 = x.astype(jnp.float32)
    y = x32 * lax.rsqrt(jnp.mean(x32 * x32, axis=-1, keepdims=True) + EPS)
    return (y * w.astype(jnp.float32)).astype(x.dtype)


def split_projection(proj):
    offsets, acc = [], 0
    for w in IN_WIDTHS[:-1]:
        acc += w
        offsets.append(acc)
    return jnp.split(proj, offsets, axis=-1)


def memory_kv(mem, mem_norm_w, w_mem_kv, mem_k_norm):
    b, m, _ = mem.shape
    k, v = jnp.split(rmsnorm(mem, mem_norm_w) @ w_mem_kv, 2, axis=-1)
    k = rmsnorm(k.reshape(b, m, MEM_HEADS, MEM_HEAD_DIM), mem_k_norm)
    return k, v.reshape(b, m, MEM_HEADS, MEM_HEAD_DIM)


def stick_breaking_attend(q, k, v, sb_bias, q_pos, k_pos):
    z = jnp.einsum('bqhd,bkhd->bhqk', q, k).astype(jnp.float32) * (SB_HEAD_DIM ** -0.5)
    z = z + sb_bias.astype(jnp.float32)[None, :, None, None]
    mask = (k_pos[None, :] < q_pos[:, None])[None, None]
    log_fail = jnp.where(mask, jax.nn.log_sigmoid(-z), 0.0)
    log_between = lax.cumsum(log_fail, axis=3, reverse=True) - log_fail
    w = jnp.where(mask, jnp.exp(jax.nn.log_sigmoid(z) + log_between), 0.0)
    return jnp.einsum('bhqk,bkhd->bqhd', w.astype(v.dtype), v)


def stick_breaking_prompt(q, k, v, sb_bias):
    b, s, h, d = q.shape
    nb = s // Q_BLOCK
    q_blocks = jnp.moveaxis(q.reshape(b, nb, Q_BLOCK, h, d), 1, 0)
    pos = jnp.arange(s, dtype=jnp.int32)
    out = lax.map(lambda blk: stick_breaking_attend(blk[0], k, v, sb_bias, blk[1], pos),
                  (q_blocks, pos.reshape(nb, Q_BLOCK)))
    return jnp.moveaxis(out, 0, 1).reshape(b, s, h, d)


def causal_conv(xbc, prefix, conv_w, conv_b):
    length = xbc.shape[1]
    xp = jnp.concatenate([prefix.astype(xbc.dtype), xbc], axis=1)
    out = conv_b + sum(xp[:, j:j + length] * conv_w[j] for j in range(CONV_WIDTH))
    return jax.nn.silu(out), xp[:, -(CONV_WIDTH - 1):]


def ssd_scan(x, dt, a, b_in, c_in, h0, d_skip):
    f32 = jnp.float32
    bsz, length = x.shape[:2]
    chunk = min(SSD_CHUNK, length)
    n_chunks = -(-length // chunk)
    pad = n_chunks * chunk - length
    r = SSD_HEADS // SSD_GROUPS

    def prep(arr):
        arr = arr.astype(f32)
        if pad:
            arr = jnp.pad(arr, [(0, 0), (0, pad)] + [(0, 0)] * (arr.ndim - 2))
        return arr.reshape((bsz, n_chunks, chunk) + arr.shape[2:])

    xc = prep(x).reshape(bsz, n_chunks, chunk, SSD_GROUPS, r, SSD_HEAD_DIM)
    dtc = prep(dt).reshape(bsz, n_chunks, chunk, SSD_GROUPS, r)
    bc, cc = prep(b_in), prep(c_in)
    cs = jnp.cumsum(dtc * a.reshape(SSD_GROUPS, r), axis=2)
    xdt = xc * dtc[..., None]
    causal = jnp.tril(jnp.ones((chunk, chunk), bool))[:, :, None, None]
    seg = cs[:, :, :, None] - cs[:, :, None, :]
    decay = jnp.exp(jnp.where(causal, seg, -jnp.inf))
    cb = jnp.einsum('bclgn,bcsgn->bclsg', cc, bc)
    y_diag = jnp.einsum('bclsg,bclsgr,bcsgrp->bclgrp', cb, decay, xdt)
    to_end = jnp.exp(cs[:, :, -1:] - cs)
    states = jnp.einsum('bclgn,bclgr,bclgrp->bcgrpn', bc, to_end, xdt)
    chunk_decay = jnp.exp(cs[:, :, -1])

    def step(h, inp):
        st, dec = inp
        return h * dec[..., None, None] + st, h

    h_init = h0.astype(f32).reshape(bsz, SSD_GROUPS, r, SSD_HEAD_DIM, SSD_STATE)
    h_final, h_prev = lax.scan(step, h_init, (jnp.moveaxis(states, 1, 0), jnp.moveaxis(chunk_decay, 1, 0)))
    h_prev = jnp.moveaxis(h_prev, 0, 1)
    y_off = jnp.einsum('bclgn,bcgrpn,bclgr->bclgrp', cc, h_prev, jnp.exp(cs))
    y = y_diag + y_off + xc * d_skip.astype(f32).reshape(SSD_GROUPS, r)[:, :, None]
    y = y.reshape(bsz, n_chunks * chunk, SSD_HEADS, SSD_HEAD_DIM)[:, :length]
    return y, h_final.reshape(bsz, SSD_HEADS, SSD_HEAD_DIM, SSD_STATE)


def mixer_layer(x, past_k, past_v, conv_prefix, ssm_init, mem_k, mem_v, norm_w, w_in,
                sb_q_norm, sb_k_norm, sb_bias, conv_w, conv_b, dt_bias, a_log, d_skip, ssd_norm_w,
                mem_q_norm, w_out):
    b, t, _ = x.shape
    q, k, v, g_sb, z, xbc, dt_raw, q_mem, g_mem = split_projection(rmsnorm(x, norm_w) @ w_in)
    q = rmsnorm(q.reshape(b, t, SB_HEADS, SB_HEAD_DIM), sb_q_norm)
    k = rmsnorm(k.reshape(b, t, SB_HEADS, SB_HEAD_DIM), sb_k_norm)
    v = v.reshape(b, t, SB_HEADS, SB_HEAD_DIM)
    if past_k is None:
        sb = stick_breaking_prompt(q, k, v, sb_bias)
    else:
        past = past_k.shape[1]
        k_all = jnp.concatenate([past_k.astype(k.dtype), k], axis=1)
        v_all = jnp.concatenate([past_v.astype(v.dtype), v], axis=1)
        sb = stick_breaking_attend(q, k_all, v_all, sb_bias, past + jnp.arange(t, dtype=jnp.int32),
                                   jnp.arange(past + t, dtype=jnp.int32))
    sb = sb.reshape(b, t, SB_WIDTH) * jax.nn.silu(g_sb)
    xbc_act, conv_new = causal_conv(xbc, conv_prefix, conv_w, conv_b)
    xs, bm, cm = jnp.split(xbc_act, [SSD_WIDTH, SSD_WIDTH + SSD_GROUPS * SSD_STATE], axis=-1)
    dt = jax.nn.softplus(dt_raw.astype(jnp.float32) + dt_bias.astype(jnp.float32))
    a = -jnp.exp(a_log.astype(jnp.float32))
    y, ssm_new = ssd_scan(xs.reshape(b, t, SSD_HEADS, SSD_HEAD_DIM), dt, a,
                          bm.reshape(b, t, SSD_GROUPS, SSD_STATE), cm.reshape(b, t, SSD_GROUPS, SSD_STATE),
                          ssm_init, d_skip)
    ssd = rmsnorm(y.reshape(b, t, SSD_WIDTH) * jax.nn.silu(z.astype(jnp.float32)), ssd_norm_w).astype(x.dtype)
    qm = rmsnorm(q_mem.reshape(b, t, MEM_HEADS, MEM_HEAD_DIM), mem_q_norm)
    s = jnp.einsum('bqhd,bmhd->bhqm', qm, mem_k).astype(jnp.float32) * (MEM_HEAD_DIM ** -0.5)
    p = jax.nn.softmax(s, axis=-1)
    mo = jnp.einsum('bhqm,bmhd->bqhd', p.astype(mem_v.dtype), mem_v).reshape(b, t, MEM_WIDTH) * jax.nn.silu(g_mem)
    mix = jnp.concatenate([sb, ssd, mo.astype(x.dtype)], axis=-1)
    return x + mix @ w_out, k, v, conv_new, ssm_new


def setup_inputs(seed: int = 0) -> dict:
    key = jax.random.key(seed)
    ks = jax.random.split(key, 32)
    f32 = jnp.float32
    n_pages = PAST_LEN // PAGE_SIZE
    n_pool = (5 * DEC_BATCH * n_pages + 3) // 4

    def nrm(k, shape, scale=1.0):
        return scale * jax.random.normal(k, shape, f32)

    def gain(k, shape):
        return 1.0 + 0.02 * jax.random.normal(k, shape, f32)

    dt0 = jnp.exp(jax.random.uniform(ks[20], (DEPTH, SSD_HEADS), f32, math.log(1e-3), math.log(1e-1)))
    page_table = jax.random.permutation(ks[9], n_pool)[:DEC_BATCH * n_pages]
    sb_bias = jnp.linspace(SB_BIAS_HI, SB_BIAS_LO, SB_HEADS, dtype=f32)[None] + nrm(ks[25], (DEPTH, SB_HEADS), 0.1)
    return {
        'x_prompt': nrm(ks[0], (BATCH, SEQ, D_MODEL)),
        'x_sample': nrm(ks[1], (DEC_BATCH, DEC_SEQ, D_MODEL)),
        'cache_sb_k': nrm(ks[2], (DEPTH, n_pool, PAGE_SIZE, SB_HEADS, SB_HEAD_DIM)),
        'cache_sb_v': nrm(ks[3], (DEPTH, n_pool, PAGE_SIZE, SB_HEADS, SB_HEAD_DIM)),
        'state_ssm': nrm(ks[4], (DEPTH, DEC_BATCH, SSD_HEADS, SSD_HEAD_DIM, SSD_STATE), 0.1),
        'state_conv': nrm(ks[5], (DEPTH, DEC_BATCH, CONV_WIDTH - 1, XBC_WIDTH)),
        'cache_mem_k': nrm(ks[6], (DEPTH, DEC_BATCH, MEM_TOKENS, MEM_HEADS, MEM_HEAD_DIM)),
        'cache_mem_v': nrm(ks[7], (DEPTH, DEC_BATCH, MEM_TOKENS, MEM_HEADS, MEM_HEAD_DIM)),
        'page_table': page_table.reshape(DEC_BATCH, n_pages).astype(jnp.int32),
        'mem_prompt': nrm(ks[8], (BATCH, MEM_TOKENS, D_MODEL)),
        'norm_w': gain(ks[10], (DEPTH, D_MODEL)),
        'w_in': nrm(ks[11], (DEPTH, D_MODEL, IN_WIDTH), D_MODEL ** -0.5),
        'sb_q_norm': gain(ks[12], (DEPTH, SB_HEAD_DIM)),
        'sb_k_norm': gain(ks[13], (DEPTH, SB_HEAD_DIM)),
        'sb_bias': sb_bias,
        'conv_w': nrm(ks[14], (DEPTH, CONV_WIDTH, XBC_WIDTH), CONV_WIDTH ** -0.5),
        'conv_b': nrm(ks[15], (DEPTH, XBC_WIDTH), 0.01),
        'dt_bias': dt0 + jnp.log(-jnp.expm1(-dt0)),
        'a_log': jnp.log(jax.random.uniform(ks[16], (DEPTH, SSD_HEADS), f32, 1.0, 16.0)),
        'd_skip': 1.0 + 0.1 * jax.random.normal(ks[17], (DEPTH, SSD_HEADS), f32),
        'ssd_norm_w': gain(ks[18], (DEPTH, SSD_WIDTH)),
        'mem_norm_w': gain(ks[19], (DEPTH, D_MODEL)),
        'w_mem_kv': nrm(ks[21], (DEPTH, D_MODEL, 2 * MEM_WIDTH), D_MODEL ** -0.5),
        'mem_q_norm': gain(ks[22], (DEPTH, MEM_HEAD_DIM)),
        'mem_k_norm': gain(ks[23], (DEPTH, MEM_HEAD_DIM)),
        'w_out': nrm(ks[24], (DEPTH, MIX_WIDTH, D_MODEL), MIX_WIDTH ** -0.5),
    }


def reference(x_prompt, x_sample, cache_sb_k, cache_sb_v, state_ssm, state_conv, cache_mem_k,
              cache_mem_v, page_table, mem_prompt, norm_w, w_in, sb_q_norm, sb_k_norm, sb_bias,
              conv_w, conv_b, dt_bias, a_log, d_skip, ssd_norm_w, mem_norm_w, w_mem_kv, mem_q_norm,
              mem_k_norm, w_out):
    n_seq = page_table.shape[0]
    yp, ys = x_prompt, x_sample
    pk, pv, pssm, pconv, pmk, pmv = [], [], [], [], [], []
    sk, sv, sssm, sconv = [], [], [], []
    for layer in range(DEPTH):
        mk, mv = memory_kv(mem_prompt, mem_norm_w[layer], w_mem_kv[layer], mem_k_norm[layer])
        zero_conv = jnp.zeros((yp.shape[0], CONV_WIDTH - 1, XBC_WIDTH), yp.dtype)
        zero_ssm = jnp.zeros((yp.shape[0], SSD_HEADS, SSD_HEAD_DIM, SSD_STATE), jnp.float32)
        yp, k_new, v_new, conv_new, ssm_new = mixer_layer(
            yp, None, None, zero_conv, zero_ssm, mk, mv, norm_w[layer], w_in[layer],
            sb_q_norm[layer], sb_k_norm[layer], sb_bias[layer], conv_w[layer], conv_b[layer],
            dt_bias[layer], a_log[layer], d_skip[layer], ssd_norm_w[layer], mem_q_norm[layer],
            w_out[layer])
        pk.append(k_new); pv.append(v_new); pssm.append(ssm_new); pconv.append(conv_new)
        pmk.append(mk); pmv.append(mv)
        past_k = cache_sb_k[layer][page_table].reshape(n_seq, -1, SB_HEADS, SB_HEAD_DIM)
        past_v = cache_sb_v[layer][page_table].reshape(n_seq, -1, SB_HEADS, SB_HEAD_DIM)
        ys, k_new, v_new, conv_new, ssm_new = mixer_layer(
            ys, past_k, past_v, state_conv[layer], state_ssm[layer], cache_mem_k[layer],
            cache_mem_v[layer], norm_w[layer], w_in[layer], sb_q_norm[layer], sb_k_norm[layer],
            sb_bias[layer], conv_w[layer], conv_b[layer], dt_bias[layer], a_log[layer],
            d_skip[layer], ssd_norm_w[layer], mem_q_norm[layer], w_out[layer])
        sk.append(k_new); sv.append(v_new); sssm.append(ssm_new); sconv.append(conv_new)
    return (yp, ys, jnp.stack(pk), jnp.stack(pv), jnp.stack(pssm), jnp.stack(pconv),
            jnp.stack(pmk), jnp.stack(pmv), jnp.stack(sk), jnp.stack(sv), jnp.stack(sssm),
            jnp.stack(sconv))
```

```cpp
#include <hip/hip_runtime.h>
#include <cstdio>
#include <cstdint>

#ifndef MK_N_LAUNCHES
#define MK_N_LAUNCHES 6
#endif

constexpr int DM = 2048, NBATCH = 4, SEQ = 2048, MP = NBATCH * SEQ;
constexpr int DSEQ = 8, DTOK = 8, MS = DSEQ * DTOK;
constexpr int MVALID = MP + MS, MROWS = 8448;
constexpr int NIN = 6664, NPAD = 6912;
constexpr int MEMT = 256, MMEM = NBATCH * MEMT;
constexpr int NPAGES = 128, PAGE = 128, PAST = NPAGES * PAGE;
constexpr float EPS = 1e-6f;
constexpr float LOG2E = 1.4426950408889634f;
constexpr float QSCALE = 0.08838834764831845f * LOG2E;

constexpr size_t O_YP = 0, O_YS = 16777216, O_PK = 16908288, O_PV = 25296896, O_PSSM = 33685504, O_PCONV = 33947648,
                 O_PMK = 33959936, O_PMV = 34484224, O_SK = 35008512, O_SV = 35074048, O_SSSM = 35139584, O_SCONV = 35663872;

constexpr size_t MiB = 1u << 20;
constexpr size_t WS_CTL = 0, CTL_BYTES = 1 * MiB;
constexpr size_t WS_WIN = 2 * MiB;
constexpr size_t WS_WM = 32 * MiB;
constexpr size_t WS_WOUT = 38 * MiB;
constexpr size_t WS_H = 48 * MiB;
constexpr size_t WS_HM = 84 * MiB;
constexpr size_t WS_PROJ = 90 * MiB;
constexpr int PC_Q = 0, PC_K = 1024, PC_V = 2048, PC_GSB = 3072, PC_Z = 4096, PC_XBC = 4608, PC_MQ = 5632, PC_GM = 6144;
constexpr size_t WS_DT = 210 * MiB;
constexpr size_t WS_MKN = 211 * MiB;
constexpr size_t WS_MVB = 213 * MiB;
constexpr size_t WS_CMK = 215 * MiB;
constexpr size_t WS_CMV = 218 * MiB;
constexpr size_t WS_SSQ = 221 * MiB;
constexpr size_t WS_FPART = 222 * MiB;
constexpr size_t WS_MIX = 224 * MiB;
constexpr size_t WS_YZ = 260 * MiB;
constexpr size_t WS_OPART = 280 * MiB;
constexpr size_t WS_END = 316 * MiB;

constexpr int CW_BAR = 4096;
constexpr int CW_QUEUE = 64;

constexpr int LDS_BYTES = 163840;
constexpr int RING_BYTES = 131072;
constexpr int LDS_CTLW = LDS_BYTES - 256;

#define LAS __attribute__((address_space(3)))
typedef unsigned short bf16_t;
typedef short bf16x8 __attribute__((ext_vector_type(8)));
typedef short s16x4 __attribute__((ext_vector_type(4)));
typedef float f32x2 __attribute__((ext_vector_type(2)));
typedef float f32x4 __attribute__((ext_vector_type(4)));
typedef float f32x16 __attribute__((ext_vector_type(16)));
typedef unsigned u32x2 __attribute__((ext_vector_type(2)));
typedef unsigned u32x4 __attribute__((ext_vector_type(4)));

__device__ __forceinline__ unsigned cvtpk(float lo, float hi) { unsigned r; asm volatile("v_cvt_pk_bf16_f32 %0, %1, %2" : "=v"(r) : "v"(lo), "v"(hi)); return r; }
__device__ __forceinline__ float bf_lo(unsigned w) { return __uint_as_float(w << 16); }
__device__ __forceinline__ float bf_hi(unsigned w) { return __uint_as_float(w & 0xffff0000u); }
__device__ __forceinline__ float bf2f(bf16_t b) { return __uint_as_float(((unsigned)b) << 16); }
__device__ __forceinline__ bf16_t f2bf(float f) { return (bf16_t)(cvtpk(f, 0.f) & 0xffffu); }
__device__ __forceinline__ float wave_sum(float v) {
#pragma unroll
    for (int o = 1; o < 64; o <<= 1) v += __shfl_xor(v, o);
    return v;
}
__device__ __forceinline__ float fast_exp2(float x) { return __builtin_amdgcn_exp2f(x); }
__device__ __forceinline__ float fast_rcp(float x) { return __builtin_amdgcn_rcpf(x); }
__device__ __forceinline__ float silu_f(float x) { return x * fast_rcp(1.f + fast_exp2(-x * LOG2E)); }

#define XB_TMO      128
#define XB_XCNT(j)  (256  + 64 * (j))
#define XB_XSUB(j)  (1280 + 64 * (j))
#define XB_XGEN(j)  (2304 + 64 * (j))
#define XB_TOP      3328
#define XB_TOPGEN   3392
#define XCD_BAR_WORDS 3456
#define XB_SPIN_CAP (1u << 18)

__device__ __forceinline__ unsigned xb_ld(unsigned* p)              { return __hip_atomic_load(p, __ATOMIC_RELAXED, __HIP_MEMORY_SCOPE_AGENT); }
__device__ __forceinline__ unsigned xb_add(unsigned* p, unsigned v) { return __hip_atomic_fetch_add(p, v, __ATOMIC_RELAXED, __HIP_MEMORY_SCOPE_AGENT); }
__device__ __forceinline__ unsigned xb_xcc_id() { return (unsigned)__builtin_amdgcn_s_getreg((3 << 11) | 20) & 0xFu; }
#define XB_SPIN(cond, bar) do { unsigned _sp = 0; while (cond) { __builtin_amdgcn_s_sleep(1); \
    if ((++_sp & 255u) == 0u) { if (xb_ld(&(bar)[XB_TMO])) break; if (_sp > XB_SPIN_CAP) { atomicAdd(&(bar)[XB_TMO], 1u); break; } } } } while (0)

struct XcdBarrier { unsigned* bar; unsigned x; volatile LAS unsigned* st; };

__device__ __forceinline__ XcdBarrier xcd_barrier_post(unsigned* bar, volatile LAS unsigned* st) {
    XcdBarrier b; b.bar = bar; b.x = xb_xcc_id(); b.st = st;
    if (threadIdx.x == 0) (void)xb_add(&bar[XB_XCNT(b.x)], 1u);
    return b;
}
__device__ __forceinline__ void xcd_barrier_complete(unsigned* bar, unsigned x, unsigned& nloc, unsigned& nx) {
    const unsigned G = gridDim.x * gridDim.y * gridDim.z;
    unsigned sum, cnt, mine, sp = 0u;
    for (;;) {
        sum = 0u; cnt = 0u; mine = 0u;
#pragma unroll
        for (unsigned j = 0; j < 16; ++j) { const unsigned c = xb_ld(&bar[XB_XCNT(j)]); sum += c; cnt += (c > 0u) ? 1u : 0u; mine = (j == x) ? c : mine; }
        if (sum == G) break;
        __builtin_amdgcn_s_sleep(1);
        if ((++sp & 255u) == 0u) { if (xb_ld(&bar[XB_TMO])) break; if (sp > XB_SPIN_CAP) { atomicAdd(&bar[XB_TMO], 1u); break; } }
    }
    nloc = mine > 0u ? mine : 1u; nx = cnt > 0u ? cnt : 1u;
}
__device__ __forceinline__ void xcd_barrier(const XcdBarrier& b) {
    asm volatile("s_waitcnt vmcnt(0)" ::: "memory");
    __syncthreads();
    if (threadIdx.x == 0) {
        unsigned* bar = b.bar;
        __builtin_amdgcn_s_waitcnt(0);
        unsigned nloc = b.st[0], nx = b.st[1];
        if (nloc == 0u) { xcd_barrier_complete(bar, b.x, nloc, nx); b.st[0] = nloc; b.st[1] = nx; }
        const unsigned old = xb_add(&bar[XB_XSUB(b.x)], 1u);
        const unsigned gen = old / nloc;
        if (old + 1u == (gen + 1u) * nloc) {
            __builtin_amdgcn_fence(__ATOMIC_RELEASE, "agent");
            asm volatile("s_waitcnt vmcnt(0)" ::: "memory");
            const unsigned og = xb_add(&bar[XB_TOP], 1u);
            const unsigned tg = og / nx;
            if (og + 1u == (tg + 1u) * nx) xb_add(&bar[XB_TOPGEN], 1u);
            else XB_SPIN(xb_ld(&bar[XB_TOPGEN]) == tg, bar);
            __builtin_amdgcn_fence(__ATOMIC_ACQUIRE, "agent");
            xb_add(&bar[XB_XGEN(b.x)], 1u);
            asm volatile("s_waitcnt vmcnt(0)" ::: "memory");
        } else {
            XB_SPIN(xb_ld(&bar[XB_XGEN(b.x)]) == gen, bar);
            __builtin_amdgcn_fence(__ATOMIC_ACQUIRE, "agent");
            asm volatile("s_waitcnt vmcnt(0)" ::: "memory");
        }
    }
    __syncthreads();
}

namespace pg8 {
constexpr int BM = 256, BK = 64, HALF = 128, HTB = HALF * BK * 2, STAGE_BYTES = 8 * HTB, NXCD = 8, WGM = 8;
__host__ __device__ __forceinline__ int lds_byte(int r, int c) { const int st = (r >> 4) * 2 + (c >> 5), rr = r & 15, cc = c & 31, ob = rr * 64 + cc * 2; return st * 1024 + (ob ^ (((ob >> 9) & 1) << 5)); }
__host__ __device__ __forceinline__ void stage_rc(int b, int& R, int& C) { const int st = b / 1024, sb = b % 1024, swz = sb ^ (((sb >> 9) & 1) << 5); R = (st >> 1) * 16 + swz / 64; C = (st & 1) * 32 + (swz % 64) / 2; }

struct Unit { int pm, pn, sel; };
struct Gemm { const bf16_t* A0; const bf16_t* B0; const bf16_t* A1; const bf16_t* B1; int K; };

struct Order {
    int nM, nN, nwg, n1M, n1N, G, c;
    __device__ void init(int nM_, int nN_, int n1M_, int n1N_, int G_, int c_) { nM = nM_; nN = nN_; nwg = nM * nN; n1M = n1M_; n1N = n1N_; G = G_; c = c_; }
    __device__ bool next(int i, Unit& u) const {
        const long L = (long)i * G + c;
        if (L >= nwg + n1M * n1N) return false;
        if (L >= nwg) { const int r = (int)L - nwg; u.pm = r / n1N; u.pn = r % n1N; u.sel = 1; return true; }
        int wgid = (int)L; { const int q = nwg / NXCD, r = nwg % NXCD, xcd = wgid % NXCD, off = wgid / NXCD; wgid = (xcd < r ? xcd * (q + 1) : r * (q + 1) + (xcd - r) * q) + off; }
        const int nig = WGM * nN, gid = wgid / nig, fm = gid * WGM, gsz = (nM - fm) < WGM ? (nM - fm) : WGM;
        u.pm = fm + ((wgid % nig) % gsz); u.pn = (wgid % nig) / gsz; u.sel = 0; return true;
    }
};

template <class Epi>
__device__ __forceinline__ void gemm_phase(LAS unsigned char* lds, const Gemm g, const Order& S, const Epi& E) {
    const int tid = threadIdx.x, wid = __builtin_amdgcn_readfirstlane(tid >> 6), lane = tid & 63, wr = wid >> 2, wc = wid & 3, fr = lane & 15, fq = lane >> 4;
    const int K = g.K, nt = K / BK;
    unsigned voffA[2];
#pragma unroll
    for (int i = 0; i < 2; ++i) { int R, C; stage_rc(tid * 16 + i * 8192, R, C); voffA[i] = (unsigned)(R * K + C) * 2u; }
    const size_t kstep = (size_t)(BK * 2);
    const size_t hstep = (size_t)HALF * K * 2;
    const size_t tstep = 2 * hstep;
    const unsigned ldsw = (unsigned)wid * 1024u;
    const int aoff = lds_byte(wr * 64 + fr, fq * 8), boff = lds_byte(wc * 32 + fr, fq * 8);
#define PG8_SA(b, h) (((b) * 2 + (h)) * HTB)
#define PG8_SB(b, h) ((4 + (b) * 2 + (h)) * HTB)
#define PG8_STAGE(bufoff, gbase) do { _Pragma("unroll") for (int _i = 0; _i < 2; ++_i) \
        __builtin_amdgcn_global_load_lds((const unsigned*)((const char*)(gbase) + voffA[_i]), (LAS unsigned*)(lds + (bufoff) + ldsw + _i * 8192), 16, 0, 0); } while (0)
#define PG8_LDA(dst, b, h) do { _Pragma("unroll") for (int m = 0; m < 4; ++m) _Pragma("unroll") for (int k = 0; k < 2; ++k) dst[m][k] = *(const LAS bf16x8*)(lds + PG8_SA(b, h) + aoff + m * 2048 + k * 1024); } while (0)
#define PG8_LDB(dst, b, h) do { _Pragma("unroll") for (int n = 0; n < 2; ++n) _Pragma("unroll") for (int k = 0; k < 2; ++k) dst[n][k] = *(const LAS bf16x8*)(lds + PG8_SB(b, h) + boff + n * 2048 + k * 1024); } while (0)
#define PG8_MMA(ai, bj, At, Bt) do { __builtin_amdgcn_s_setprio(1); _Pragma("unroll") for (int m = 0; m < 4; ++m) _Pragma("unroll") for (int n = 0; n < 2; ++n) _Pragma("unroll") for (int k = 0; k < 2; ++k) \
        acc[ai][bj][m][n] = __builtin_amdgcn_mfma_f32_16x16x32_bf16(Bt[n][k], At[m][k], acc[ai][bj][m][n], 0, 0, 0); __builtin_amdgcn_s_setprio(0); } while (0)
#define PG8_WAIT_V(n) asm volatile("s_waitcnt vmcnt(" #n ")" ::: "memory")
#define PG8_WAIT_L(n) asm volatile("s_waitcnt lgkmcnt(" #n ")" ::: "memory")
#define PG8_BAR __builtin_amdgcn_s_barrier()
#define PG8_SCHED __builtin_amdgcn_sched_barrier(0)
    Unit cur, nxt; int ui = 0;
    if (!S.next(0, cur)) return;
    f32x4 acc[2][2][4][2];
#pragma unroll
    for (int a = 0; a < 2; ++a)
#pragma unroll
        for (int b = 0; b < 2; ++b)
#pragma unroll
            for (int m = 0; m < 4; ++m)
#pragma unroll
                for (int n = 0; n < 2; ++n) acc[a][b][m][n] = (f32x4){0.f, 0.f, 0.f, 0.f};
    bf16x8 At[4][2], B0[2][2], B1[2][2];
    const char* cA = (const char*)(cur.sel ? g.A1 : g.A0) + (size_t)cur.pm * tstep; const char* cB = (const char*)(cur.sel ? g.B1 : g.B0) + (size_t)cur.pn * tstep;
    PG8_STAGE(PG8_SB(0, 0), cB); PG8_STAGE(PG8_SB(0, 1), cB + hstep); PG8_STAGE(PG8_SA(0, 0), cA); PG8_STAGE(PG8_SA(0, 1), cA + hstep);
    if (wr == 1) PG8_BAR;
    PG8_WAIT_V(2); PG8_BAR;
    PG8_STAGE(PG8_SB(1, 0), cB + kstep); PG8_STAGE(PG8_SA(1, 0), cA + kstep); PG8_STAGE(PG8_SB(1, 1), cB + hstep + kstep);
    PG8_WAIT_V(6); PG8_BAR;
    for (;;) {
        const bool has_next = S.next(ui + 1, nxt);
        const char* nA = has_next ? (const char*)(nxt.sel ? g.A1 : g.A0) + (size_t)nxt.pm * tstep : cA; const char* nB = has_next ? (const char*)(nxt.sel ? g.B1 : g.B0) + (size_t)nxt.pn * tstep : cB;
        for (int t = 0; t < nt; t += 2) {
            const bool last = (t == nt - 2);
            const char* a1 = cA + (size_t)(t + 1) * kstep;
            const char* a2 = last ? nA : cA + (size_t)(t + 2) * kstep; const char* b2 = last ? nB : cB + (size_t)(t + 2) * kstep;
            const char* a3 = a2 + kstep; const char* b3 = b2 + kstep;
            PG8_LDB(B0, 0, 0); PG8_LDB(B1, 0, 1); PG8_SCHED; PG8_LDA(At, 0, 0); PG8_STAGE(PG8_SA(1, 1), a1 + hstep);
            PG8_WAIT_V(8); PG8_WAIT_L(0); PG8_BAR; PG8_MMA(0, 0, At, B0); PG8_MMA(0, 1, At, B1); PG8_BAR; PG8_SCHED;
            PG8_LDA(At, 0, 1); PG8_STAGE(PG8_SB(0, 0), b2); PG8_STAGE(PG8_SB(0, 1), b2 + hstep); PG8_STAGE(PG8_SA(0, 0), a2);
            PG8_WAIT_V(8); PG8_WAIT_L(0); PG8_BAR; PG8_MMA(1, 0, At, B0); PG8_MMA(1, 1, At, B1); PG8_BAR; PG8_SCHED;
            PG8_LDB(B0, 1, 0); PG8_LDB(B1, 1, 1); PG8_SCHED; PG8_LDA(At, 1, 0); PG8_STAGE(PG8_SA(0, 1), a2 + hstep);
            PG8_WAIT_V(8); PG8_WAIT_L(0); PG8_BAR; PG8_MMA(0, 0, At, B0); PG8_MMA(0, 1, At, B1); PG8_BAR; PG8_SCHED;
            PG8_LDA(At, 1, 1); PG8_STAGE(PG8_SB(1, 0), b3); PG8_STAGE(PG8_SB(1, 1), b3 + hstep); PG8_STAGE(PG8_SA(1, 0), a3);
            PG8_WAIT_V(8); PG8_WAIT_L(0); PG8_BAR; PG8_MMA(1, 0, At, B0); PG8_MMA(1, 1, At, B1); PG8_BAR; PG8_SCHED;
        }
        if (wr == 0) PG8_BAR;
        E(acc, cur, wr, wc, fr, fq);
        if (!has_next) break;
#pragma unroll
        for (int a = 0; a < 2; ++a)
#pragma unroll
            for (int b = 0; b < 2; ++b)
#pragma unroll
                for (int m = 0; m < 4; ++m)
#pragma unroll
                    for (int n = 0; n < 2; ++n) acc[a][b][m][n] = (f32x4){0.f, 0.f, 0.f, 0.f};
        cur = nxt; cA = nA; cB = nB; ++ui;
        if (wr == 1) PG8_BAR;
    }
    PG8_WAIT_V(0);
    PG8_BAR;
#undef PG8_SA
#undef PG8_SB
#undef PG8_STAGE
#undef PG8_LDA
#undef PG8_LDB
#undef PG8_MMA
#undef PG8_WAIT_V
#undef PG8_WAIT_L
#undef PG8_BAR
#undef PG8_SCHED
}
typedef f32x4 Acc[2][2][4][2];
__device__ __forceinline__ void store_f32(const Acc& acc, float* base, int ld, int rl0, int cl0, int valid) {
#pragma unroll
    for (int ai = 0; ai < 2; ++ai)
#pragma unroll
        for (int m = 0; m < 4; ++m) { const int row = rl0 + ai * HALF + m * 16; if (row < valid) { float* rp = base + (size_t)row * ld + cl0;
#pragma unroll
            for (int bj = 0; bj < 2; ++bj)
#pragma unroll
                for (int n = 0; n < 2; ++n) *(f32x4*)(rp + bj * HALF + n * 16) = acc[ai][bj][m][n]; } }
}
__device__ __forceinline__ void store_bf16(const Acc& acc, bf16_t* base, int ld, int rl0, int cl0) {
#pragma unroll
    for (int ai = 0; ai < 2; ++ai)
#pragma unroll
        for (int m = 0; m < 4; ++m) { const int row = rl0 + ai * HALF + m * 16; bf16_t* rp = base + (size_t)row * ld + cl0;
#pragma unroll
            for (int bj = 0; bj < 2; ++bj)
#pragma unroll
                for (int n = 0; n < 2; ++n) { const f32x4 a = acc[ai][bj][m][n]; u32x2 w; w.x = cvtpk(a[0], a[1]); w.y = cvtpk(a[2], a[3]); *(u32x2*)(rp + bj * HALF + n * 16) = w; } }
}
}

struct Params {
    const float* in[26];
    float* out;
    unsigned char* ws;
    int ph_lo, ph_hi;
};
enum { I_XP = 0, I_XS, I_CK, I_CV, I_SSM, I_SCONV, I_CMK, I_CMV, I_PT, I_MEM, I_NORMW, I_WIN, I_QNORM, I_KNORM, I_SBBIAS, I_CONVW, I_CONVB, I_DTBIAS, I_ALOG, I_DSKIP,
       I_SSDNW, I_MEMNW, I_WMEM, I_MQNORM, I_MKNORM, I_WOUT };

template <int MAP>
__device__ __forceinline__ void p0_transpose_item(const float* W, int K, int Nsrc, int N, bf16_t* WT, LAS float* scr, int item, int lane) {
    const int nblk = N / 32, kb = item / nblk, nb = item % nblk, k0 = 64 * kb, n0 = 32 * nb;
    const int nd = n0 + (lane & 31);
    int ns = nd; bool ok = true;
    if (MAP == 1) { if (nd < 5632) ns = nd; else if (nd < 6656) ns = nd + 8; else if (nd < 6664) ns = nd - 1024; else { ns = 0; ok = false; } }
#pragma unroll 8
    for (int i = 0; i < 32; ++i) { const int kk = 2 * i + (lane >> 5); scr[kk * 33 + (lane & 31)] = ok ? W[(size_t)(k0 + kk) * Nsrc + ns] : 0.f; }
    asm volatile("s_waitcnt lgkmcnt(0)" ::: "memory");
    const int c = lane & 7;
#pragma unroll
    for (int j = 0; j < 4; ++j) { const int n = (lane >> 3) + 8 * j; const LAS float* s = scr + (8 * c) * 33 + n;
        u32x4 o; o.x = cvtpk(s[0 * 33], s[1 * 33]); o.y = cvtpk(s[2 * 33], s[3 * 33]); o.z = cvtpk(s[4 * 33], s[5 * 33]); o.w = cvtpk(s[6 * 33], s[7 * 33]);
        *(u32x4*)(WT + (size_t)(n0 + n) * K + k0 + 8 * c) = o; }
    asm volatile("s_waitcnt lgkmcnt(0)" ::: "memory");
}
__device__ __forceinline__ void rms_row_to_bf16(const float* xrow, const float* gain, bf16_t* orow, int lane) {
    const f32x4* xr = (const f32x4*)xrow + lane; const f32x4* gr = (const f32x4*)gain + lane;
    f32x4 v[8]; float s = 0.f;
#pragma unroll
    for (int j = 0; j < 8; ++j) { v[j] = xr[64 * j]; s += (v[j].x * v[j].x + v[j].y * v[j].y) + (v[j].z * v[j].z + v[j].w * v[j].w); }
    const float rs = 1.f / sqrtf(wave_sum(s) * (1.f / DM) + EPS);
    u32x2* o8 = (u32x2*)orow + lane;
#pragma unroll
    for (int j = 0; j < 8; ++j) { const f32x4 g = gr[64 * j]; u32x2 w; w.x = cvtpk(v[j].x * rs * g.x, v[j].y * rs * g.y); w.y = cvtpk(v[j].z * rs * g.z, v[j].w * rs * g.w); o8[64 * j] = w; }
}
__device__ __forceinline__ void phase0(const Params& p, LAS unsigned char* lds, int vcu, int G) {
    const int tid = threadIdx.x, lane = tid & 63, wave = __builtin_amdgcn_readfirstlane(tid >> 6);
    LAS float* scr = (LAS float*)(lds + wave * 16384);
    const int gw = vcu * 8 + wave, NGW = G * 8;
    bf16_t* WinT = (bf16_t*)(p.ws + WS_WIN); bf16_t* WmT = (bf16_t*)(p.ws + WS_WM); bf16_t* WoutT = (bf16_t*)(p.ws + WS_WOUT);
    constexpr int I_IN = (DM / 64) * (NPAD / 32), I_M = (DM / 64) * (1024 / 32), I_O = (DM / 64) * (DM / 32);
    for (int it = gw; it < I_IN + I_M + I_O; it += NGW) {
        int r = it;
        if (r < I_IN) { p0_transpose_item<1>(p.in[I_WIN], DM, NIN, NPAD, WinT, scr, r, lane); continue; } r -= I_IN;
        if (r < I_M) { p0_transpose_item<0>(p.in[I_WMEM], DM, 1024, 1024, WmT, scr, r, lane); continue; } r -= I_M;
        p0_transpose_item<0>(p.in[I_WOUT], DM, DM, DM, WoutT, scr, r, lane);
    }
    bf16_t* H = (bf16_t*)(p.ws + WS_H); bf16_t* HM = (bf16_t*)(p.ws + WS_HM);
    for (int m = gw; m < MVALID + MMEM; m += NGW) {
        if (m < MP) rms_row_to_bf16(p.in[I_XP] + (size_t)m * DM, p.in[I_NORMW], H + (size_t)m * DM, lane);
        else if (m < MVALID) rms_row_to_bf16(p.in[I_XS] + (size_t)(m - MP) * DM, p.in[I_NORMW], H + (size_t)m * DM, lane);
        else rms_row_to_bf16(p.in[I_MEM] + (size_t)(m - MVALID) * DM, p.in[I_MEMNW], HM + (size_t)(m - MVALID) * DM, lane);
    }
    const int gt = vcu * 512 + tid, NGT = G * 512;
    u32x4* cmk = (u32x4*)(p.ws + WS_CMK); u32x4* cmv = (u32x4*)(p.ws + WS_CMV);
    constexpr int N8 = DSEQ * MEMT * 512 / 8;
    for (int i = gt; i < 2 * N8; i += NGT) { const bool isk = i < N8; const int j = isk ? i : i - N8; const f32x4* s = (const f32x4*)(isk ? p.in[I_CMK] : p.in[I_CMV]) + 2 * (size_t)j;
        const f32x4 a = s[0], b = s[1]; u32x4 o; o.x = cvtpk(a.x, a.y); o.y = cvtpk(a.z, a.w); o.z = cvtpk(b.x, b.y); o.w = cvtpk(b.z, b.w); (isk ? cmk : cmv)[j] = o; }
}

struct Epi1 {
    bf16_t* PROJ; float* DT; float* out;
    __device__ __forceinline__ void operator()(const pg8::Acc& acc, const pg8::Unit& u, int wr, int wc, int fr, int fq) const {
        int rl0 = wr * 64 + fr, cl0 = wc * 32 + 4 * fq;
        asm volatile("" : "+v"(rl0), "+v"(cl0));
        const int pn = u.pn; const size_t r0 = (size_t)u.pm * 256;
        float* fbase = nullptr; int fld = 1024, valid = 256;
        if (u.sel == 1) { fbase = out + (pn < 2 ? O_PMK : O_PMV) + r0 * 512 + (pn & 1) * 256; fld = 512; }
        else if (pn >= 4 && pn < 12) {
            if (u.pm < 32) fbase = out + (pn < 8 ? O_PK : O_PV) + r0 * 1024 + (pn & 3) * 256;
            else { fbase = out + (pn < 8 ? O_SK : O_SV) + (pn & 3) * 256; valid = MS; } }
        if (fbase) pg8::store_f32(acc, fbase, fld, rl0, cl0, valid);
        if (u.sel == 0) {
            pg8::store_bf16(acc, PROJ + r0 * NPAD + pn * 256, NPAD, rl0, cl0);
            if (pn == 26 && wc == 0 && fq < 2) {
#pragma unroll
                for (int ai = 0; ai < 2; ++ai)
#pragma unroll
                    for (int m = 0; m < 4; ++m) { const int row = rl0 + ai * 128 + m * 16; *(f32x4*)(DT + (r0 + row) * 8 + 4 * fq) = acc[ai][0][m][0]; } }
        }
    }
};

__device__ __forceinline__ float group16_sum(float v) { v += __shfl_xor(v, 1); v += __shfl_xor(v, 2); v += __shfl_xor(v, 4); v += __shfl_xor(v, 8); return v; }
__device__ __forceinline__ void phase2(const Params& p, int vcu, int G) {
    const int tid = threadIdx.x, lane = tid & 63, wave = __builtin_amdgcn_readfirstlane(tid >> 6);
    const int gw = vcu * 8 + wave, NGW = G * 8;
    const int sub = lane & 15, grp = lane >> 4;
    bf16_t* PROJ = (bf16_t*)(p.ws + WS_PROJ);
    bf16_t* MKn = (bf16_t*)(p.ws + WS_MKN); bf16_t* MVb = (bf16_t*)(p.ws + WS_MVB);
    f32x4 gq[2], gk[2], gmq[2], gmk[2];
#pragma unroll
    for (int j = 0; j < 2; ++j) { gq[j] = *(const f32x4*)(p.in[I_QNORM] + sub * 8 + 4 * j) * QSCALE; gk[j] = *(const f32x4*)(p.in[I_KNORM] + sub * 8 + 4 * j);
                                  gmq[j] = *(const f32x4*)(p.in[I_MQNORM] + sub * 8 + 4 * j) * QSCALE; gmk[j] = *(const f32x4*)(p.in[I_MKNORM] + sub * 8 + 4 * j); }
    for (int row = gw; row < MVALID + MMEM; row += NGW) {
        if (row < MVALID) {
#pragma unroll
            for (int ps = 0; ps < 2; ++ps) { u32x4* qp = (u32x4*)(PROJ + (size_t)row * NPAD + PC_Q + (ps * 4 + grp) * 128 + sub * 8); const u32x4 w = *qp;
                float v[8] = {bf_lo(w.x), bf_hi(w.x), bf_lo(w.y), bf_hi(w.y), bf_lo(w.z), bf_hi(w.z), bf_lo(w.w), bf_hi(w.w)}; float s = 0.f;
#pragma unroll
                for (int k = 0; k < 8; ++k) s += v[k] * v[k];
                const float rs = 1.f / sqrtf(group16_sum(s) * (1.f / 128.f) + EPS);
                u32x4 o; o.x = cvtpk(v[0] * rs * gq[0].x, v[1] * rs * gq[0].y); o.y = cvtpk(v[2] * rs * gq[0].z, v[3] * rs * gq[0].w); o.z = cvtpk(v[4] * rs * gq[1].x, v[5] * rs * gq[1].y); o.w = cvtpk(v[6] * rs * gq[1].z, v[7] * rs * gq[1].w);
                *qp = o; }
            { u32x4* qp = (u32x4*)(PROJ + (size_t)row * NPAD + PC_MQ + grp * 128 + sub * 8); const u32x4 w = *qp;
                float v[8] = {bf_lo(w.x), bf_hi(w.x), bf_lo(w.y), bf_hi(w.y), bf_lo(w.z), bf_hi(w.z), bf_lo(w.w), bf_hi(w.w)}; float s = 0.f;
#pragma unroll
                for (int k = 0; k < 8; ++k) s += v[k] * v[k];
                const float rs = 1.f / sqrtf(group16_sum(s) * (1.f / 128.f) + EPS);
                u32x4 o; o.x = cvtpk(v[0] * rs * gmq[0].x, v[1] * rs * gmq[0].y); o.y = cvtpk(v[2] * rs * gmq[0].z, v[3] * rs * gmq[0].w); o.z = cvtpk(v[4] * rs * gmq[1].x, v[5] * rs * gmq[1].y); o.w = cvtpk(v[6] * rs * gmq[1].z, v[7] * rs * gmq[1].w);
                *qp = o; }
            float* krow = (row < MP) ? p.out + O_PK + (size_t)row * 1024 : p.out + O_SK + (size_t)(row - MP) * 1024;
#pragma unroll
            for (int ps = 0; ps < 2; ++ps) { f32x4* kp = (f32x4*)(krow + (ps * 4 + grp) * 128 + sub * 8); f32x4 a = kp[0], b = kp[1];
                float s = (a.x * a.x + a.y * a.y) + (a.z * a.z + a.w * a.w) + (b.x * b.x + b.y * b.y) + (b.z * b.z + b.w * b.w);
                const float rs = 1.f / sqrtf(group16_sum(s) * (1.f / 128.f) + EPS);
                a = a * rs * gk[0]; b = b * rs * gk[1]; kp[0] = a; kp[1] = b;
                u32x4 o; o.x = cvtpk(a.x, a.y); o.y = cvtpk(a.z, a.w); o.z = cvtpk(b.x, b.y); o.w = cvtpk(b.z, b.w);
                *(u32x4*)(PROJ + (size_t)row * NPAD + PC_K + (ps * 4 + grp) * 128 + sub * 8) = o; }
        } else {
            const int mr = row - MVALID;
            { f32x4* kp = (f32x4*)(p.out + O_PMK + (size_t)mr * 512 + grp * 128 + sub * 8); f32x4 a = kp[0], b = kp[1];
                float s = (a.x * a.x + a.y * a.y) + (a.z * a.z + a.w * a.w) + (b.x * b.x + b.y * b.y) + (b.z * b.z + b.w * b.w);
                const float rs = 1.f / sqrtf(group16_sum(s) * (1.f / 128.f) + EPS);
                a = a * rs * gmk[0]; b = b * rs * gmk[1]; kp[0] = a; kp[1] = b;
                u32x4 o; o.x = cvtpk(a.x, a.y); o.y = cvtpk(a.z, a.w); o.z = cvtpk(b.x, b.y); o.w = cvtpk(b.z, b.w);
                *(u32x4*)(MKn + (size_t)mr * 512 + grp * 128 + sub * 8) = o; }
            { const f32x4* vp = (const f32x4*)(p.out + O_PMV + (size_t)mr * 512 + grp * 128 + sub * 8); const f32x4 a = vp[0], b = vp[1];
                u32x4 o; o.x = cvtpk(a.x, a.y); o.y = cvtpk(a.z, a.w); o.z = cvtpk(b.x, b.y); o.w = cvtpk(b.z, b.w);
                *(u32x4*)(MVb + (size_t)mr * 512 + grp * 128 + sub * 8) = o; }
        }
    }
    const bf16_t* XBC = (const bf16_t*)(p.ws + WS_PROJ) + PC_XBC;
    const int gt = vcu * 512 + tid, NGT = G * 512;
    for (int i = gt; i < (NBATCH + DSEQ) * 3 * 1024; i += NGT) {
        const int c = i & 1023, j = (i >> 10) % 3, s = i / 3072;
        if (s < NBATCH) p.out[O_PCONV + (size_t)i] = bf2f(XBC[(size_t)(s * SEQ + SEQ - 3 + j) * NPAD + c]);
        else p.out[O_SCONV + (size_t)(i - NBATCH * 3072)] = bf2f(XBC[(size_t)(MP + (s - NBATCH) * DTOK + DTOK - 3 + j) * NPAD + c]);
    }
}

#define KSWZ(row, colB) ((row) * 256 + ((colB) ^ (((row) & 7) << 4)))
#define SBAR() __builtin_amdgcn_sched_barrier(0)
__device__ __forceinline__ int crow(int r, int hi) { return (r & 3) + 8 * (r >> 2) + 4 * hi; }
__device__ __forceinline__ int v_st(int k, int c) { const int kk = (k & ~0xC) | ((k & 4) << 1) | ((k & 8) >> 1); return ((kk >> 3) * 4 + (c >> 5)) * 512 + ((kk & 7) * 32 + (c & 31)) * 2; }
__device__ __forceinline__ int v_rd_base(int lane) { return ((lane & 3) << 3) | (((lane >> 2) & 3) << 6) | (((lane >> 4) & 1) << 5) | (((lane >> 5) & 1) << 8); }
constexpr int v_rd_off(int d0, int ks, int half) { return d0 * 512 + ks * 4096 + half * 2048; }
template <int OFF> __device__ __forceinline__ s16x4 tr_read(int vb) {
    s16x4 r; asm volatile("ds_read_b64_tr_b16 %0, %1 offset:%2" : "=&v"(r) : "v"(vb), "i"(OFF) : "memory"); return r;
}
#define PKV(L, H) (bf16x8){L[0], L[1], L[2], L[3], H[0], H[1], H[2], H[3]}
template <int D0, int KS0> __device__ __forceinline__ void pv_one(f32x16& od, int vb, const bf16x8* pa) {
    const s16x4 l0 = tr_read<v_rd_off(D0, KS0, 0)>(vb), h0 = tr_read<v_rd_off(D0, KS0, 1)>(vb), l1 = tr_read<v_rd_off(D0, KS0 + 1, 0)>(vb), h1 = tr_read<v_rd_off(D0, KS0 + 1, 1)>(vb);
    asm volatile("s_waitcnt lgkmcnt(0)" ::: "memory"); SBAR();
    od = __builtin_amdgcn_mfma_f32_32x32x16_bf16(pa[0], PKV(l0, h0), od, 0, 0, 0);
    od = __builtin_amdgcn_mfma_f32_32x32x16_bf16(pa[1], PKV(l1, h1), od, 0, 0, 0);
}
template <int KS0> __device__ __forceinline__ void pv_blk(f32x16* o, int vb, const bf16x8* pa) {
    pv_one<0, KS0>(o[0], vb, pa); pv_one<1, KS0>(o[1], vb, pa); pv_one<2, KS0>(o[2], vb, pa); pv_one<3, KS0>(o[3], vb, pa);
}
__device__ __forceinline__ void pack_p(const f32x16& P, bf16x8& out0, bf16x8& out1) {
#define PK4(BASE, OUT) do { unsigned a0 = cvtpk(P[BASE + 0], P[BASE + 1]), a1 = cvtpk(P[BASE + 2], P[BASE + 3]);   \
    unsigned b0 = cvtpk(P[BASE + 4], P[BASE + 5]), b1 = cvtpk(P[BASE + 6], P[BASE + 7]);                              \
    auto r0 = __builtin_amdgcn_permlane32_swap(a0, b0, false, false); auto r1 = __builtin_amdgcn_permlane32_swap(a1, b1, false, false); \
    u32x4 w = {r0[0], r1[0], r0[1], r1[1]}; OUT = *reinterpret_cast<bf16x8*>(&w); } while (0)
    PK4(0, out0); PK4(8, out1);
#undef PK4
}
template <int NB, bool MASK> __device__ __forceinline__ void sb_transform(f32x16* P, float& R, int hi, int kpos0, int qpos) {
    float T[NB][4];
#pragma unroll
    for (int b = 0; b < NB; ++b)
#pragma unroll
        for (int g = 0; g < 4; ++g) {
            float be[4], f[4];
#pragma unroll
            for (int i = 0; i < 4; ++i) {
                const float z = fmaxf(P[b][4 * g + i], -100.f);
                const float e = fast_exp2(-z), rc = fast_rcp(1.f + e);
                be[i] = rc; f[i] = e * rc;
                if (MASK) { const bool ok = (kpos0 + 32 * b + 8 * g + 4 * hi + i) < qpos; be[i] = ok ? be[i] : 0.f; f[i] = ok ? f[i] : 1.f; }
            }
            const float e2 = f[3], e1 = f[2] * f[3], e0 = f[1] * e1;
            T[b][g] = f[0] * e0;
            P[b][4 * g + 0] = be[0] * e0; P[b][4 * g + 1] = be[1] * e1; P[b][4 * g + 2] = be[2] * e2; P[b][4 * g + 3] = be[3];
        }
    float E = R;
#pragma unroll
    for (int b = NB - 1; b >= 0; --b)
#pragma unroll
        for (int g = 3; g >= 0; --g) {
            const float To = __shfl_xor(T[b][g], 32);
            const float Eg = hi ? E : E * To;
#pragma unroll
            for (int i = 0; i < 4; ++i) P[b][4 * g + i] *= Eg;
            E = E * T[b][g] * To;
        }
    R = E;
}

struct AttnArgs {
    const bf16_t* Q; int qstride;
    const bf16_t* K; const bf16_t* V; int kvstride;
    int ntiles;
    int qpos0;
    int nvalid;
    float bias2;
    const bf16_t* gate; int gstride;
    bf16_t* out; int ostride;
};
template <int MODE>
__device__ __forceinline__ void attn_unit(LAS unsigned char* lds, const bf16_t* aQ, int aqstride, const bf16_t* aK, const bf16_t* aV, int akvstride, int antiles, int aqpos0, int anvalid, float abias2,
                                      const bf16_t* agate, int agstride, bf16_t* aout, int aostride) {
    AttnArgs a; a.Q = aQ; a.qstride = aqstride; a.K = aK; a.V = aV; a.kvstride = akvstride; a.ntiles = antiles; a.qpos0 = aqpos0; a.nvalid = anvalid; a.bias2 = abias2;
    a.gate = agate; a.gstride = agstride; a.out = aout; a.ostride = aostride;
    int tid = threadIdx.x; asm volatile("" : "+v"(tid));
    const int wid = __builtin_amdgcn_readfirstlane(tid >> 6), lane = tid & 63, r32 = lane & 31, hi = lane >> 5;
    constexpr int SHM_V = 16384, SHM_K = 16384;
    LAS unsigned char* V_lds = lds; LAS unsigned char* K_lds = lds + 2 * SHM_V;
    LAS float* wsf = (LAS float*)(lds + 2 * SHM_V + 2 * SHM_K) + wid * 64;
    f32x16 o[4];
#pragma unroll
    for (int d = 0; d < 4; ++d) o[d] = f32x16{};
    bf16x8 qr[8];
    { int qrow = wid * 32 + r32; qrow = qrow < a.nvalid ? qrow : a.nvalid - 1;
      const bf16_t* Qw = a.Q + (size_t)qrow * a.qstride + hi * 8;
#pragma unroll
      for (int d0 = 0; d0 < 8; ++d0) qr[d0] = *(const bf16x8*)(Qw + d0 * 16); }
    const int sr = tid >> 4, sc = (tid & 15) * 8, vst0 = v_st(sr, sc), vst1 = v_st(32 + sr, sc);
    const int vb0 = (int)(uintptr_t)V_lds + v_rd_base(lane);
    bf16x8 sv0, sv1, sk0, sk1;
#define SLOAD(k0) do { sv0 = *(const bf16x8*)(a.V + (size_t)((k0) + sr) * a.kvstride + sc); sv1 = *(const bf16x8*)(a.V + (size_t)((k0) + 32 + sr) * a.kvstride + sc); \
    sk0 = *(const bf16x8*)(a.K + (size_t)((k0) + sr) * a.kvstride + sc); sk1 = *(const bf16x8*)(a.K + (size_t)((k0) + 32 + sr) * a.kvstride + sc); } while (0)
#define SWRITE(b) do { *(LAS bf16x8*)(V_lds + (b) * SHM_V + vst0) = sv0; *(LAS bf16x8*)(V_lds + (b) * SHM_V + vst1) = sv1; \
    *(LAS bf16x8*)(K_lds + (b) * SHM_K + KSWZ(sr, sc * 2)) = sk0; *(LAS bf16x8*)(K_lds + (b) * SHM_K + KSWZ(32 + sr, sc * 2)) = sk1; } while (0)
    const int nt = a.ntiles;
    float R = 1.f, lsum = 0.f;
    const int qpos = a.qpos0 + wid * 32 + r32;
    const int qmax_w = a.qpos0 + wid * 32 + 31;
    __syncthreads();
    { const int t0 = (MODE == 0) ? nt - 1 : 0; SLOAD(t0 * 64); SWRITE(0); }
    __syncthreads();
    for (int j = 0; j < nt; ++j) {
        const int cur = j & 1, t = (MODE == 0) ? nt - 1 - j : j;
        if (j + 1 < nt) { const int tn = (MODE == 0) ? t - 1 : t + 1; SLOAD(tn * 64); }
        const bool active = (MODE == 1) || (t * 64 < qmax_w);
        if (active) {
            const LAS unsigned char* Ks = K_lds + cur * SHM_K;
            const bool diag = (MODE == 0) && (t * 64 + 63 >= a.qpos0);
#define ATT_BLOCK(B) do { f32x16 pb_[1]; { const float init = (MODE == 0) ? a.bias2 : 0.f; _Pragma("unroll") for (int r = 0; r < 16; ++r) pb_[0][r] = init; } \
            _Pragma("unroll") for (int d0 = 0; d0 < 8; ++d0) { const int cb = (d0 * 16 + hi * 8) * 2; \
                const bf16x8 kf = *(const LAS bf16x8*)(Ks + KSWZ(32 * (B) + r32, cb)); \
                pb_[0] = __builtin_amdgcn_mfma_f32_32x32x16_bf16(kf, qr[d0], pb_[0], 0, 0, 0); } \
            if (MODE == 0) { if (diag) sb_transform<1, true>(pb_, R, hi, t * 64 + 32 * (B), qpos); else sb_transform<1, false>(pb_, R, hi, 0, 0); } \
            else { float ps = 0.f; _Pragma("unroll") for (int r = 0; r < 16; ++r) { pb_[0][r] = fast_exp2(pb_[0][r]); ps += pb_[0][r]; } lsum += ps; } \
            bf16x8 pa_[2]; pack_p(pb_[0], pa_[0], pa_[1]); SBAR(); \
            pv_blk<2 * (B)>(o, vb0 + cur * SHM_V, pa_); } while (0)
            ATT_BLOCK(1);
            ATT_BLOCK(0);
#undef ATT_BLOCK
        }
        if (j + 1 < nt) SWRITE(cur ^ 1);
        __syncthreads();
    }
#undef SLOAD
#undef SWRITE
    float rl[16];
    if (MODE == 1) {
        lsum += __shfl_xor(lsum, 32);
        if (hi == 0) wsf[r32] = lsum;
        asm volatile("s_waitcnt lgkmcnt(0)" ::: "memory");
#pragma unroll
        for (int r = 0; r < 16; ++r) rl[r] = fast_rcp(wsf[crow(r, hi)]);
    }
#pragma unroll
    for (int r = 0; r < 16; ++r) {
        const int row = wid * 32 + crow(r, hi);
        if (row < a.nvalid) {
#pragma unroll
            for (int d0 = 0; d0 < 4; ++d0) {
                const float gt = bf2f(a.gate[(size_t)row * a.gstride + d0 * 32 + r32]);
                float v = o[d0][r]; if (MODE == 1) v *= rl[r];
                a.out[(size_t)row * a.ostride + d0 * 32 + r32] = f2bf(v * silu_f(gt));
            }
        }
    }
}

__device__ __forceinline__ void decode_unit(const int* ptab, const float* ck, const float* cv, const float* sbbias, unsigned char* ws, LAS unsigned char* lds, int seq, int page) {
    int tid = threadIdx.x; asm volatile("" : "+v"(tid));
    const int wid = __builtin_amdgcn_readfirstlane(tid >> 6), lane = tid & 63, r32 = lane & 31, hi = lane >> 5;
    const int head = wid;
    LAS unsigned char* K_lds = lds + wid * 16384; LAS unsigned char* V_lds = K_lds + 8192;
    const int phys = __builtin_amdgcn_readfirstlane(ptab[seq * NPAGES + page]);
    const float* Kp = ck + (size_t)phys * (PAGE * 1024) + head * 128;
    const float* Vp = cv + (size_t)phys * (PAGE * 1024) + head * 128;
    const float bias2 = sbbias[head] * LOG2E;
    const bf16_t* PROJ = (const bf16_t*)(ws + WS_PROJ);
    LAS unsigned char* Q_lds = lds + RING_BYTES + wid * 2048;
    f32x16 o[4];
#pragma unroll
    for (int d = 0; d < 4; ++d) o[d] = f32x16{};
    float R = 1.f;
    const int srow = lane >> 4, scol = (lane & 15) * 8;
    const int vb0 = (int)(uintptr_t)V_lds + v_rd_base(lane);
    __syncthreads();
#pragma unroll
    for (int i = 0; i < 2; ++i) { const int c = lane + 64 * i, qrw = c >> 4, qc = (c & 15) * 8;
        *(LAS bf16x8*)(Q_lds + KSWZ(qrw, qc * 2)) = *(const bf16x8*)(PROJ + (size_t)(MP + seq * DTOK + qrw) * NPAD + PC_Q + head * 128 + qc); }
    f32x4 st[16];
#define DLOAD(src, kb) do { _Pragma("unroll") for (int i = 0; i < 8; ++i) { const f32x4* g_ = (const f32x4*)((src) + (size_t)((kb) * 32 + srow + 4 * i) * 1024 + scol); \
        st[2 * i] = __builtin_nontemporal_load(g_); st[2 * i + 1] = __builtin_nontemporal_load(g_ + 1); } } while (0)
    DLOAD(Kp, 3);
    for (int kb = 3; kb >= 0; --kb) {
#pragma unroll
        for (int i = 0; i < 8; ++i) { u32x4 w; w.x = cvtpk(st[2 * i].x, st[2 * i].y); w.y = cvtpk(st[2 * i].z, st[2 * i].w); w.z = cvtpk(st[2 * i + 1].x, st[2 * i + 1].y); w.w = cvtpk(st[2 * i + 1].z, st[2 * i + 1].w);
            *(LAS u32x4*)(K_lds + KSWZ(srow + 4 * i, scol * 2)) = w; }
        DLOAD(Vp, kb);
        f32x16 pp[1];
#pragma unroll
        for (int r = 0; r < 16; ++r) pp[0][r] = bias2;
#pragma unroll
        for (int d0 = 0; d0 < 8; ++d0) { const int cb = (d0 * 16 + hi * 8) * 2;
            const bf16x8 b0 = *(const LAS bf16x8*)(K_lds + KSWZ(r32, cb));
            const bf16x8 qf = *(const LAS bf16x8*)(Q_lds + KSWZ(r32 & 7, cb));
            pp[0] = __builtin_amdgcn_mfma_f32_32x32x16_bf16(b0, qf, pp[0], 0, 0, 0); }
        sb_transform<1, false>(pp, R, hi, 0, 0);
        bf16x8 pa[2];
        pack_p(pp[0], pa[0], pa[1]);
#pragma unroll
        for (int i = 0; i < 8; ++i) { u32x4 w; w.x = cvtpk(st[2 * i].x, st[2 * i].y); w.y = cvtpk(st[2 * i].z, st[2 * i].w); w.z = cvtpk(st[2 * i + 1].x, st[2 * i + 1].y); w.w = cvtpk(st[2 * i + 1].z, st[2 * i + 1].w);
            *(LAS u32x4*)(V_lds + v_st(srow + 4 * i, scol)) = w; }
        if (kb > 0) DLOAD(Kp, kb - 1);
        SBAR();
        pv_blk<0>(o, vb0, pa);
    }
#undef DLOAD
    float* Op = (float*)(ws + WS_OPART) + ((size_t)((seq * 8 + head) * NPAGES + page)) * (DTOK * 128);
#pragma unroll
    for (int r = 0; r < 4; ++r)
#pragma unroll
        for (int d0 = 0; d0 < 4; ++d0) Op[(r + 4 * hi) * 128 + d0 * 32 + r32] = o[d0][r];
    if (lane < 8) ((float*)(ws + WS_FPART))[((size_t)((seq * 8 + head) * NPAGES + page)) * DTOK + lane] = R;
}

constexpr int SS_LD = 272;
constexpr int SS_CM = 0, SS_BM = 34816, SS_BWT = 69632, SS_XT = 104448, SS_HB = 121856, SS_XS = 139264, SS_XS_LD = 144, SS_F = 157696;
static_assert(SS_F + 1024 <= LDS_CTLW, "SSD LDS map");
template <bool SAMPLE>
__device__ __forceinline__ void ssd_unit(unsigned char* ws, float* outp, const float* alog, const float* dtbias, const float* dskip, const float* ssm0, const float* sconv0, const float* convw, const float* convb,
                                     LAS unsigned char* lds, int bs, int h) {
    int tid = threadIdx.x; asm volatile("" : "+v"(tid));
    const int wid = __builtin_amdgcn_readfirstlane(tid >> 6), lane = tid & 63, j16 = lane & 15, ig = lane >> 4;
    const int g = h >> 2;
    const int rowbase = SAMPLE ? MP + bs * DTOK : bs * SEQ;
    constexpr int NTOK = SAMPLE ? DTOK : SEQ, NCH = SAMPLE ? 1 : SEQ / 128;
    const float a_h = -__expf(alog[h]), dtb = dtbias[h], D_h = dskip[h];
    const bf16_t* PROJ = (const bf16_t*)(ws + WS_PROJ);
    const float* DTb = (const float*)(ws + WS_DT);
    LAS float* csf = (LAS float*)(lds + SS_F); LAS float* dtf = csf + 128;
    f32x4 hs[4];
    __syncthreads();
#pragma unroll
    for (int pb = 0; pb < 4; ++pb) {
#pragma unroll
        for (int r = 0; r < 4; ++r) { const int pp = 16 * pb + 4 * ig + r, n = 16 * wid + j16;
            const float v = SAMPLE ? ssm0[((size_t)(bs * 8 + h) * 64 + pp) * 128 + n] : 0.f; hs[pb][r] = v;
            *(LAS bf16_t*)(lds + SS_HB + pp * SS_LD + n * 2) = f2bf(v); } }
    for (int c = 0; c < NCH; ++c) {
        const int crow0 = rowbase + c * 128;
        if (wid == 0) {
            float da[2], dtv[2];
#pragma unroll
            for (int q = 0; q < 2; ++q) { const int l = lane + 64 * q; float dt = 0.f;
                if (c * 128 + l < NTOK) { const float x = DTb[(size_t)(crow0 + l) * 8 + h] + dtb; dt = (x > 20.f) ? x : log1pf(__expf(x)); }
                dtv[q] = dt; da[q] = dt * a_h; }
#pragma unroll
            for (int q = 0; q < 2; ++q) {
#pragma unroll
                for (int o = 1; o < 64; o <<= 1) { const float t = __shfl_up(da[q], o); if (lane >= o) da[q] += t; } }
            const float tot0 = __shfl(da[0], 63);
            csf[lane] = da[0]; csf[lane + 64] = da[1] + tot0; dtf[lane] = dtv[0]; dtf[lane + 64] = dtv[1];
        }
        __syncthreads();
        const float cs_end = csf[127];
        for (int it = tid; it < 1280; it += 512) {
            const int cc = it % 40, rg = it / 40, l0 = 4 * rg;
            const int ch0 = (cc < 8) ? h * 64 + 8 * cc : (cc < 24) ? 512 + g * 128 + 8 * (cc - 8) : 768 + g * 128 + 8 * (cc - 24);
            float raw[7][8];
#pragma unroll
            for (int r = 0; r < 7; ++r) { const int l = l0 - 3 + r; const int tpos = c * 128 + l;
                if (tpos >= 0 && tpos < NTOK) { const u32x4 w = *(const u32x4*)(PROJ + (size_t)(crow0 + l) * NPAD + PC_XBC + ch0);
                    raw[r][0] = bf_lo(w.x); raw[r][1] = bf_hi(w.x); raw[r][2] = bf_lo(w.y); raw[r][3] = bf_hi(w.y); raw[r][4] = bf_lo(w.z); raw[r][5] = bf_hi(w.z); raw[r][6] = bf_lo(w.w); raw[r][7] = bf_hi(w.w); }
                else if (SAMPLE && tpos < 0) { const f32x4* s = (const f32x4*)(sconv0 + ((size_t)bs * 3 + (3 + tpos)) * 1024 + ch0); const f32x4 u0 = s[0], u1 = s[1];
                    raw[r][0] = u0.x; raw[r][1] = u0.y; raw[r][2] = u0.z; raw[r][3] = u0.w; raw[r][4] = u1.x; raw[r][5] = u1.y; raw[r][6] = u1.z; raw[r][7] = u1.w; }
                else {
#pragma unroll
                    for (int k = 0; k < 8; ++k) raw[r][k] = 0.f; } }
            float cw[4][8], cbv[8];
#pragma unroll
            for (int jj = 0; jj < 4; ++jj) { const f32x4* s = (const f32x4*)(convw + jj * 1024 + ch0); const f32x4 u0 = s[0], u1 = s[1];
                cw[jj][0] = u0.x; cw[jj][1] = u0.y; cw[jj][2] = u0.z; cw[jj][3] = u0.w; cw[jj][4] = u1.x; cw[jj][5] = u1.y; cw[jj][6] = u1.z; cw[jj][7] = u1.w; }
            { const f32x4* s = (const f32x4*)(convb + ch0); const f32x4 u0 = s[0], u1 = s[1];
                cbv[0] = u0.x; cbv[1] = u0.y; cbv[2] = u0.z; cbv[3] = u0.w; cbv[4] = u1.x; cbv[5] = u1.y; cbv[6] = u1.z; cbv[7] = u1.w; }
            float ov[4][8];
#pragma unroll
            for (int r = 0; r < 4; ++r) { const bool live = (c * 128 + l0 + r) < NTOK;
#pragma unroll
                for (int k = 0; k < 8; ++k) { float v = cbv[k];
#pragma unroll
                    for (int jj = 0; jj < 4; ++jj) v = fmaf(raw[r + jj][k], cw[jj][k], v);
                    ov[r][k] = live ? silu_f(v) : 0.f; } }
            if (cc < 8) {
                float dtl[4];
#pragma unroll
                for (int r = 0; r < 4; ++r) dtl[r] = dtf[l0 + r];
#pragma unroll
                for (int r = 0; r < 4; ++r) { u32x4 w; w.x = cvtpk(ov[r][0], ov[r][1]); w.y = cvtpk(ov[r][2], ov[r][3]); w.z = cvtpk(ov[r][4], ov[r][5]); w.w = cvtpk(ov[r][6], ov[r][7]);
                    *(LAS u32x4*)(lds + SS_XS + (l0 + r) * SS_XS_LD + cc * 16) = w; }
#pragma unroll
                for (int k = 0; k < 8; ++k) { u32x2 w; w.x = cvtpk(ov[0][k] * dtl[0], ov[1][k] * dtl[1]); w.y = cvtpk(ov[2][k] * dtl[2], ov[3][k] * dtl[3]);
                    *(LAS u32x2*)(lds + SS_XT + (8 * cc + k) * SS_LD + l0 * 2) = w; }
            } else if (cc < 24) {
                const int n0 = 8 * (cc - 8);
                float wl[4];
#pragma unroll
                for (int r = 0; r < 4; ++r) wl[r] = __expf(cs_end - csf[l0 + r]);
#pragma unroll
                for (int r = 0; r < 4; ++r) { u32x4 w; w.x = cvtpk(ov[r][0], ov[r][1]); w.y = cvtpk(ov[r][2], ov[r][3]); w.z = cvtpk(ov[r][4], ov[r][5]); w.w = cvtpk(ov[r][6], ov[r][7]);
                    *(LAS u32x4*)(lds + SS_BM + (l0 + r) * SS_LD + n0 * 2) = w; }
#pragma unroll
                for (int k = 0; k < 8; ++k) { u32x2 w; w.x = cvtpk(ov[0][k] * wl[0], ov[1][k] * wl[1]); w.y = cvtpk(ov[2][k] * wl[2], ov[3][k] * wl[3]);
                    *(LAS u32x2*)(lds + SS_BWT + (n0 + k) * SS_LD + l0 * 2) = w; }
            } else {
                const int n0 = 8 * (cc - 24);
#pragma unroll
                for (int r = 0; r < 4; ++r) { u32x4 w; w.x = cvtpk(ov[r][0], ov[r][1]); w.y = cvtpk(ov[r][2], ov[r][3]); w.z = cvtpk(ov[r][4], ov[r][5]); w.w = cvtpk(ov[r][6], ov[r][7]);
                    *(LAS u32x4*)(lds + SS_CM + (l0 + r) * SS_LD + n0 * 2) = w; }
            }
        }
        __syncthreads();
        f32x4 cb[8];
#pragma unroll
        for (int sb = 0; sb < 8; ++sb) cb[sb] = f32x4{0.f, 0.f, 0.f, 0.f};
#pragma unroll
        for (int ks = 0; ks < 4; ++ks) {
            const bf16x8 af = *(const LAS bf16x8*)(lds + SS_CM + (16 * wid + j16) * SS_LD + (32 * ks + 8 * ig) * 2);
#pragma unroll
            for (int sb = 0; sb < 8; ++sb) { const bf16x8 bf = *(const LAS bf16x8*)(lds + SS_BM + (16 * sb + j16) * SS_LD + (32 * ks + 8 * ig) * 2);
                cb[sb] = __builtin_amdgcn_mfma_f32_16x16x32_bf16(af, bf, cb[sb], 0, 0, 0); } }
        { const float dec = __expf(cs_end);
#pragma unroll
          for (int pb = 0; pb < 4; ++pb) hs[pb] = hs[pb] * dec;
#pragma unroll
          for (int ks = 0; ks < 4; ++ks) {
              const bf16x8 bf = *(const LAS bf16x8*)(lds + SS_BWT + (16 * wid + j16) * SS_LD + (32 * ks + 8 * ig) * 2);
#pragma unroll
              for (int pb = 0; pb < 4; ++pb) { const bf16x8 af = *(const LAS bf16x8*)(lds + SS_XT + (16 * pb + j16) * SS_LD + (32 * ks + 8 * ig) * 2);
                  hs[pb] = __builtin_amdgcn_mfma_f32_16x16x32_bf16(af, bf, hs[pb], 0, 0, 0); } } }
        __syncthreads();
        {
            float csl[4];
#pragma unroll
            for (int r = 0; r < 4; ++r) csl[r] = csf[16 * wid + 4 * ig + r];
#pragma unroll
            for (int sb = 0; sb < 8; ++sb) { const int s = 16 * sb + j16; const float css = csf[s];
#pragma unroll
                for (int r = 0; r < 4; ++r) { const int l = 16 * wid + 4 * ig + r; const float gv = (s <= l) ? cb[sb][r] * __expf(csl[r] - css) : 0.f;
                    *(LAS bf16_t*)(lds + SS_BM + l * SS_LD + s * 2) = f2bf(gv); } }
        }
        f32x4 yd[4], yo[4];
#pragma unroll
        for (int pb = 0; pb < 4; ++pb) { yd[pb] = f32x4{0.f, 0.f, 0.f, 0.f}; yo[pb] = f32x4{0.f, 0.f, 0.f, 0.f}; }
#pragma unroll
        for (int ks = 0; ks < 4; ++ks) {
            const bf16x8 ag = *(const LAS bf16x8*)(lds + SS_BM + (16 * wid + j16) * SS_LD + (32 * ks + 8 * ig) * 2);
            const bf16x8 ac = *(const LAS bf16x8*)(lds + SS_CM + (16 * wid + j16) * SS_LD + (32 * ks + 8 * ig) * 2);
#pragma unroll
            for (int pb = 0; pb < 4; ++pb) {
                const bf16x8 bx = *(const LAS bf16x8*)(lds + SS_XT + (16 * pb + j16) * SS_LD + (32 * ks + 8 * ig) * 2);
                const bf16x8 bh = *(const LAS bf16x8*)(lds + SS_HB + (16 * pb + j16) * SS_LD + (32 * ks + 8 * ig) * 2);
                yd[pb] = __builtin_amdgcn_mfma_f32_16x16x32_bf16(ag, bx, yd[pb], 0, 0, 0);
                yo[pb] = __builtin_amdgcn_mfma_f32_16x16x32_bf16(ac, bh, yo[pb], 0, 0, 0); } }
        {
            float* YZ = (float*)(ws + WS_YZ); float* SSQ = (float*)(ws + WS_SSQ);
#pragma unroll
            for (int r = 0; r < 4; ++r) { const int l = 16 * wid + 4 * ig + r; const float el = __expf(csf[l]); float sq = 0.f;
                const bool live = (c * 128 + l) < NTOK; const size_t grow = (size_t)(crow0 + l);
#pragma unroll
                for (int pb = 0; pb < 4; ++pb) { const int pp = 16 * pb + j16;
                    const float xv = bf2f(*(const LAS bf16_t*)(lds + SS_XS + l * SS_XS_LD + pp * 2));
                    float y = yd[pb][r] + el * yo[pb][r] + D_h * xv;
                    if (live) { const float zv = bf2f(PROJ[grow * NPAD + PC_Z + h * 64 + pp]); y *= silu_f(zv); YZ[grow * 512 + h * 64 + pp] = y; sq += y * y; } }
                sq = group16_sum(sq);
                if (live && j16 == 0) SSQ[grow * 8 + h] = sq; }
        }
        __syncthreads();
#pragma unroll
        for (int pb = 0; pb < 4; ++pb)
#pragma unroll
            for (int r = 0; r < 4; ++r) *(LAS bf16_t*)(lds + SS_HB + (16 * pb + 4 * ig + r) * SS_LD + (16 * wid + j16) * 2) = f2bf(hs[pb][r]);
    }
    float* So = outp + (SAMPLE ? O_SSSM : O_PSSM) + (size_t)(bs * 8 + h) * 64 * 128;
#pragma unroll
    for (int pb = 0; pb < 4; ++pb)
#pragma unroll
        for (int r = 0; r < 4; ++r) So[(16 * pb + 4 * ig + r) * 128 + 16 * wid + j16] = hs[pb][r];
}

constexpr int U_SSDP = 32, U_SB = 256, U_DEC = DSEQ * NPAGES, U_MEMP = NBATCH * 8 * 4, U_SSDS = 64, U_MEMS = DSEQ * 4;
#define QUEUE_LOOP(qi, total, ...) for (;;) { __syncthreads(); if (threadIdx.x == 0) ctlw[16] = __hip_atomic_fetch_add(qbase + 64 * (qi), 1u, __ATOMIC_RELAXED, __HIP_MEMORY_SCOPE_AGENT); \
        __syncthreads(); const int u = (int)ctlw[16]; if (u >= (total)) break; __VA_ARGS__ }
__device__ __forceinline__ void phase3(const Params& p, LAS unsigned char* lds, volatile LAS unsigned* ctlw) {
    unsigned* qbase = (unsigned*)(p.ws + WS_CTL) + CW_QUEUE;
    const bf16_t* PROJ = (const bf16_t*)(p.ws + WS_PROJ);
    bf16_t* MIX = (bf16_t*)(p.ws + WS_MIX);
    QUEUE_LOOP(0, U_SSDP, { ssd_unit<false>(p.ws, p.out, p.in[I_ALOG], p.in[I_DTBIAS], p.in[I_DSKIP], p.in[I_SSM], p.in[I_SCONV], p.in[I_CONVW], p.in[I_CONVB], lds, u >> 3, u & 7); })
    if (blockIdx.x & 1) {
        QUEUE_LOOP(1, U_DEC, { decode_unit((const int*)p.in[I_PT], p.in[I_CK], p.in[I_CV], p.in[I_SBBIAS], p.ws, lds, u >> 7, u & 127); })
    }
    QUEUE_LOOP(2, U_SB, {
        const int i = 7 - (u >> 5), bh = u & 31, b = bh >> 3, h = bh & 7;
        attn_unit<0>(lds, PROJ + (size_t)(b * SEQ + i * 256) * NPAD + PC_Q + h * 128, NPAD,
                     PROJ + (size_t)(b * SEQ) * NPAD + PC_K + h * 128, PROJ + (size_t)(b * SEQ) * NPAD + PC_V + h * 128, NPAD,
                     4 * (i + 1), i * 256, 256, p.in[I_SBBIAS][h] * LOG2E,
                     PROJ + (size_t)(b * SEQ + i * 256) * NPAD + PC_GSB + h * 128, NPAD, MIX + (size_t)(b * SEQ + i * 256) * 2048 + h * 128, 2048); })
    QUEUE_LOOP(1, U_DEC, { decode_unit((const int*)p.in[I_PT], p.in[I_CK], p.in[I_CV], p.in[I_SBBIAS], p.ws, lds, u >> 7, u & 127); })
    QUEUE_LOOP(3, U_MEMP + U_MEMS, {
        if (u < U_MEMP) { const int hm = u & 3, qb = (u >> 2) & 7, b = u >> 5; const size_t r0 = (size_t)(b * SEQ + qb * 256);
            attn_unit<1>(lds, PROJ + r0 * NPAD + PC_MQ + hm * 128, NPAD, (const bf16_t*)(p.ws + WS_MKN) + (size_t)(b * MEMT) * 512 + hm * 128, (const bf16_t*)(p.ws + WS_MVB) + (size_t)(b * MEMT) * 512 + hm * 128, 512,
                         4, 0, 256, 0.f, PROJ + r0 * NPAD + PC_GM + hm * 128, NPAD, MIX + r0 * 2048 + 1536 + hm * 128, 2048); }
        else { const int v = u - U_MEMP, hm = v & 3, sq = v >> 2; const size_t r0 = (size_t)(MP + sq * DTOK);
            attn_unit<1>(lds, PROJ + r0 * NPAD + PC_MQ + hm * 128, NPAD, (const bf16_t*)(p.ws + WS_CMK) + (size_t)(sq * MEMT) * 512 + hm * 128, (const bf16_t*)(p.ws + WS_CMV) + (size_t)(sq * MEMT) * 512 + hm * 128, 512,
                         4, 0, DTOK, 0.f, PROJ + r0 * NPAD + PC_GM + hm * 128, NPAD, MIX + r0 * 2048 + 1536 + hm * 128, 2048); } })
    QUEUE_LOOP(4, U_SSDS, { ssd_unit<true>(p.ws, p.out, p.in[I_ALOG], p.in[I_DTBIAS], p.in[I_DSKIP], p.in[I_SSM], p.in[I_SCONV], p.in[I_CONVW], p.in[I_CONVB], lds, u >> 3, u & 7); })
}

__device__ __forceinline__ void phase4(const Params& p, int vcu, int G) {
    const int tid = threadIdx.x, lane = tid & 63, wave = __builtin_amdgcn_readfirstlane(tid >> 6);
    const int gw = vcu * 8 + wave, NGW = G * 8;
    bf16_t* MIX = (bf16_t*)(p.ws + WS_MIX); const float* YZ = (const float*)(p.ws + WS_YZ); const float* SSQ = (const float*)(p.ws + WS_SSQ);
    const bf16_t* PROJ = (const bf16_t*)(p.ws + WS_PROJ);
    f32x4 gw4[2]; gw4[0] = *(const f32x4*)(p.in[I_SSDNW] + lane * 8); gw4[1] = *(const f32x4*)(p.in[I_SSDNW] + lane * 8 + 4);
    for (int row = gw; row < MVALID; row += NGW) {
        const f32x4 s0 = *(const f32x4*)(SSQ + (size_t)row * 8), s1 = *(const f32x4*)(SSQ + (size_t)row * 8 + 4);
        const float ssq = ((s0.x + s0.y) + (s0.z + s0.w)) + ((s1.x + s1.y) + (s1.z + s1.w));
        const float rs = 1.f / sqrtf(ssq * (1.f / 512.f) + EPS);
        const f32x4 a = *(const f32x4*)(YZ + (size_t)row * 512 + lane * 8), b = *(const f32x4*)(YZ + (size_t)row * 512 + lane * 8 + 4);
        u32x4 o; o.x = cvtpk(a.x * rs * gw4[0].x, a.y * rs * gw4[0].y); o.y = cvtpk(a.z * rs * gw4[0].z, a.w * rs * gw4[0].w); o.z = cvtpk(b.x * rs * gw4[1].x, b.y * rs * gw4[1].y); o.w = cvtpk(b.z * rs * gw4[1].z, b.w * rs * gw4[1].w);
        *(u32x4*)(MIX + (size_t)row * 2048 + 1024 + lane * 8) = o;
    }
    for (int u = vcu; u < DSEQ * 8; u += G) {
        const int seq = u >> 3, head = u & 7, i = wave;
        const int row = MP + seq * DTOK + i;
        const float bias2 = p.in[I_SBBIAS][head] * LOG2E;
        const unsigned qw = *(const unsigned*)(PROJ + (size_t)row * NPAD + PC_Q + head * 128 + 2 * lane);
        const float q0 = bf_lo(qw), q1 = bf_hi(qw);
        float acc0 = 0.f, acc1 = 0.f, R = 1.f;
        for (int j = DTOK - 1; j >= 0; --j) {
            const f32x2 kv = *(const f32x2*)(p.out + O_SK + (size_t)(seq * DTOK + j) * 1024 + head * 128 + 2 * lane);
            const float kb0 = bf2f(f2bf(kv.x)), kb1 = bf2f(f2bf(kv.y));
            const float z = fmaxf(wave_sum(q0 * kb0 + q1 * kb1) + bias2, -100.f);
            if (j < i) {
                const float e = fast_exp2(-z), rc = fast_rcp(1.f + e);
                const f32x2 vv = *(const f32x2*)(p.out + O_SV + (size_t)(seq * DTOK + j) * 1024 + head * 128 + 2 * lane);
                const float w = rc * R; acc0 += w * vv.x; acc1 += w * vv.y; R *= e * rc;
            }
        }
        const float* Op = (const float*)(p.ws + WS_OPART) + (size_t)((seq * 8 + head) * NPAGES) * (DTOK * 128) + i * 128 + 2 * lane;
        const float* Fp = (const float*)(p.ws + WS_FPART) + (size_t)((seq * 8 + head) * NPAGES) * DTOK + i;
        for (int pg = NPAGES - 1; pg >= 0; --pg) {
            const f32x2 ov = *(const f32x2*)(Op + (size_t)pg * (DTOK * 128));
            acc0 += R * ov.x; acc1 += R * ov.y; R *= Fp[(size_t)pg * DTOK];
        }
        const unsigned gwd = *(const unsigned*)(PROJ + (size_t)row * NPAD + PC_GSB + head * 128 + 2 * lane);
        *(unsigned*)(MIX + (size_t)row * 2048 + head * 128 + 2 * lane) = cvtpk(acc0 * silu_f(bf_lo(gwd)), acc1 * silu_f(bf_hi(gwd)));
    }
}

struct Epi5 {
    const float* xp; const float* xs; float* out;
    __device__ __forceinline__ void operator()(const pg8::Acc& acc, const pg8::Unit& u, int wr, int wc, int fr, int fq) const {
        int rl0 = wr * 64 + fr, cl0 = u.pn * 256 + wc * 32 + 4 * fq;
        asm volatile("" : "+v"(rl0), "+v"(cl0));
        const float* xb = u.pm < 32 ? xp + (size_t)u.pm * 256 * DM : xs; float* ob = u.pm < 32 ? out + O_YP + (size_t)u.pm * 256 * DM : out + O_YS; const int valid = u.pm < 32 ? 256 : MS;
#pragma unroll
        for (int ai = 0; ai < 2; ++ai)
#pragma unroll
            for (int m = 0; m < 4; ++m) { const int row = rl0 + ai * 128 + m * 16; if (row < valid) { const float* xr = xb + (size_t)row * DM + cl0; float* orow = ob + (size_t)row * DM + cl0;
#pragma unroll
                for (int bj = 0; bj < 2; ++bj)
#pragma unroll
                    for (int n = 0; n < 2; ++n) *(f32x4*)(orow + bj * 128 + n * 16) = *(const f32x4*)(xr + bj * 128 + n * 16) + acc[ai][bj][m][n]; } }
    }
};

constexpr int NPHASE = 6;
__global__ void __launch_bounds__(512, 2) hymba_fwd(Params p) {
    extern __shared__ __attribute__((aligned(16))) unsigned char lds_raw[];
    LAS unsigned char* lds = (LAS unsigned char*)lds_raw;
    const int tid = threadIdx.x;
    const int G = gridDim.x; const int bx = blockIdx.x; const int vcu = (G % 8 == 0) ? (bx % 8) * (G / 8) + bx / 8 : bx;
    volatile LAS unsigned* ctlw = (volatile LAS unsigned*)(lds + LDS_CTLW);
    if (tid < 64) ctlw[tid] = 0u;
    __syncthreads();
    unsigned* ctl = (unsigned*)(p.ws + WS_CTL);
    const int lo = p.ph_lo, hi = p.ph_hi;
    XcdBarrier bar; bar.bar = ctl + CW_BAR; bar.x = 0; bar.st = nullptr;
    if (hi - lo > 1) bar = xcd_barrier_post(ctl + CW_BAR, ctlw + 8);
#define IN(k) (lo <= (k) && (k) < hi)
#define BOTH(k) (IN(k) && IN((k) + 1))
    if (IN(0)) { phase0(p, lds, vcu, G); if (BOTH(0)) xcd_barrier(bar); }
    if (IN(1)) {
        pg8::Gemm g{(const bf16_t*)(p.ws + WS_H), (const bf16_t*)(p.ws + WS_WIN), (const bf16_t*)(p.ws + WS_HM), (const bf16_t*)(p.ws + WS_WM), DM};
        pg8::Order S; S.init(MROWS / 256, NPAD / 256, MMEM / 256, 1024 / 256, G, bx);
        Epi1 E{(bf16_t*)(p.ws + WS_PROJ), (float*)(p.ws + WS_DT), p.out};
        pg8::gemm_phase<Epi1>(lds, g, S, E);
        if (BOTH(1)) xcd_barrier(bar);
    }
    if (IN(2)) { phase2(p, vcu, G); if (BOTH(2)) xcd_barrier(bar); }
    if (IN(3)) { phase3(p, lds, ctlw); if (BOTH(3)) xcd_barrier(bar); }
    if (IN(4)) { phase4(p, vcu, G); if (BOTH(4)) xcd_barrier(bar); }
    if (IN(5)) {
        pg8::Gemm g{(const bf16_t*)(p.ws + WS_MIX), (const bf16_t*)(p.ws + WS_WOUT), nullptr, nullptr, DM};
        pg8::Order S; S.init(MROWS / 256, DM / 256, 0, 1, G, bx);
        Epi5 E{p.in[I_XP], p.in[I_XS], p.out};
        pg8::gemm_phase<Epi5>(lds, g, S, E);
    }
#undef IN
#undef BOTH
}

extern "C" void kernel_launch(void* const* d_in, const int* in_sizes, int n_in, void* d_out, int out_size, void* d_ws, size_t ws_size, hipStream_t stream) {
    static int grid = 0;
    if (grid == 0) {
        if (n_in != 26 || ws_size < WS_END) { fprintf(stderr, "kernel_launch: unexpected n_in %d / ws %zu\n", n_in, ws_size); grid = -1; return; }
        int dev = 0, cus = 0, per_cu = 0;
        if (hipGetDevice(&dev) != hipSuccess || hipDeviceGetAttribute(&cus, hipDeviceAttributeMultiprocessorCount, dev) != hipSuccess) { grid = -1; return; }
        if (hipFuncSetAttribute((const void*)hymba_fwd, hipFuncAttributeMaxDynamicSharedMemorySize, LDS_BYTES) != hipSuccess) { fprintf(stderr, "kernel_launch: hipFuncSetAttribute failed\n"); grid = -1; return; }
        if (hipOccupancyMaxActiveBlocksPerMultiprocessor(&per_cu, (const void*)hymba_fwd, 512, LDS_BYTES) != hipSuccess || per_cu < 1) fprintf(stderr, "kernel_launch: occupancy query says %d\n", per_cu);
        (void)hipGetLastError();
        grid = cus;
    }
    if (grid < 0) return;
    (void)hipMemsetAsync((char*)d_ws + WS_CTL, 0, CTL_BYTES, stream);
    Params p{};
    for (int i = 0; i < 26; ++i) p.in[i] = (const float*)d_in[i];
    p.out = (float*)d_out; p.ws = (unsigned char*)d_ws;
    if (MK_N_LAUNCHES == 1) { p.ph_lo = 0; p.ph_hi = NPHASE; hipLaunchKernelGGL(hymba_fwd, dim3(grid), dim3(512), LDS_BYTES, stream, p); }
    else for (int ph = 0; ph < NPHASE; ++ph) { p.ph_lo = ph; p.ph_hi = ph + 1; hipLaunchKernelGGL(hymba_fwd, dim3(grid), dim3(512), LDS_BYTES, stream, p); }
    const hipError_t le = hipPeekAtLastError();
    if (le != hipSuccess) fprintf(stderr, "kernel_launch: launch failed: %s\n", hipGetErrorName(le));
}
```

```cpp
#include <hip/hip_runtime.h>
#include <cstdio>
#include <cstdint>

#ifndef MK_N_LAUNCHES
#define MK_N_LAUNCHES 1
#endif

constexpr int DM = 2048, NBATCH = 4, SEQ = 2048, MP = NBATCH * SEQ;
constexpr int DSEQ = 8, DTOK = 8, MS = DSEQ * DTOK;
constexpr int MVALID = MP + MS, MROWS = 8448;
constexpr int NIN = 6664, NPAD = 6912;
constexpr int MEMT = 256, MMEM = NBATCH * MEMT;
constexpr int NPAGES = 128, PAGE = 128, PAST = NPAGES * PAGE;
constexpr float EPS = 1e-6f;
constexpr float LOG2E = 1.4426950408889634f;
constexpr float QSCALE = 0.08838834764831845f * LOG2E;

constexpr size_t O_YP = 0, O_YS = 16777216, O_PK = 16908288, O_PV = 25296896, O_PSSM = 33685504, O_PCONV = 33947648,
                 O_PMK = 33959936, O_PMV = 34484224, O_SK = 35008512, O_SV = 35074048, O_SSSM = 35139584, O_SCONV = 35663872;

constexpr size_t MiB = 1u << 20;
constexpr size_t WS_CTL = 0, CTL_BYTES = 1 * MiB;
constexpr size_t WS_WIN = 2 * MiB;
constexpr size_t WS_WM = 32 * MiB;
constexpr size_t WS_WOUT = 38 * MiB;
constexpr size_t WS_H = 48 * MiB;
constexpr size_t WS_HM = 84 * MiB;
constexpr size_t WS_PROJ = 90 * MiB;
constexpr int PC_Q = 0, PC_K = 1024, PC_V = 2048, PC_GSB = 3072, PC_Z = 4096, PC_XBC = 4608, PC_MQ = 5632, PC_GM = 6144;
constexpr size_t WS_DT = 210 * MiB;
constexpr size_t WS_MKN = 211 * MiB;
constexpr size_t WS_MVB = 213 * MiB;
constexpr size_t WS_CMK = 215 * MiB;
constexpr size_t WS_CMV = 218 * MiB;
constexpr size_t WS_SSQ = 221 * MiB;
constexpr size_t WS_FPART = 222 * MiB;
constexpr size_t WS_MIX = 224 * MiB;
constexpr size_t WS_YZ = 260 * MiB;
constexpr size_t WS_OPART = 280 * MiB;
constexpr size_t WS_END = 316 * MiB;

constexpr int CW_BAR = 4096;
constexpr int CW_QUEUE = 64;

constexpr int LDS_BYTES = 163840;
constexpr int RING_BYTES = 131072;
constexpr int LDS_CTLW = LDS_BYTES - 256;

#define LAS __attribute__((address_space(3)))
typedef unsigned short bf16_t;
typedef short bf16x8 __attribute__((ext_vector_type(8)));
typedef short s16x4 __attribute__((ext_vector_type(4)));
typedef float f32x2 __attribute__((ext_vector_type(2)));
typedef float f32x4 __attribute__((ext_vector_type(4)));
typedef float f32x16 __attribute__((ext_vector_type(16)));
typedef unsigned u32x2 __attribute__((ext_vector_type(2)));
typedef unsigned u32x4 __attribute__((ext_vector_type(4)));

__device__ __forceinline__ unsigned cvtpk(float lo, float hi) { unsigned r; asm volatile("v_cvt_pk_bf16_f32 %0, %1, %2" : "=v"(r) : "v"(lo), "v"(hi)); return r; }
__device__ __forceinline__ float bf_lo(unsigned w) { return __uint_as_float(w << 16); }
__device__ __forceinline__ float bf_hi(unsigned w) { return __uint_as_float(w & 0xffff0000u); }
__device__ __forceinline__ float bf2f(bf16_t b) { return __uint_as_float(((unsigned)b) << 16); }
__device__ __forceinline__ bf16_t f2bf(float f) { return (bf16_t)(cvtpk(f, 0.f) & 0xffffu); }
__device__ __forceinline__ float wave_sum(float v) {
#pragma unroll
    for (int o = 1; o < 64; o <<= 1) v += __shfl_xor(v, o);
    return v;
}
__device__ __forceinline__ float fast_exp2(float x) { return __builtin_amdgcn_exp2f(x); }
__device__ __forceinline__ float fast_rcp(float x) { return __builtin_amdgcn_rcpf(x); }
__device__ __forceinline__ float silu_f(float x) { return x * fast_rcp(1.f + fast_exp2(-x * LOG2E)); }

#define XB_TMO      128
#define XB_XCNT(j)  (256  + 64 * (j))
#define XB_XSUB(j)  (1280 + 64 * (j))
#define XB_XGEN(j)  (2304 + 64 * (j))
#define XB_TOP      3328
#define XB_TOPGEN   3392
#define XCD_BAR_WORDS 3456
#define XB_SPIN_CAP (1u << 18)

__device__ __forceinline__ unsigned xb_ld(unsigned* p)              { return __hip_atomic_load(p, __ATOMIC_RELAXED, __HIP_MEMORY_SCOPE_AGENT); }
__device__ __forceinline__ unsigned xb_add(unsigned* p, unsigned v) { return __hip_atomic_fetch_add(p, v, __ATOMIC_RELAXED, __HIP_MEMORY_SCOPE_AGENT); }
__device__ __forceinline__ unsigned xb_xcc_id() { return (unsigned)__builtin_amdgcn_s_getreg((3 << 11) | 20) & 0xFu; }
#define XB_SPIN(cond, bar) do { unsigned _sp = 0; while (cond) { __builtin_amdgcn_s_sleep(1); \
    if ((++_sp & 255u) == 0u) { if (xb_ld(&(bar)[XB_TMO])) break; if (_sp > XB_SPIN_CAP) { atomicAdd(&(bar)[XB_TMO], 1u); break; } } } } while (0)

struct XcdBarrier { unsigned* bar; unsigned x; volatile LAS unsigned* st; };

__device__ __forceinline__ XcdBarrier xcd_barrier_post(unsigned* bar, volatile LAS unsigned* st) {
    XcdBarrier b; b.bar = bar; b.x = xb_xcc_id(); b.st = st;
    if (threadIdx.x == 0) (void)xb_add(&bar[XB_XCNT(b.x)], 1u);
    return b;
}
__device__ __forceinline__ void xcd_barrier_complete(unsigned* bar, unsigned x, unsigned& nloc, unsigned& nx) {
    const unsigned G = gridDim.x * gridDim.y * gridDim.z;
    unsigned sum, cnt, mine, sp = 0u;
    for (;;) {
        sum = 0u; cnt = 0u; mine = 0u;
#pragma unroll
        for (unsigned j = 0; j < 16; ++j) { const unsigned c = xb_ld(&bar[XB_XCNT(j)]); sum += c; cnt += (c > 0u) ? 1u : 0u; mine = (j == x) ? c : mine; }
        if (sum == G) break;
        __builtin_amdgcn_s_sleep(1);
        if ((++sp & 255u) == 0u) { if (xb_ld(&bar[XB_TMO])) break; if (sp > XB_SPIN_CAP) { atomicAdd(&bar[XB_TMO], 1u); break; } }
    }
    nloc = mine > 0u ? mine : 1u; nx = cnt > 0u ? cnt : 1u;
}
__device__ __forceinline__ void xcd_barrier(const XcdBarrier& b) {
    asm volatile("s_waitcnt vmcnt(0)" ::: "memory");
    __syncthreads();
    if (threadIdx.x == 0) {
        unsigned* bar = b.bar;
        __builtin_amdgcn_s_waitcnt(0);
        unsigned nloc = b.st[0], nx = b.st[1];
        if (nloc == 0u) { xcd_barrier_complete(bar, b.x, nloc, nx); b.st[0] = nloc; b.st[1] = nx; }
        const unsigned old = xb_add(&bar[XB_XSUB(b.x)], 1u);
        const unsigned gen = old / nloc;
        if (old + 1u == (gen + 1u) * nloc) {
            __builtin_amdgcn_fence(__ATOMIC_RELEASE, "agent");
            asm volatile("s_waitcnt vmcnt(0)" ::: "memory");
            const unsigned og = xb_add(&bar[XB_TOP], 1u);
            const unsigned tg = og / nx;
            if (og + 1u == (tg + 1u) * nx) xb_add(&bar[XB_TOPGEN], 1u);
            else XB_SPIN(xb_ld(&bar[XB_TOPGEN]) == tg, bar);
            __builtin_amdgcn_fence(__ATOMIC_ACQUIRE, "agent");
            xb_add(&bar[XB_XGEN(b.x)], 1u);
            asm volatile("s_waitcnt vmcnt(0)" ::: "memory");
        } else {
            XB_SPIN(xb_ld(&bar[XB_XGEN(b.x)]) == gen, bar);
            __builtin_amdgcn_fence(__ATOMIC_ACQUIRE, "agent");
            asm volatile("s_waitcnt vmcnt(0)" ::: "memory");
        }
    }
    __syncthreads();
}

namespace pg8 {
constexpr int BM = 256, BK = 64, HALF = 128, HTB = HALF * BK * 2, STAGE_BYTES = 8 * HTB, NXCD = 8, WGM = 8;
__host__ __device__ __forceinline__ int lds_byte(int r, int c) { const int st = (r >> 4) * 2 + (c >> 5), rr = r & 15, cc = c & 31, ob = rr * 64 + cc * 2; return st * 1024 + (ob ^ (((ob >> 9) & 1) << 5)); }
__host__ __device__ __forceinline__ void stage_rc(int b, int& R, int& C) { const int st = b / 1024, sb = b % 1024, swz = sb ^ (((sb >> 9) & 1) << 5); R = (st >> 1) * 16 + swz / 64; C = (st & 1) * 32 + (swz % 64) / 2; }

struct Unit { int pm, pn, sel; };
struct Gemm { const bf16_t* A0; const bf16_t* B0; const bf16_t* A1; const bf16_t* B1; int K; };

struct Order {
    int nM, nN, nwg, n1M, n1N, G, c;
    __device__ void init(int nM_, int nN_, int n1M_, int n1N_, int G_, int c_) { nM = nM_; nN = nN_; nwg = nM * nN; n1M = n1M_; n1N = n1N_; G = G_; c = c_; }
    __device__ bool next(int i, Unit& u) const {
        const long L = (long)i * G + c;
        if (L >= nwg + n1M * n1N) return false;
        if (L >= nwg) { const int r = (int)L - nwg; u.pm = r / n1N; u.pn = r % n1N; u.sel = 1; return true; }
        int wgid = (int)L; { const int q = nwg / NXCD, r = nwg % NXCD, xcd = wgid % NXCD, off = wgid / NXCD; wgid = (xcd < r ? xcd * (q + 1) : r * (q + 1) + (xcd - r) * q) + off; }
        const int nig = WGM * nN, gid = wgid / nig, fm = gid * WGM, gsz = (nM - fm) < WGM ? (nM - fm) : WGM;
        u.pm = fm + ((wgid % nig) % gsz); u.pn = (wgid % nig) / gsz; u.sel = 0; return true;
    }
};

template <class Epi>
__device__ __forceinline__ void gemm_phase(LAS unsigned char* lds, const Gemm g, const Order& S, const Epi& E) {
    const int tid = threadIdx.x, wid = __builtin_amdgcn_readfirstlane(tid >> 6), lane = tid & 63, wr = wid >> 2, wc = wid & 3, fr = lane & 15, fq = lane >> 4;
    const int K = g.K, nt = K / BK;
    unsigned voffA[2];
#pragma unroll
    for (int i = 0; i < 2; ++i) { int R, C; stage_rc(tid * 16 + i * 8192, R, C); voffA[i] = (unsigned)(R * K + C) * 2u; }
    const size_t kstep = (size_t)(BK * 2);
    const size_t hstep = (size_t)HALF * K * 2;
    const size_t tstep = 2 * hstep;
    const unsigned ldsw = (unsigned)wid * 1024u;
    const int aoff = lds_byte(wr * 64 + fr, fq * 8), boff = lds_byte(wc * 32 + fr, fq * 8);
#define PG8_SA(b, h) (((b) * 2 + (h)) * HTB)
#define PG8_SB(b, h) ((4 + (b) * 2 + (h)) * HTB)
#define PG8_STAGE(bufoff, gbase) do { _Pragma("unroll") for (int _i = 0; _i < 2; ++_i) \
        __builtin_amdgcn_global_load_lds((const unsigned*)((const char*)(gbase) + voffA[_i]), (LAS unsigned*)(lds + (bufoff) + ldsw + _i * 8192), 16, 0, 0); } while (0)
#define PG8_LDA(dst, b, h) do { _Pragma("unroll") for (int m = 0; m < 4; ++m) _Pragma("unroll") for (int k = 0; k < 2; ++k) dst[m][k] = *(const LAS bf16x8*)(lds + PG8_SA(b, h) + aoff + m * 2048 + k * 1024); } while (0)
#define PG8_LDB(dst, b, h) do { _Pragma("unroll") for (int n = 0; n < 2; ++n) _Pragma("unroll") for (int k = 0; k < 2; ++k) dst[n][k] = *(const LAS bf16x8*)(lds + PG8_SB(b, h) + boff + n * 2048 + k * 1024); } while (0)
#define PG8_MMA(ai, bj, At, Bt) do { __builtin_amdgcn_s_setprio(1); _Pragma("unroll") for (int m = 0; m < 4; ++m) _Pragma("unroll") for (int n = 0; n < 2; ++n) _Pragma("unroll") for (int k = 0; k < 2; ++k) \
        acc[ai][bj][m][n] = __builtin_amdgcn_mfma_f32_16x16x32_bf16(Bt[n][k], At[m][k], acc[ai][bj][m][n], 0, 0, 0); __builtin_amdgcn_s_setprio(0); } while (0)
#define PG8_WAIT_V(n) asm volatile("s_waitcnt vmcnt(" #n ")" ::: "memory")
#define PG8_WAIT_L(n) asm volatile("s_waitcnt lgkmcnt(" #n ")" ::: "memory")
#define PG8_BAR __builtin_amdgcn_s_barrier()
#define PG8_SCHED __builtin_amdgcn_sched_barrier(0)
    Unit cur, nxt; int ui = 0;
    if (!S.next(0, cur)) return;
    f32x4 acc[2][2][4][2];
#pragma unroll
    for (int a = 0; a < 2; ++a)
#pragma unroll
        for (int b = 0; b < 2; ++b)
#pragma unroll
            for (int m = 0; m < 4; ++m)
#pragma unroll
                for (int n = 0; n < 2; ++n) acc[a][b][m][n] = (f32x4){0.f, 0.f, 0.f, 0.f};
    bf16x8 At[4][2], B0[2][2], B1[2][2];
    const char* cA = (const char*)(cur.sel ? g.A1 : g.A0) + (size_t)cur.pm * tstep; const char* cB = (const char*)(cur.sel ? g.B1 : g.B0) + (size_t)cur.pn * tstep;
    PG8_STAGE(PG8_SB(0, 0), cB); PG8_STAGE(PG8_SB(0, 1), cB + hstep); PG8_STAGE(PG8_SA(0, 0), cA); PG8_STAGE(PG8_SA(0, 1), cA + hstep);
    if (wr == 1) PG8_BAR;
    PG8_WAIT_V(2); PG8_BAR;
    PG8_STAGE(PG8_SB(1, 0), cB + kstep); PG8_STAGE(PG8_SA(1, 0), cA + kstep); PG8_STAGE(PG8_SB(1, 1), cB + hstep + kstep);
    PG8_WAIT_V(6); PG8_BAR;
    for (;;) {
        const bool has_next = S.next(ui + 1, nxt);
        const char* nA = has_next ? (const char*)(nxt.sel ? g.A1 : g.A0) + (size_t)nxt.pm * tstep : cA; const char* nB = has_next ? (const char*)(nxt.sel ? g.B1 : g.B0) + (size_t)nxt.pn * tstep : cB;
        for (int t = 0; t < nt; t += 2) {
            const bool last = (t == nt - 2);
            const char* a1 = cA + (size_t)(t + 1) * kstep;
            const char* a2 = last ? nA : cA + (size_t)(t + 2) * kstep; const char* b2 = last ? nB : cB + (size_t)(t + 2) * kstep;
            const char* a3 = a2 + kstep; const char* b3 = b2 + kstep;
            PG8_LDB(B0, 0, 0); PG8_LDB(B1, 0, 1); PG8_SCHED; PG8_LDA(At, 0, 0); PG8_STAGE(PG8_SA(1, 1), a1 + hstep);
            PG8_WAIT_V(8); PG8_WAIT_L(0); PG8_BAR; PG8_MMA(0, 0, At, B0); PG8_MMA(0, 1, At, B1); PG8_BAR; PG8_SCHED;
            PG8_LDA(At, 0, 1); PG8_STAGE(PG8_SB(0, 0), b2); PG8_STAGE(PG8_SB(0, 1), b2 + hstep); PG8_STAGE(PG8_SA(0, 0), a2);
            PG8_WAIT_V(8); PG8_WAIT_L(0); PG8_BAR; PG8_MMA(1, 0, At, B0); PG8_MMA(1, 1, At, B1); PG8_BAR; PG8_SCHED;
            PG8_LDB(B0, 1, 0); PG8_LDB(B1, 1, 1); PG8_SCHED; PG8_LDA(At, 1, 0); PG8_STAGE(PG8_SA(0, 1), a2 + hstep);
            PG8_WAIT_V(8); PG8_WAIT_L(0); PG8_BAR; PG8_MMA(0, 0, At, B0); PG8_MMA(0, 1, At, B1); PG8_BAR; PG8_SCHED;
            PG8_LDA(At, 1, 1); PG8_STAGE(PG8_SB(1, 0), b3); PG8_STAGE(PG8_SB(1, 1), b3 + hstep); PG8_STAGE(PG8_SA(1, 0), a3);
            PG8_WAIT_V(8); PG8_WAIT_L(0); PG8_BAR; PG8_MMA(1, 0, At, B0); PG8_MMA(1, 1, At, B1); PG8_BAR; PG8_SCHED;
        }
        if (wr == 0) PG8_BAR;
        E(acc, cur, wr, wc, fr, fq);
        if (!has_next) break;
#pragma unroll
        for (int a = 0; a < 2; ++a)
#pragma unroll
            for (int b = 0; b < 2; ++b)
#pragma unroll
                for (int m = 0; m < 4; ++m)
#pragma unroll
                    for (int n = 0; n < 2; ++n) acc[a][b][m][n] = (f32x4){0.f, 0.f, 0.f, 0.f};
        cur = nxt; cA = nA; cB = nB; ++ui;
        if (wr == 1) PG8_BAR;
    }
    PG8_WAIT_V(0);
    PG8_BAR;
#undef PG8_SA
#undef PG8_SB
#undef PG8_STAGE
#undef PG8_LDA
#undef PG8_LDB
#undef PG8_MMA
#undef PG8_WAIT_V
#undef PG8_WAIT_L
#undef PG8_BAR
#undef PG8_SCHED
}
typedef f32x4 Acc[2][2][4][2];
__device__ __forceinline__ void store_f32(const Acc& acc, float* base, int ld, int rl0, int cl0, int valid) {
#pragma unroll
    for (int ai = 0; ai < 2; ++ai)
#pragma unroll
        for (int m = 0; m < 4; ++m) { const int row = rl0 + ai * HALF + m * 16; if (row < valid) { float* rp = base + (size_t)row * ld + cl0;
#pragma unroll
            for (int bj = 0; bj < 2; ++bj)
#pragma unroll
                for (int n = 0; n < 2; ++n) *(f32x4*)(rp + bj * HALF + n * 16) = acc[ai][bj][m][n]; } }
}
__device__ __forceinline__ void store_bf16(const Acc& acc, bf16_t* base, int ld, int rl0, int cl0) {
#pragma unroll
    for (int ai = 0; ai < 2; ++ai)
#pragma unroll
        for (int m = 0; m < 4; ++m) { const int row = rl0 + ai * HALF + m * 16; bf16_t* rp = base + (size_t)row * ld + cl0;
#pragma unroll
            for (int bj = 0; bj < 2; ++bj)
#pragma unroll
                for (int n = 0; n < 2; ++n) { const f32x4 a = acc[ai][bj][m][n]; u32x2 w; w.x = cvtpk(a[0], a[1]); w.y = cvtpk(a[2], a[3]); *(u32x2*)(rp + bj * HALF + n * 16) = w; } }
}
}

struct Params {
    const float* in[26];
    float* out;
    unsigned char* ws;
    int ph_lo, ph_hi;
};
enum { I_XP = 0, I_XS, I_CK, I_CV, I_SSM, I_SCONV, I_CMK, I_CMV, I_PT, I_MEM, I_NORMW, I_WIN, I_QNORM, I_KNORM, I_SBBIAS, I_CONVW, I_CONVB, I_DTBIAS, I_ALOG, I_DSKIP,
       I_SSDNW, I_MEMNW, I_WMEM, I_MQNORM, I_MKNORM, I_WOUT };

template <int MAP>
__device__ __forceinline__ void p0_transpose_item(const float* W, int K, int Nsrc, int N, bf16_t* WT, LAS float* scr, int item, int lane) {
    const int nblk = N / 32, kb = item / nblk, nb = item % nblk, k0 = 64 * kb, n0 = 32 * nb;
    const int nd = n0 + (lane & 31);
    int ns = nd; bool ok = true;
    if (MAP == 1) { if (nd < 5632) ns = nd; else if (nd < 6656) ns = nd + 8; else if (nd < 6664) ns = nd - 1024; else { ns = 0; ok = false; } }
#pragma unroll 8
    for (int i = 0; i < 32; ++i) { const int kk = 2 * i + (lane >> 5); scr[kk * 33 + (lane & 31)] = ok ? W[(size_t)(k0 + kk) * Nsrc + ns] : 0.f; }
    asm volatile("s_waitcnt lgkmcnt(0)" ::: "memory");
    const int c = lane & 7;
#pragma unroll
    for (int j = 0; j < 4; ++j) { const int n = (lane >> 3) + 8 * j; const LAS float* s = scr + (8 * c) * 33 + n;
        u32x4 o; o.x = cvtpk(s[0 * 33], s[1 * 33]); o.y = cvtpk(s[2 * 33], s[3 * 33]); o.z = cvtpk(s[4 * 33], s[5 * 33]); o.w = cvtpk(s[6 * 33], s[7 * 33]);
        *(u32x4*)(WT + (size_t)(n0 + n) * K + k0 + 8 * c) = o; }
    asm volatile("s_waitcnt lgkmcnt(0)" ::: "memory");
}
__device__ __forceinline__ void rms_row_to_bf16(const float* xrow, const float* gain, bf16_t* orow, int lane) {
    const f32x4* xr = (const f32x4*)xrow + lane; const f32x4* gr = (const f32x4*)gain + lane;
    f32x4 v[8]; float s = 0.f;
#pragma unroll
    for (int j = 0; j < 8; ++j) { v[j] = xr[64 * j]; s += (v[j].x * v[j].x + v[j].y * v[j].y) + (v[j].z * v[j].z + v[j].w * v[j].w); }
    const float rs = 1.f / sqrtf(wave_sum(s) * (1.f / DM) + EPS);
    u32x2* o8 = (u32x2*)orow + lane;
#pragma unroll
    for (int j = 0; j < 8; ++j) { const f32x4 g = gr[64 * j]; u32x2 w; w.x = cvtpk(v[j].x * rs * g.x, v[j].y * rs * g.y); w.y = cvtpk(v[j].z * rs * g.z, v[j].w * rs * g.w); o8[64 * j] = w; }
}
__device__ __forceinline__ void phase0(const Params& p, LAS unsigned char* lds, int vcu, int G) {
    const int tid = threadIdx.x, lane = tid & 63, wave = __builtin_amdgcn_readfirstlane(tid >> 6);
    LAS float* scr = (LAS float*)(lds + wave * 16384);
    const int gw = vcu * 8 + wave, NGW = G * 8;
    bf16_t* WinT = (bf16_t*)(p.ws + WS_WIN); bf16_t* WmT = (bf16_t*)(p.ws + WS_WM); bf16_t* WoutT = (bf16_t*)(p.ws + WS_WOUT);
    constexpr int I_IN = (DM / 64) * (NPAD / 32), I_M = (DM / 64) * (1024 / 32), I_O = (DM / 64) * (DM / 32);
    for (int it = gw; it < I_IN + I_M + I_O; it += NGW) {
        int r = it;
        if (r < I_IN) { p0_transpose_item<1>(p.in[I_WIN], DM, NIN, NPAD, WinT, scr, r, lane); continue; } r -= I_IN;
        if (r < I_M) { p0_transpose_item<0>(p.in[I_WMEM], DM, 1024, 1024, WmT, scr, r, lane); continue; } r -= I_M;
        p0_transpose_item<0>(p.in[I_WOUT], DM, DM, DM, WoutT, scr, r, lane);
    }
    bf16_t* H = (bf16_t*)(p.ws + WS_H); bf16_t* HM = (bf16_t*)(p.ws + WS_HM);
    for (int m = gw; m < MVALID + MMEM; m += NGW) {
        if (m < MP) rms_row_to_bf16(p.in[I_XP] + (size_t)m * DM, p.in[I_NORMW], H + (size_t)m * DM, lane);
        else if (m < MVALID) rms_row_to_bf16(p.in[I_XS] + (size_t)(m - MP) * DM, p.in[I_NORMW], H + (size_t)m * DM, lane);
        else rms_row_to_bf16(p.in[I_MEM] + (size_t)(m - MVALID) * DM, p.in[I_MEMNW], HM + (size_t)(m - MVALID) * DM, lane);
    }
    const int gt = vcu * 512 + tid, NGT = G * 512;
    u32x4* cmk = (u32x4*)(p.ws + WS_CMK); u32x4* cmv = (u32x4*)(p.ws + WS_CMV);
    constexpr int N8 = DSEQ * MEMT * 512 / 8;
    for (int i = gt; i < 2 * N8; i += NGT) { const bool isk = i < N8; const int j = isk ? i : i - N8; const f32x4* s = (const f32x4*)(isk ? p.in[I_CMK] : p.in[I_CMV]) + 2 * (size_t)j;
        const f32x4 a = s[0], b = s[1]; u32x4 o; o.x = cvtpk(a.x, a.y); o.y = cvtpk(a.z, a.w); o.z = cvtpk(b.x, b.y); o.w = cvtpk(b.z, b.w); (isk ? cmk : cmv)[j] = o; }
}

struct Epi1 {
    bf16_t* PROJ; float* DT; float* out;
    __device__ __forceinline__ void operator()(const pg8::Acc& acc, const pg8::Unit& u, int wr, int wc, int fr, int fq) const {
        int rl0 = wr * 64 + fr, cl0 = wc * 32 + 4 * fq;
        asm volatile("" : "+v"(rl0), "+v"(cl0));
        const int pn = u.pn; const size_t r0 = (size_t)u.pm * 256;
        float* fbase = nullptr; int fld = 1024, valid = 256;
        if (u.sel == 1) { fbase = out + (pn < 2 ? O_PMK : O_PMV) + r0 * 512 + (pn & 1) * 256; fld = 512; }
        else if (pn >= 4 && pn < 12) {
            if (u.pm < 32) fbase = out + (pn < 8 ? O_PK : O_PV) + r0 * 1024 + (pn & 3) * 256;
            else { fbase = out + (pn < 8 ? O_SK : O_SV) + (pn & 3) * 256; valid = MS; } }
        if (fbase) pg8::store_f32(acc, fbase, fld, rl0, cl0, valid);
        if (u.sel == 0) {
            pg8::store_bf16(acc, PROJ + r0 * NPAD + pn * 256, NPAD, rl0, cl0);
            if (pn == 26 && wc == 0 && fq < 2) {
#pragma unroll
                for (int ai = 0; ai < 2; ++ai)
#pragma unroll
                    for (int m = 0; m < 4; ++m) { const int row = rl0 + ai * 128 + m * 16; *(f32x4*)(DT + (r0 + row) * 8 + 4 * fq) = acc[ai][0][m][0]; } }
        }
    }
};

__device__ __forceinline__ float group16_sum(float v) { v += __shfl_xor(v, 1); v += __shfl_xor(v, 2); v += __shfl_xor(v, 4); v += __shfl_xor(v, 8); return v; }
__device__ __forceinline__ void phase2(const Params& p, int vcu, int G) {
    const int tid = threadIdx.x, lane = tid & 63, wave = __builtin_amdgcn_readfirstlane(tid >> 6);
    const int gw = vcu * 8 + wave, NGW = G * 8;
    const int sub = lane & 15, grp = lane >> 4;
    bf16_t* PROJ = (bf16_t*)(p.ws + WS_PROJ);
    bf16_t* MKn = (bf16_t*)(p.ws + WS_MKN); bf16_t* MVb = (bf16_t*)(p.ws + WS_MVB);
    f32x4 gq[2], gk[2], gmq[2], gmk[2];
#pragma unroll
    for (int j = 0; j < 2; ++j) { gq[j] = *(const f32x4*)(p.in[I_QNORM] + sub * 8 + 4 * j) * QSCALE; gk[j] = *(const f32x4*)(p.in[I_KNORM] + sub * 8 + 4 * j);
                                  gmq[j] = *(const f32x4*)(p.in[I_MQNORM] + sub * 8 + 4 * j) * QSCALE; gmk[j] = *(const f32x4*)(p.in[I_MKNORM] + sub * 8 + 4 * j); }
    for (int row = gw; row < MVALID + MMEM; row += NGW) {
        if (row < MVALID) {
#pragma unroll
            for (int ps = 0; ps < 2; ++ps) { u32x4* qp = (u32x4*)(PROJ + (size_t)row * NPAD + PC_Q + (ps * 4 + grp) * 128 + sub * 8); const u32x4 w = *qp;
                float v[8] = {bf_lo(w.x), bf_hi(w.x), bf_lo(w.y), bf_hi(w.y), bf_lo(w.z), bf_hi(w.z), bf_lo(w.w), bf_hi(w.w)}; float s = 0.f;
#pragma unroll
                for (int k = 0; k < 8; ++k) s += v[k] * v[k];
                const float rs = 1.f / sqrtf(group16_sum(s) * (1.f / 128.f) + EPS);
                u32x4 o; o.x = cvtpk(v[0] * rs * gq[0].x, v[1] * rs * gq[0].y); o.y = cvtpk(v[2] * rs * gq[0].z, v[3] * rs * gq[0].w); o.z = cvtpk(v[4] * rs * gq[1].x, v[5] * rs * gq[1].y); o.w = cvtpk(v[6] * rs * gq[1].z, v[7] * rs * gq[1].w);
                *qp = o; }
            { u32x4* qp = (u32x4*)(PROJ + (size_t)row * NPAD + PC_MQ + grp * 128 + sub * 8); const u32x4 w = *qp;
                float v[8] = {bf_lo(w.x), bf_hi(w.x), bf_lo(w.y), bf_hi(w.y), bf_lo(w.z), bf_hi(w.z), bf_lo(w.w), bf_hi(w.w)}; float s = 0.f;
#pragma unroll
                for (int k = 0; k < 8; ++k) s += v[k] * v[k];
                const float rs = 1.f / sqrtf(group16_sum(s) * (1.f / 128.f) + EPS);
                u32x4 o; o.x = cvtpk(v[0] * rs * gmq[0].x, v[1] * rs * gmq[0].y); o.y = cvtpk(v[2] * rs * gmq[0].z, v[3] * rs * gmq[0].w); o.z = cvtpk(v[4] * rs * gmq[1].x, v[5] * rs * gmq[1].y); o.w = cvtpk(v[6] * rs * gmq[1].z, v[7] * rs * gmq[1].w);
                *qp = o; }
            float* krow = (row < MP) ? p.out + O_PK + (size_t)row * 1024 : p.out + O_SK + (size_t)(row - MP) * 1024;
#pragma unroll
            for (int ps = 0; ps < 2; ++ps) { f32x4* kp = (f32x4*)(krow + (ps * 4 + grp) * 128 + sub * 8); f32x4 a = kp[0], b = kp[1];
                float s = (a.x * a.x + a.y * a.y) + (a.z * a.z + a.w * a.w) + (b.x * b.x + b.y * b.y) + (b.z * b.z + b.w * b.w);
                const float rs = 1.f / sqrtf(group16_sum(s) * (1.f / 128.f) + EPS);
                a = a * rs * gk[0]; b = b * rs * gk[1]; kp[0] = a; kp[1] = b;
                u32x4 o; o.x = cvtpk(a.x, a.y); o.y = cvtpk(a.z, a.w); o.z = cvtpk(b.x, b.y); o.w = cvtpk(b.z, b.w);
                *(u32x4*)(PROJ + (size_t)row * NPAD + PC_K + (ps * 4 + grp) * 128 + sub * 8) = o; }
        } else {
            const int mr = row - MVALID;
            { f32x4* kp = (f32x4*)(p.out + O_PMK + (size_t)mr * 512 + grp * 128 + sub * 8); f32x4 a = kp[0], b = kp[1];
                float s = (a.x * a.x + a.y * a.y) + (a.z * a.z + a.w * a.w) + (b.x * b.x + b.y * b.y) + (b.z * b.z + b.w * b.w);
                const float rs = 1.f / sqrtf(group16_sum(s) * (1.f / 128.f) + EPS);
                a = a * rs * gmk[0]; b = b * rs * gmk[1]; kp[0] = a; kp[1] = b;
                u32x4 o; o.x = cvtpk(a.x, a.y); o.y = cvtpk(a.z, a.w); o.z = cvtpk(b.x, b.y); o.w = cvtpk(b.z, b.w);
                *(u32x4*)(MKn + (size_t)mr * 512 + grp * 128 + sub * 8) = o; }
            { const f32x4* vp = (const f32x4*)(p.out + O_PMV + (size_t)mr * 512 + grp * 128 + sub * 8); const f32x4 a = vp[0], b = vp[1];
                u32x4 o; o.x = cvtpk(a.x, a.y); o.y = cvtpk(a.z, a.w); o.z = cvtpk(b.x, b.y); o.w = cvtpk(b.z, b.w);
                *(u32x4*)(MVb + (size_t)mr * 512 + grp * 128 + sub * 8) = o; }
        }
    }
    const bf16_t* XBC = (const bf16_t*)(p.ws + WS_PROJ) + PC_XBC;
    const int gt = vcu * 512 + tid, NGT = G * 512;
    for (int i = gt; i < (NBATCH + DSEQ) * 3 * 1024; i += NGT) {
        const int c = i & 1023, j = (i >> 10) % 3, s = i / 3072;
        if (s < NBATCH) p.out[O_PCONV + (size_t)i] = bf2f(XBC[(size_t)(s * SEQ + SEQ - 3 + j) * NPAD + c]);
        else p.out[O_SCONV + (size_t)(i - NBATCH * 3072)] = bf2f(XBC[(size_t)(MP + (s - NBATCH) * DTOK + DTOK - 3 + j) * NPAD + c]);
    }
}

#define KSWZ(row, colB) ((row) * 256 + ((colB) ^ (((row) & 7) << 4)))
#define SBAR() __builtin_amdgcn_sched_barrier(0)
__device__ __forceinline__ int crow(int r, int hi) { return (r & 3) + 8 * (r >> 2) + 4 * hi; }
__device__ __forceinline__ int v_st(int k, int c) { const int kk = (k & ~0xC) | ((k & 4) << 1) | ((k & 8) >> 1); return ((kk >> 3) * 4 + (c >> 5)) * 512 + ((kk & 7) * 32 + (c & 31)) * 2; }
__device__ __forceinline__ int v_rd_base(int lane) { return ((lane & 3) << 3) | (((lane >> 2) & 3) << 6) | (((lane >> 4) & 1) << 5) | (((lane >> 5) & 1) << 8); }
constexpr int v_rd_off(int d0, int ks, int half) { return d0 * 512 + ks * 4096 + half * 2048; }
template <int OFF> __device__ __forceinline__ s16x4 tr_read(int vb) {
    s16x4 r; asm volatile("ds_read_b64_tr_b16 %0, %1 offset:%2" : "=&v"(r) : "v"(vb), "i"(OFF) : "memory"); return r;
}
#define PKV(L, H) (bf16x8){L[0], L[1], L[2], L[3], H[0], H[1], H[2], H[3]}
template <int D0, int KS0> __device__ __forceinline__ void pv_one(f32x16& od, int vb, const bf16x8* pa) {
    const s16x4 l0 = tr_read<v_rd_off(D0, KS0, 0)>(vb), h0 = tr_read<v_rd_off(D0, KS0, 1)>(vb), l1 = tr_read<v_rd_off(D0, KS0 + 1, 0)>(vb), h1 = tr_read<v_rd_off(D0, KS0 + 1, 1)>(vb);
    asm volatile("s_waitcnt lgkmcnt(0)" ::: "memory"); SBAR();
    od = __builtin_amdgcn_mfma_f32_32x32x16_bf16(pa[0], PKV(l0, h0), od, 0, 0, 0);
    od = __builtin_amdgcn_mfma_f32_32x32x16_bf16(pa[1], PKV(l1, h1), od, 0, 0, 0);
}
template <int KS0> __device__ __forceinline__ void pv_blk(f32x16* o, int vb, const bf16x8* pa) {
    pv_one<0, KS0>(o[0], vb, pa); pv_one<1, KS0>(o[1], vb, pa); pv_one<2, KS0>(o[2], vb, pa); pv_one<3, KS0>(o[3], vb, pa);
}
__device__ __forceinline__ void pack_p(const f32x16& P, bf16x8& out0, bf16x8& out1) {
#define PK4(BASE, OUT) do { unsigned a0 = cvtpk(P[BASE + 0], P[BASE + 1]), a1 = cvtpk(P[BASE + 2], P[BASE + 3]);   \
    unsigned b0 = cvtpk(P[BASE + 4], P[BASE + 5]), b1 = cvtpk(P[BASE + 6], P[BASE + 7]);                              \
    auto r0 = __builtin_amdgcn_permlane32_swap(a0, b0, false, false); auto r1 = __builtin_amdgcn_permlane32_swap(a1, b1, false, false); \
    u32x4 w = {r0[0], r1[0], r0[1], r1[1]}; OUT = *reinterpret_cast<bf16x8*>(&w); } while (0)
    PK4(0, out0); PK4(8, out1);
#undef PK4
}
template <int NB, bool MASK> __device__ __forceinline__ void sb_transform(f32x16* P, float& R, int hi, int kpos0, int qpos) {
    float T[NB][4];
#pragma unroll
    for (int b = 0; b < NB; ++b)
#pragma unroll
        for (int g = 0; g < 4; ++g) {
            float be[4], f[4];
#pragma unroll
            for (int i = 0; i < 4; ++i) {
                const float z = fmaxf(P[b][4 * g + i], -100.f);
                const float e = fast_exp2(-z), rc = fast_rcp(1.f + e);
                be[i] = rc; f[i] = e * rc;
                if (MASK) { const bool ok = (kpos0 + 32 * b + 8 * g + 4 * hi + i) < qpos; be[i] = ok ? be[i] : 0.f; f[i] = ok ? f[i] : 1.f; }
            }
            const float e2 = f[3], e1 = f[2] * f[3], e0 = f[1] * e1;
            T[b][g] = f[0] * e0;
            P[b][4 * g + 0] = be[0] * e0; P[b][4 * g + 1] = be[1] * e1; P[b][4 * g + 2] = be[2] * e2; P[b][4 * g + 3] = be[3];
        }
    float E = R;
#pragma unroll
    for (int b = NB - 1; b >= 0; --b)
#pragma unroll
        for (int g = 3; g >= 0; --g) {
            const float To = __shfl_xor(T[b][g], 32);
            const float Eg = hi ? E : E * To;
#pragma unroll
            for (int i = 0; i < 4; ++i) P[b][4 * g + i] *= Eg;
            E = E * T[b][g] * To;
        }
    R = E;
}

struct AttnArgs {
    const bf16_t* Q; int qstride;
    const bf16_t* K; const bf16_t* V; int kvstride;
    int ntiles;
    int qpos0;
    int nvalid;
    float bias2;
    const bf16_t* gate; int gstride;
    bf16_t* out; int ostride;
};
template <int MODE>
__device__ __forceinline__ void attn_unit(LAS unsigned char* lds, const bf16_t* aQ, int aqstride, const bf16_t* aK, const bf16_t* aV, int akvstride, int antiles, int aqpos0, int anvalid, float abias2,
                                      const bf16_t* agate, int agstride, bf16_t* aout, int aostride) {
    AttnArgs a; a.Q = aQ; a.qstride = aqstride; a.K = aK; a.V = aV; a.kvstride = akvstride; a.ntiles = antiles; a.qpos0 = aqpos0; a.nvalid = anvalid; a.bias2 = abias2;
    a.gate = agate; a.gstride = agstride; a.out = aout; a.ostride = aostride;
    int tid = threadIdx.x; asm volatile("" : "+v"(tid));
    const int wid = __builtin_amdgcn_readfirstlane(tid >> 6), lane = tid & 63, r32 = lane & 31, hi = lane >> 5;
    constexpr int SHM_V = 16384, SHM_K = 16384;
    LAS unsigned char* V_lds = lds; LAS unsigned char* K_lds = lds + 2 * SHM_V;
    LAS float* wsf = (LAS float*)(lds + 2 * SHM_V + 2 * SHM_K) + wid * 64;
    f32x16 o[4];
#pragma unroll
    for (int d = 0; d < 4; ++d) o[d] = f32x16{};
    bf16x8 qr[8];
    { int qrow = wid * 32 + r32; qrow = qrow < a.nvalid ? qrow : a.nvalid - 1;
      const bf16_t* Qw = a.Q + (size_t)qrow * a.qstride + hi * 8;
#pragma unroll
      for (int d0 = 0; d0 < 8; ++d0) qr[d0] = *(const bf16x8*)(Qw + d0 * 16); }
    const int sr = tid >> 4, sc = (tid & 15) * 8, vst0 = v_st(sr, sc), vst1 = v_st(32 + sr, sc);
    const int vb0 = (int)(uintptr_t)V_lds + v_rd_base(lane);
    bf16x8 sv0, sv1, sk0, sk1;
#define SLOAD(k0) do { sv0 = *(const bf16x8*)(a.V + (size_t)((k0) + sr) * a.kvstride + sc); sv1 = *(const bf16x8*)(a.V + (size_t)((k0) + 32 + sr) * a.kvstride + sc); \
    sk0 = *(const bf16x8*)(a.K + (size_t)((k0) + sr) * a.kvstride + sc); sk1 = *(const bf16x8*)(a.K + (size_t)((k0) + 32 + sr) * a.kvstride + sc); } while (0)
#define SWRITE(b) do { *(LAS bf16x8*)(V_lds + (b) * SHM_V + vst0) = sv0; *(LAS bf16x8*)(V_lds + (b) * SHM_V + vst1) = sv1; \
    *(LAS bf16x8*)(K_lds + (b) * SHM_K + KSWZ(sr, sc * 2)) = sk0; *(LAS bf16x8*)(K_lds + (b) * SHM_K + KSWZ(32 + sr, sc * 2)) = sk1; } while (0)
    const int nt = a.ntiles;
    float R = 1.f, lsum = 0.f;
    const int qpos = a.qpos0 + wid * 32 + r32;
    const int qmax_w = a.qpos0 + wid * 32 + 31;
    __syncthreads();
    { const int t0 = (MODE == 0) ? nt - 1 : 0; SLOAD(t0 * 64); SWRITE(0); }
    __syncthreads();
    for (int j = 0; j < nt; ++j) {
        const int cur = j & 1, t = (MODE == 0) ? nt - 1 - j : j;
        if (j + 1 < nt) { const int tn = (MODE == 0) ? t - 1 : t + 1; SLOAD(tn * 64); }
        const bool active = (MODE == 1) || (t * 64 < qmax_w);
        if (active) {
            const LAS unsigned char* Ks = K_lds + cur * SHM_K;
            const bool diag = (MODE == 0) && (t * 64 + 63 >= a.qpos0);
#define ATT_BLOCK(B) do { f32x16 pb_[1]; { const float init = (MODE == 0) ? a.bias2 : 0.f; _Pragma("unroll") for (int r = 0; r < 16; ++r) pb_[0][r] = init; } \
            _Pragma("unroll") for (int d0 = 0; d0 < 8; ++d0) { const int cb = (d0 * 16 + hi * 8) * 2; \
                const bf16x8 kf = *(const LAS bf16x8*)(Ks + KSWZ(32 * (B) + r32, cb)); \
                pb_[0] = __builtin_amdgcn_mfma_f32_32x32x16_bf16(kf, qr[d0], pb_[0], 0, 0, 0); } \
            if (MODE == 0) { if (diag) sb_transform<1, true>(pb_, R, hi, t * 64 + 32 * (B), qpos); else sb_transform<1, false>(pb_, R, hi, 0, 0); } \
            else { float ps = 0.f; _Pragma("unroll") for (int r = 0; r < 16; ++r) { pb_[0][r] = fast_exp2(pb_[0][r]); ps += pb_[0][r]; } lsum += ps; } \
            bf16x8 pa_[2]; pack_p(pb_[0], pa_[0], pa_[1]); SBAR(); \
            pv_blk<2 * (B)>(o, vb0 + cur * SHM_V, pa_); } while (0)
            ATT_BLOCK(1);
            ATT_BLOCK(0);
#undef ATT_BLOCK
        }
        if (j + 1 < nt) SWRITE(cur ^ 1);
        __syncthreads();
    }
#undef SLOAD
#undef SWRITE
    float rl[16];
    if (MODE == 1) {
        lsum += __shfl_xor(lsum, 32);
        if (hi == 0) wsf[r32] = lsum;
        asm volatile("s_waitcnt lgkmcnt(0)" ::: "memory");
#pragma unroll
        for (int r = 0; r < 16; ++r) rl[r] = fast_rcp(wsf[crow(r, hi)]);
    }
#pragma unroll
    for (int r = 0; r < 16; ++r) {
        const int row = wid * 32 + crow(r, hi);
        if (row < a.nvalid) {
#pragma unroll
            for (int d0 = 0; d0 < 4; ++d0) {
                const float gt = bf2f(a.gate[(size_t)row * a.gstride + d0 * 32 + r32]);
                float v = o[d0][r]; if (MODE == 1) v *= rl[r];
                a.out[(size_t)row * a.ostride + d0 * 32 + r32] = f2bf(v * silu_f(gt));
            }
        }
    }
}

__device__ __forceinline__ void decode_unit(const int* ptab, const float* ck, const float* cv, const float* sbbias, unsigned char* ws, LAS unsigned char* lds, int seq, int page) {
    int tid = threadIdx.x; asm volatile("" : "+v"(tid));
    const int wid = __builtin_amdgcn_readfirstlane(tid >> 6), lane = tid & 63, r32 = lane & 31, hi = lane >> 5;
    const int head = wid;
    LAS unsigned char* K_lds = lds + wid * 16384; LAS unsigned char* V_lds = K_lds + 8192;
    const int phys = __builtin_amdgcn_readfirstlane(ptab[seq * NPAGES + page]);
    const float* Kp = ck + (size_t)phys * (PAGE * 1024) + head * 128;
    const float* Vp = cv + (size_t)phys * (PAGE * 1024) + head * 128;
    const float bias2 = sbbias[head] * LOG2E;
    const bf16_t* PROJ = (const bf16_t*)(ws + WS_PROJ);
    LAS unsigned char* Q_lds = lds + RING_BYTES + wid * 2048;
    f32x16 o[4];
#pragma unroll
    for (int d = 0; d < 4; ++d) o[d] = f32x16{};
    float R = 1.f;
    const int srow = lane >> 4, scol = (lane & 15) * 8;
    const int vb0 = (int)(uintptr_t)V_lds + v_rd_base(lane);
    __syncthreads();
#pragma unroll
    for (int i = 0; i < 2; ++i) { const int c = lane + 64 * i, qrw = c >> 4, qc = (c & 15) * 8;
        *(LAS bf16x8*)(Q_lds + KSWZ(qrw, qc * 2)) = *(const bf16x8*)(PROJ + (size_t)(MP + seq * DTOK + qrw) * NPAD + PC_Q + head * 128 + qc); }
    f32x4 st[16];
#define DLOAD(src, kb) do { _Pragma("unroll") for (int i = 0; i < 8; ++i) { const f32x4* g_ = (const f32x4*)((src) + (size_t)((kb) * 32 + srow + 4 * i) * 1024 + scol); \
        st[2 * i] = __builtin_nontemporal_load(g_); st[2 * i + 1] = __builtin_nontemporal_load(g_ + 1); } } while (0)
    DLOAD(Kp, 3);
    for (int kb = 3; kb >= 0; --kb) {
#pragma unroll
        for (int i = 0; i < 8; ++i) { u32x4 w; w.x = cvtpk(st[2 * i].x, st[2 * i].y); w.y = cvtpk(st[2 * i].z, st[2 * i].w); w.z = cvtpk(st[2 * i + 1].x, st[2 * i + 1].y); w.w = cvtpk(st[2 * i + 1].z, st[2 * i + 1].w);
            *(LAS u32x4*)(K_lds + KSWZ(srow + 4 * i, scol * 2)) = w; }
        DLOAD(Vp, kb);
        f32x16 pp[1];
#pragma unroll
        for (int r = 0; r < 16; ++r) pp[0][r] = bias2;
#pragma unroll
        for (int d0 = 0; d0 < 8; ++d0) { const int cb = (d0 * 16 + hi * 8) * 2;
            const bf16x8 b0 = *(const LAS bf16x8*)(K_lds + KSWZ(r32, cb));
            const bf16x8 qf = *(const LAS bf16x8*)(Q_lds + KSWZ(r32 & 7, cb));
            pp[0] = __builtin_amdgcn_mfma_f32_32x32x16_bf16(b0, qf, pp[0], 0, 0, 0); }
        sb_transform<1, false>(pp, R, hi, 0, 0);
        bf16x8 pa[2];
        pack_p(pp[0], pa[0], pa[1]);
#pragma unroll
        for (int i = 0; i < 8; ++i) { u32x4 w; w.x = cvtpk(st[2 * i].x, st[2 * i].y); w.y = cvtpk(st[2 * i].z, st[2 * i].w); w.z = cvtpk(st[2 * i + 1].x, st[2 * i + 1].y); w.w = cvtpk(st[2 * i + 1].z, st[2 * i + 1].w);
            *(LAS u32x4*)(V_lds + v_st(srow + 4 * i, scol)) = w; }
        if (kb > 0) DLOAD(Kp, kb - 1);
        SBAR();
        pv_blk<0>(o, vb0, pa);
    }
#undef DLOAD
    float* Op = (float*)(ws + WS_OPART) + ((size_t)((seq * 8 + head) * NPAGES + page)) * (DTOK * 128);
#pragma unroll
    for (int r = 0; r < 4; ++r)
#pragma unroll
        for (int d0 = 0; d0 < 4; ++d0) Op[(r + 4 * hi) * 128 + d0 * 32 + r32] = o[d0][r];
    if (lane < 8) ((float*)(ws + WS_FPART))[((size_t)((seq * 8 + head) * NPAGES + page)) * DTOK + lane] = R;
}

constexpr int SS_LD = 272;
constexpr int SS_CM = 0, SS_BM = 34816, SS_BWT = 69632, SS_XT = 104448, SS_HB = 121856, SS_XS = 139264, SS_XS_LD = 144, SS_F = 157696;
static_assert(SS_F + 1024 <= LDS_CTLW, "SSD LDS map");
template <bool SAMPLE>
__device__ __forceinline__ void ssd_unit(unsigned char* ws, float* outp, const float* alog, const float* dtbias, const float* dskip, const float* ssm0, const float* sconv0, const float* convw, const float* convb,
                                     LAS unsigned char* lds, int bs, int h) {
    int tid = threadIdx.x; asm volatile("" : "+v"(tid));
    const int wid = __builtin_amdgcn_readfirstlane(tid >> 6), lane = tid & 63, j16 = lane & 15, ig = lane >> 4;
    const int g = h >> 2;
    const int rowbase = SAMPLE ? MP + bs * DTOK : bs * SEQ;
    constexpr int NTOK = SAMPLE ? DTOK : SEQ, NCH = SAMPLE ? 1 : SEQ / 128;
    const float a_h = -__expf(alog[h]), dtb = dtbias[h], D_h = dskip[h];
    const bf16_t* PROJ = (const bf16_t*)(ws + WS_PROJ);
    const float* DTb = (const float*)(ws + WS_DT);
    LAS float* csf = (LAS float*)(lds + SS_F); LAS float* dtf = csf + 128;
    f32x4 hs[4];
    __syncthreads();
#pragma unroll
    for (int pb = 0; pb < 4; ++pb) {
#pragma unroll
        for (int r = 0; r < 4; ++r) { const int pp = 16 * pb + 4 * ig + r, n = 16 * wid + j16;
            const float v = SAMPLE ? ssm0[((size_t)(bs * 8 + h) * 64 + pp) * 128 + n] : 0.f; hs[pb][r] = v;
            *(LAS bf16_t*)(lds + SS_HB + pp * SS_LD + n * 2) = f2bf(v); } }
    for (int c = 0; c < NCH; ++c) {
        const int crow0 = rowbase + c * 128;
        if (wid == 0) {
            float da[2], dtv[2];
#pragma unroll
            for (int q = 0; q < 2; ++q) { const int l = lane + 64 * q; float dt = 0.f;
                if (c * 128 + l < NTOK) { const float x = DTb[(size_t)(crow0 + l) * 8 + h] + dtb; dt = (x > 20.f) ? x : log1pf(__expf(x)); }
                dtv[q] = dt; da[q] = dt * a_h; }
#pragma unroll
            for (int q = 0; q < 2; ++q) {
#pragma unroll
                for (int o = 1; o < 64; o <<= 1) { const float t = __shfl_up(da[q], o); if (lane >= o) da[q] += t; } }
            const float tot0 = __shfl(da[0], 63);
            csf[lane] = da[0]; csf[lane + 64] = da[1] + tot0; dtf[lane] = dtv[0]; dtf[lane + 64] = dtv[1];
        }
        __syncthreads();
        const float cs_end = csf[127];
        for (int it = tid; it < 1280; it += 512) {
            const int cc = it % 40, rg = it / 40, l0 = 4 * rg;
            const int ch0 = (cc < 8) ? h * 64 + 8 * cc : (cc < 24) ? 512 + g * 128 + 8 * (cc - 8) : 768 + g * 128 + 8 * (cc - 24);
            float raw[7][8];
#pragma unroll
            for (int r = 0; r < 7; ++r) { const int l = l0 - 3 + r; const int tpos = c * 128 + l;
                if (tpos >= 0 && tpos < NTOK) { const u32x4 w = *(const u32x4*)(PROJ + (size_t)(crow0 + l) * NPAD + PC_XBC + ch0);
                    raw[r][0] = bf_lo(w.x); raw[r][1] = bf_hi(w.x); raw[r][2] = bf_lo(w.y); raw[r][3] = bf_hi(w.y); raw[r][4] = bf_lo(w.z); raw[r][5] = bf_hi(w.z); raw[r][6] = bf_lo(w.w); raw[r][7] = bf_hi(w.w); }
                else if (SAMPLE && tpos < 0) { const f32x4* s = (const f32x4*)(sconv0 + ((size_t)bs * 3 + (3 + tpos)) * 1024 + ch0); const f32x4 u0 = s[0], u1 = s[1];
                    raw[r][0] = u0.x; raw[r][1] = u0.y; raw[r][2] = u0.z; raw[r][3] = u0.w; raw[r][4] = u1.x; raw[r][5] = u1.y; raw[r][6] = u1.z; raw[r][7] = u1.w; }
                else {
#pragma unroll
                    for (int k = 0; k < 8; ++k) raw[r][k] = 0.f; } }
            float cw[4][8], cbv[8];
#pragma unroll
            for (int jj = 0; jj < 4; ++jj) { const f32x4* s = (const f32x4*)(convw + jj * 1024 + ch0); const f32x4 u0 = s[0], u1 = s[1];
                cw[jj][0] = u0.x; cw[jj][1] = u0.y; cw[jj][2] = u0.z; cw[jj][3] = u0.w; cw[jj][4] = u1.x; cw[jj][5] = u1.y; cw[jj][6] = u1.z; cw[jj][7] = u1.w; }
            { const f32x4* s = (const f32x4*)(convb + ch0); const f32x4 u0 = s[0], u1 = s[1];
                cbv[0] = u0.x; cbv[1] = u0.y; cbv[2] = u0.z; cbv[3] = u0.w; cbv[4] = u1.x; cbv[5] = u1.y; cbv[6] = u1.z; cbv[7] = u1.w; }
            float ov[4][8];
#pragma unroll
            for (int r = 0; r < 4; ++r) { const bool live = (c * 128 + l0 + r) < NTOK;
#pragma unroll
                for (int k = 0; k < 8; ++k) { float v = cbv[k];
#pragma unroll
                    for (int jj = 0; jj < 4; ++jj) v = fmaf(raw[r + jj][k], cw[jj][k], v);
                    ov[r][k] = live ? silu_f(v) : 0.f; } }
            if (cc < 8) {
                float dtl[4];
#pragma unroll
                for (int r = 0; r < 4; ++r) dtl[r] = dtf[l0 + r];
#pragma unroll
                for (int r = 0; r < 4; ++r) { u32x4 w; w.x = cvtpk(ov[r][0], ov[r][1]); w.y = cvtpk(ov[r][2], ov[r][3]); w.z = cvtpk(ov[r][4], ov[r][5]); w.w = cvtpk(ov[r][6], ov[r][7]);
                    *(LAS u32x4*)(lds + SS_XS + (l0 + r) * SS_XS_LD + cc * 16) = w; }
#pragma unroll
                for (int k = 0; k < 8; ++k) { u32x2 w; w.x = cvtpk(ov[0][k] * dtl[0], ov[1][k] * dtl[1]); w.y = cvtpk(ov[2][k] * dtl[2], ov[3][k] * dtl[3]);
                    *(LAS u32x2*)(lds + SS_XT + (8 * cc + k) * SS_LD + l0 * 2) = w; }
            } else if (cc < 24) {
                const int n0 = 8 * (cc - 8);
                float wl[4];
#pragma unroll
                for (int r = 0; r < 4; ++r) wl[r] = __expf(cs_end - csf[l0 + r]);
#pragma unroll
                for (int r = 0; r < 4; ++r) { u32x4 w; w.x = cvtpk(ov[r][0], ov[r][1]); w.y = cvtpk(ov[r][2], ov[r][3]); w.z = cvtpk(ov[r][4], ov[r][5]); w.w = cvtpk(ov[r][6], ov[r][7]);
                    *(LAS u32x4*)(lds + SS_BM + (l0 + r) * SS_LD + n0 * 2) = w; }
#pragma unroll
                for (int k = 0; k < 8; ++k) { u32x2 w; w.x = cvtpk(ov[0][k] * wl[0], ov[1][k] * wl[1]); w.y = cvtpk(ov[2][k] * wl[2], ov[3][k] * wl[3]);
                    *(LAS u32x2*)(lds + SS_BWT + (n0 + k) * SS_LD + l0 * 2) = w; }
            } else {
                const int n0 = 8 * (cc - 24);
#pragma unroll
                for (int r = 0; r < 4; ++r) { u32x4 w; w.x = cvtpk(ov[r][0], ov[r][1]); w.y = cvtpk(ov[r][2], ov[r][3]); w.z = cvtpk(ov[r][4], ov[r][5]); w.w = cvtpk(ov[r][6], ov[r][7]);
                    *(LAS u32x4*)(lds + SS_CM + (l0 + r) * SS_LD + n0 * 2) = w; }
            }
        }
        __syncthreads();
        f32x4 cb[8];
#pragma unroll
        for (int sb = 0; sb < 8; ++sb) cb[sb] = f32x4{0.f, 0.f, 0.f, 0.f};
#pragma unroll
        for (int ks = 0; ks < 4; ++ks) {
            const bf16x8 af = *(const LAS bf16x8*)(lds + SS_CM + (16 * wid + j16) * SS_LD + (32 * ks + 8 * ig) * 2);
#pragma unroll
            for (int sb = 0; sb < 8; ++sb) { const bf16x8 bf = *(const LAS bf16x8*)(lds + SS_BM + (16 * sb + j16) * SS_LD + (32 * ks + 8 * ig) * 2);
                cb[sb] = __builtin_amdgcn_mfma_f32_16x16x32_bf16(af, bf, cb[sb], 0, 0, 0); } }
        { const float dec = __expf(cs_end);
#pragma unroll
          for (int pb = 0; pb < 4; ++pb) hs[pb] = hs[pb] * dec;
#pragma unroll
          for (int ks = 0; ks < 4; ++ks) {
              const bf16x8 bf = *(const LAS bf16x8*)(lds + SS_BWT + (16 * wid + j16) * SS_LD + (32 * ks + 8 * ig) * 2);
#pragma unroll
              for (int pb = 0; pb < 4; ++pb) { const bf16x8 af = *(const LAS bf16x8*)(lds + SS_XT + (16 * pb + j16) * SS_LD + (32 * ks + 8 * ig) * 2);
                  hs[pb] = __builtin_amdgcn_mfma_f32_16x16x32_bf16(af, bf, hs[pb], 0, 0, 0); } } }
        __syncthreads();
        {
            float csl[4];
#pragma unroll
            for (int r = 0; r < 4; ++r) csl[r] = csf[16 * wid + 4 * ig + r];
#pragma unroll
            for (int sb = 0; sb < 8; ++sb) { const int s = 16 * sb + j16; const float css = csf[s];
#pragma unroll
                for (int r = 0; r < 4; ++r) { const int l = 16 * wid + 4 * ig + r; const float gv = (s <= l) ? cb[sb][r] * __expf(csl[r] - css) : 0.f;
                    *(LAS bf16_t*)(lds + SS_BM + l * SS_LD + s * 2) = f2bf(gv); } }
        }
        f32x4 yd[4], yo[4];
#pragma unroll
        for (int pb = 0; pb < 4; ++pb) { yd[pb] = f32x4{0.f, 0.f, 0.f, 0.f}; yo[pb] = f32x4{0.f, 0.f, 0.f, 0.f}; }
#pragma unroll
        for (int ks = 0; ks < 4; ++ks) {
            const bf16x8 ag = *(const LAS bf16x8*)(lds + SS_BM + (16 * wid + j16) * SS_LD + (32 * ks + 8 * ig) * 2);
            const bf16x8 ac = *(const LAS bf16x8*)(lds + SS_CM + (16 * wid + j16) * SS_LD + (32 * ks + 8 * ig) * 2);
#pragma unroll
            for (int pb = 0; pb < 4; ++pb) {
                const bf16x8 bx = *(const LAS bf16x8*)(lds + SS_XT + (16 * pb + j16) * SS_LD + (32 * ks + 8 * ig) * 2);
                const bf16x8 bh = *(const LAS bf16x8*)(lds + SS_HB + (16 * pb + j16) * SS_LD + (32 * ks + 8 * ig) * 2);
                yd[pb] = __builtin_amdgcn_mfma_f32_16x16x32_bf16(ag, bx, yd[pb], 0, 0, 0);
                yo[pb] = __builtin_amdgcn_mfma_f32_16x16x32_bf16(ac, bh, yo[pb], 0, 0, 0); } }
        {
            float* YZ = (float*)(ws + WS_YZ); float* SSQ = (float*)(ws + WS_SSQ);
#pragma unroll
            for (int r = 0; r < 4; ++r) { const int l = 16 * wid + 4 * ig + r; const float el = __expf(csf[l]); float sq = 0.f;
                const bool live = (c * 128 + l) < NTOK; const size_t grow = (size_t)(crow0 + l);
#pragma unroll
                for (int pb = 0; pb < 4; ++pb) { const int pp = 16 * pb + j16;
                    const float xv = bf2f(*(const LAS bf16_t*)(lds + SS_XS + l * SS_XS_LD + pp * 2));
                    float y = yd[pb][r] + el * yo[pb][r] + D_h * xv;
                    if (live) { const float zv = bf2f(PROJ[grow * NPAD + PC_Z + h * 64 + pp]); y *= silu_f(zv); YZ[grow * 512 + h * 64 + pp] = y; sq += y * y; } }
                sq = group16_sum(sq);
                if (live && j16 == 0) SSQ[grow * 8 + h] = sq; }
        }
        __syncthreads();
#pragma unroll
        for (int pb = 0; pb < 4; ++pb)
#pragma unroll
            for (int r = 0; r < 4; ++r) *(LAS bf16_t*)(lds + SS_HB + (16 * pb + 4 * ig + r) * SS_LD + (16 * wid + j16) * 2) = f2bf(hs[pb][r]);
    }
    float* So = outp + (SAMPLE ? O_SSSM : O_PSSM) + (size_t)(bs * 8 + h) * 64 * 128;
#pragma unroll
    for (int pb = 0; pb < 4; ++pb)
#pragma unroll
        for (int r = 0; r < 4; ++r) So[(16 * pb + 4 * ig + r) * 128 + 16 * wid + j16] = hs[pb][r];
}

constexpr int U_SSDP = 32, U_SB = 256, U_DEC = DSEQ * NPAGES, U_MEMP = NBATCH * 8 * 4, U_SSDS = 64, U_MEMS = DSEQ * 4;
#define QUEUE_LOOP(qi, total, ...) for (;;) { __syncthreads(); if (threadIdx.x == 0) ctlw[16] = __hip_atomic_fetch_add(qbase + 64 * (qi), 1u, __ATOMIC_RELAXED, __HIP_MEMORY_SCOPE_AGENT); \
        __syncthreads(); const int u = (int)ctlw[16]; if (u >= (total)) break; __VA_ARGS__ }
__device__ __forceinline__ void phase3(const Params& p, LAS unsigned char* lds, volatile LAS unsigned* ctlw) {
    unsigned* qbase = (unsigned*)(p.ws + WS_CTL) + CW_QUEUE;
    const bf16_t* PROJ = (const bf16_t*)(p.ws + WS_PROJ);
    bf16_t* MIX = (bf16_t*)(p.ws + WS_MIX);
    QUEUE_LOOP(0, U_SSDP, { ssd_unit<false>(p.ws, p.out, p.in[I_ALOG], p.in[I_DTBIAS], p.in[I_DSKIP], p.in[I_SSM], p.in[I_SCONV], p.in[I_CONVW], p.in[I_CONVB], lds, u >> 3, u & 7); })
    if (blockIdx.x & 1) {
        QUEUE_LOOP(1, U_DEC, { decode_unit((const int*)p.in[I_PT], p.in[I_CK], p.in[I_CV], p.in[I_SBBIAS], p.ws, lds, u >> 7, u & 127); })
    }
    QUEUE_LOOP(2, U_SB, {
        const int i = 7 - (u >> 5), bh = u & 31, b = bh >> 3, h = bh & 7;
        attn_unit<0>(lds, PROJ + (size_t)(b * SEQ + i * 256) * NPAD + PC_Q + h * 128, NPAD,
                     PROJ + (size_t)(b * SEQ) * NPAD + PC_K + h * 128, PROJ + (size_t)(b * SEQ) * NPAD + PC_V + h * 128, NPAD,
                     4 * (i + 1), i * 256, 256, p.in[I_SBBIAS][h] * LOG2E,
                     PROJ + (size_t)(b * SEQ + i * 256) * NPAD + PC_GSB + h * 128, NPAD, MIX + (size_t)(b * SEQ + i * 256) * 2048 + h * 128, 2048); })
    QUEUE_LOOP(1, U_DEC, { decode_unit((const int*)p.in[I_PT], p.in[I_CK], p.in[I_CV], p.in[I_SBBIAS], p.ws, lds, u >> 7, u & 127); })
    QUEUE_LOOP(3, U_MEMP + U_MEMS, {
        if (u < U_MEMP) { const int hm = u & 3, qb = (u >> 2) & 7, b = u >> 5; const size_t r0 = (size_t)(b * SEQ + qb * 256);
            attn_unit<1>(lds, PROJ + r0 * NPAD + PC_MQ + hm * 128, NPAD, (const bf16_t*)(p.ws + WS_MKN) + (size_t)(b * MEMT) * 512 + hm * 128, (const bf16_t*)(p.ws + WS_MVB) + (size_t)(b * MEMT) * 512 + hm * 128, 512,
                         4, 0, 256, 0.f, PROJ + r0 * NPAD + PC_GM + hm * 128, NPAD, MIX + r0 * 2048 + 1536 + hm * 128, 2048); }
        else { const int v = u - U_MEMP, hm = v & 3, sq = v >> 2; const size_t r0 = (size_t)(MP + sq * DTOK);
            attn_unit<1>(lds, PROJ + r0 * NPAD + PC_MQ + hm * 128, NPAD, (const bf16_t*)(p.ws + WS_CMK) + (size_t)(sq * MEMT) * 512 + hm * 128, (const bf16_t*)(p.ws + WS_CMV) + (size_t)(sq * MEMT) * 512 + hm * 128, 512,
                         4, 0, DTOK, 0.f, PROJ + r0 * NPAD + PC_GM + hm * 128, NPAD, MIX + r0 * 2048 + 1536 + hm * 128, 2048); } })
    QUEUE_LOOP(4, U_SSDS, { ssd_unit<true>(p.ws, p.out, p.in[I_ALOG], p.in[I_DTBIAS], p.in[I_DSKIP], p.in[I_SSM], p.in[I_SCONV], p.in[I_CONVW], p.in[I_CONVB], lds, u >> 3, u & 7); })
}

__device__ __forceinline__ void phase4(const Params& p, int vcu, int G) {
    const int tid = threadIdx.x, lane = tid & 63, wave = __builtin_amdgcn_readfirstlane(tid >> 6);
    const int gw = vcu * 8 + wave, NGW = G * 8;
    bf16_t* MIX = (bf16_t*)(p.ws + WS_MIX); const float* YZ = (const float*)(p.ws + WS_YZ); const float* SSQ = (const float*)(p.ws + WS_SSQ);
    const bf16_t* PROJ = (const bf16_t*)(p.ws + WS_PROJ);
    f32x4 gw4[2]; gw4[0] = *(const f32x4*)(p.in[I_SSDNW] + lane * 8); gw4[1] = *(const f32x4*)(p.in[I_SSDNW] + lane * 8 + 4);
    for (int row = gw; row < MVALID; row += NGW) {
        const f32x4 s0 = *(const f32x4*)(SSQ + (size_t)row * 8), s1 = *(const f32x4*)(SSQ + (size_t)row * 8 + 4);
        const float ssq = ((s0.x + s0.y) + (s0.z + s0.w)) + ((s1.x + s1.y) + (s1.z + s1.w));
        const float rs = 1.f / sqrtf(ssq * (1.f / 512.f) + EPS);
        const f32x4 a = *(const f32x4*)(YZ + (size_t)row * 512 + lane * 8), b = *(const f32x4*)(YZ + (size_t)row * 512 + lane * 8 + 4);
        u32x4 o; o.x = cvtpk(a.x * rs * gw4[0].x, a.y * rs * gw4[0].y); o.y = cvtpk(a.z * rs * gw4[0].z, a.w * rs * gw4[0].w); o.z = cvtpk(b.x * rs * gw4[1].x, b.y * rs * gw4[1].y); o.w = cvtpk(b.z * rs * gw4[1].z, b.w * rs * gw4[1].w);
        *(u32x4*)(MIX + (size_t)row * 2048 + 1024 + lane * 8) = o;
    }
    for (int u = vcu; u < DSEQ * 8; u += G) {
        const int seq = u >> 3, head = u & 7, i = wave;
        const int row = MP + seq * DTOK + i;
        const float bias2 = p.in[I_SBBIAS][head] * LOG2E;
        const unsigned qw = *(const unsigned*)(PROJ + (size_t)row * NPAD + PC_Q + head * 128 + 2 * lane);
        const float q0 = bf_lo(qw), q1 = bf_hi(qw);
        float acc0 = 0.f, acc1 = 0.f, R = 1.f;
        for (int j = DTOK - 1; j >= 0; --j) {
            const f32x2 kv = *(const f32x2*)(p.out + O_SK + (size_t)(seq * DTOK + j) * 1024 + head * 128 + 2 * lane);
            const float kb0 = bf2f(f2bf(kv.x)), kb1 = bf2f(f2bf(kv.y));
            const float z = fmaxf(wave_sum(q0 * kb0 + q1 * kb1) + bias2, -100.f);
            if (j < i) {
                const float e = fast_exp2(-z), rc = fast_rcp(1.f + e);
                const f32x2 vv = *(const f32x2*)(p.out + O_SV + (size_t)(seq * DTOK + j) * 1024 + head * 128 + 2 * lane);
                const float w = rc * R; acc0 += w * vv.x; acc1 += w * vv.y; R *= e * rc;
            }
        }
        const float* Op = (const float*)(p.ws + WS_OPART) + (size_t)((seq * 8 + head) * NPAGES) * (DTOK * 128) + i * 128 + 2 * lane;
        const float* Fp = (const float*)(p.ws + WS_FPART) + (size_t)((seq * 8 + head) * NPAGES) * DTOK + i;
        for (int pg = NPAGES - 1; pg >= 0; --pg) {
            const f32x2 ov = *(const f32x2*)(Op + (size_t)pg * (DTOK * 128));
            acc0 += R * ov.x; acc1 += R * ov.y; R *= Fp[(size_t)pg * DTOK];
        }
        const unsigned gwd = *(const unsigned*)(PROJ + (size_t)row * NPAD + PC_GSB + head * 128 + 2 * lane);
        *(unsigned*)(MIX + (size_t)row * 2048 + head * 128 + 2 * lane) = cvtpk(acc0 * silu_f(bf_lo(gwd)), acc1 * silu_f(bf_hi(gwd)));
    }
}

struct Epi5 {
    const float* xp; const float* xs; float* out;
    __device__ __forceinline__ void operator()(const pg8::Acc& acc, const pg8::Unit& u, int wr, int wc, int fr, int fq) const {
        int rl0 = wr * 64 + fr, cl0 = u.pn * 256 + wc * 32 + 4 * fq;
        asm volatile("" : "+v"(rl0), "+v"(cl0));
        const float* xb = u.pm < 32 ? xp + (size_t)u.pm * 256 * DM : xs; float* ob = u.pm < 32 ? out + O_YP + (size_t)u.pm * 256 * DM : out + O_YS; const int valid = u.pm < 32 ? 256 : MS;
#pragma unroll
        for (int ai = 0; ai < 2; ++ai)
#pragma unroll
            for (int m = 0; m < 4; ++m) { const int row = rl0 + ai * 128 + m * 16; if (row < valid) { const float* xr = xb + (size_t)row * DM + cl0; float* orow = ob + (size_t)row * DM + cl0;
#pragma unroll
                for (int bj = 0; bj < 2; ++bj)
#pragma unroll
                    for (int n = 0; n < 2; ++n) *(f32x4*)(orow + bj * 128 + n * 16) = *(const f32x4*)(xr + bj * 128 + n * 16) + acc[ai][bj][m][n]; } }
    }
};

constexpr int NPHASE = 6;
__global__ void __launch_bounds__(512, 2) hymba_fwd(Params p) {
    extern __shared__ __attribute__((aligned(16))) unsigned char lds_raw[];
    LAS unsigned char* lds = (LAS unsigned char*)lds_raw;
    const int tid = threadIdx.x;
    const int G = gridDim.x; const int bx = blockIdx.x; const int vcu = (G % 8 == 0) ? (bx % 8) * (G / 8) + bx / 8 : bx;
    volatile LAS unsigned* ctlw = (volatile LAS unsigned*)(lds + LDS_CTLW);
    if (tid < 64) ctlw[tid] = 0u;
    __syncthreads();
    unsigned* ctl = (unsigned*)(p.ws + WS_CTL);
    const int lo = p.ph_lo, hi = p.ph_hi;
    XcdBarrier bar; bar.bar = ctl + CW_BAR; bar.x = 0; bar.st = nullptr;
    if (hi - lo > 1) bar = xcd_barrier_post(ctl + CW_BAR, ctlw + 8);
#define IN(k) (lo <= (k) && (k) < hi)
#define BOTH(k) (IN(k) && IN((k) + 1))
    if (IN(0)) { phase0(p, lds, vcu, G); if (BOTH(0)) xcd_barrier(bar); }
    if (IN(1)) {
        pg8::Gemm g{(const bf16_t*)(p.ws + WS_H), (const bf16_t*)(p.ws + WS_WIN), (const bf16_t*)(p.ws + WS_HM), (const bf16_t*)(p.ws + WS_WM), DM};
        pg8::Order S; S.init(MROWS / 256, NPAD / 256, MMEM / 256, 1024 / 256, G, bx);
        Epi1 E{(bf16_t*)(p.ws + WS_PROJ), (float*)(p.ws + WS_DT), p.out};
        pg8::gemm_phase<Epi1>(lds, g, S, E);
        if (BOTH(1)) xcd_barrier(bar);
    }
    if (IN(2)) { phase2(p, vcu, G); if (BOTH(2)) xcd_barrier(bar); }
    if (IN(3)) { phase3(p, lds, ctlw); if (BOTH(3)) xcd_barrier(bar); }
    if (IN(4)) { phase4(p, vcu, G); if (BOTH(4)) xcd_barrier(bar); }
    if (IN(5)) {
        pg8::Gemm g{(const bf16_t*)(p.ws + WS_MIX), (const bf16_t*)(p.ws + WS_WOUT), nullptr, nullptr, DM};
        pg8::Order S; S.init(MROWS / 256, DM / 256, 0, 1, G, bx);
        Epi5 E{p.in[I_XP], p.in[I_XS], p.out};
        pg8::gemm_phase<Epi5>(lds, g, S, E);
    }
#undef IN
#undef BOTH
}

extern "C" void kernel_launch(void* const* d_in, const int* in_sizes, int n_in, void* d_out, int out_size, void* d_ws, size_t ws_size, hipStream_t stream) {
    static int grid = 0;
    if (grid == 0) {
        if (n_in != 26 || ws_size < WS_END) { fprintf(stderr, "kernel_launch: unexpected n_in %d / ws %zu\n", n_in, ws_size); grid = -1; return; }
        int dev = 0, cus = 0, per_cu = 0;
        if (hipGetDevice(&dev) != hipSuccess || hipDeviceGetAttribute(&cus, hipDeviceAttributeMultiprocessorCount, dev) != hipSuccess) { grid = -1; return; }
        if (hipFuncSetAttribute((const void*)hymba_fwd, hipFuncAttributeMaxDynamicSharedMemorySize, LDS_BYTES) != hipSuccess) { fprintf(stderr, "kernel_launch: hipFuncSetAttribute failed\n"); grid = -1; return; }
        if (hipOccupancyMaxActiveBlocksPerMultiprocessor(&per_cu, (const void*)hymba_fwd, 512, LDS_BYTES) != hipSuccess || per_cu < 1) fprintf(stderr, "kernel_launch: occupancy query says %d\n", per_cu);
        (void)hipGetLastError();
        grid = cus;
    }
    if (grid < 0) return;
    (void)hipMemsetAsync((char*)d_ws + WS_CTL, 0, CTL_BYTES, stream);
    Params p{};
    for (int i = 0; i < 26; ++i) p.in[i] = (const float*)d_in[i];
    p.out = (float*)d_out; p.ws = (unsigned char*)d_ws;
    if (MK_N_LAUNCHES == 1) { p.ph_lo = 0; p.ph_hi = NPHASE; hipLaunchKernelGGL(hymba_fwd, dim3(grid), dim3(512), LDS_BYTES, stream, p); }
    else for (int ph = 0; ph < NPHASE; ++ph) { p.ph_lo = ph; p.ph_hi = ph + 1; hipLaunchKernelGGL(hymba_fwd, dim3(grid), dim3(512), LDS_BYTES, stream, p); }
    const hipError_t le = hipPeekAtLastError();
    if (le != hipSuccess) fprintf(stderr, "kernel_launch: launch failed: %s\n", hipGetErrorName(le));
}
```

```cpp
#include <hip/hip_runtime.h>
#include <cstdio>
#include <cstdint>

#ifndef PROBE_DUP
#define PROBE_DUP -1
#endif
#ifndef MK_N_LAUNCHES
#define MK_N_LAUNCHES 1
#endif

constexpr int DM = 2048, NBATCH = 4, SEQ = 2048, MP = NBATCH * SEQ;
constexpr int DSEQ = 8, DTOK = 8, MS = DSEQ * DTOK;
constexpr int MVALID = MP + MS, MROWS = 8448;
constexpr int NIN = 6664, NPAD = 6912;
constexpr int MEMT = 256, MMEM = NBATCH * MEMT;
constexpr int NPAGES = 128, PAGE = 128, PAST = NPAGES * PAGE;
constexpr float EPS = 1e-6f;
constexpr float LOG2E = 1.4426950408889634f;
constexpr float QSCALE = 0.08838834764831845f * LOG2E;

constexpr size_t O_YP = 0, O_YS = 16777216, O_PK = 16908288, O_PV = 25296896, O_PSSM = 33685504, O_PCONV = 33947648,
                 O_PMK = 33959936, O_PMV = 34484224, O_SK = 35008512, O_SV = 35074048, O_SSSM = 35139584, O_SCONV = 35663872;

constexpr size_t MiB = 1u << 20;
constexpr size_t WS_CTL = 0, CTL_BYTES = 1 * MiB;
constexpr size_t WS_WIN = 2 * MiB;
constexpr size_t WS_WM = 32 * MiB;
constexpr size_t WS_WOUT = 38 * MiB;
constexpr size_t WS_H = 48 * MiB;
constexpr size_t WS_HM = 84 * MiB;
constexpr size_t WS_PROJ = 90 * MiB;
constexpr int PC_Q = 0, PC_K = 1024, PC_V = 2048, PC_GSB = 3072, PC_Z = 4096, PC_XBC = 4608, PC_MQ = 5632, PC_GM = 6144;
constexpr size_t WS_DT = 210 * MiB;
constexpr size_t WS_MKN = 211 * MiB;
constexpr size_t WS_MVB = 213 * MiB;
constexpr size_t WS_CMK = 215 * MiB;
constexpr size_t WS_CMV = 218 * MiB;
constexpr size_t WS_SSQ = 221 * MiB;
constexpr size_t WS_FPART = 222 * MiB;
constexpr size_t WS_MIX = 224 * MiB;
constexpr size_t WS_YZ = 260 * MiB;
constexpr size_t WS_OPART = 280 * MiB;
constexpr size_t WS_XA = 316 * MiB;
constexpr size_t WS_SLOC = 334 * MiB;
constexpr size_t WS_SUMDT = 354 * MiB;
constexpr size_t WS_END = 355 * MiB;

constexpr int CW_BAR = 4096;
constexpr int CW_QUEUE = 64;

constexpr int LDS_BYTES = 163840;
constexpr int RING_BYTES = 131072;
constexpr int LDS_CTLW = LDS_BYTES - 256;

#define LAS __attribute__((address_space(3)))
typedef unsigned short bf16_t;
typedef short bf16x8 __attribute__((ext_vector_type(8)));
typedef short s16x4 __attribute__((ext_vector_type(4)));
typedef float f32x2 __attribute__((ext_vector_type(2)));
typedef float f32x4 __attribute__((ext_vector_type(4)));
typedef float f32x16 __attribute__((ext_vector_type(16)));
typedef unsigned u32x2 __attribute__((ext_vector_type(2)));
typedef unsigned u32x4 __attribute__((ext_vector_type(4)));

__device__ __forceinline__ unsigned cvtpk(float lo, float hi) { unsigned r; asm volatile("v_cvt_pk_bf16_f32 %0, %1, %2" : "=v"(r) : "v"(lo), "v"(hi)); return r; }
__device__ __forceinline__ float bf_lo(unsigned w) { return __uint_as_float(w << 16); }
__device__ __forceinline__ float bf_hi(unsigned w) { return __uint_as_float(w & 0xffff0000u); }
__device__ __forceinline__ float bf2f(bf16_t b) { return __uint_as_float(((unsigned)b) << 16); }
__device__ __forceinline__ bf16_t f2bf(float f) { return (bf16_t)(cvtpk(f, 0.f) & 0xffffu); }
__device__ __forceinline__ float wave_sum(float v) {
#pragma unroll
    for (int o = 1; o < 64; o <<= 1) v += __shfl_xor(v, o);
    return v;
}
__device__ __forceinline__ float fast_exp2(float x) { return __builtin_amdgcn_exp2f(x); }
__device__ __forceinline__ float fast_rcp(float x) { return __builtin_amdgcn_rcpf(x); }
__device__ __forceinline__ float silu_f(float x) { return x * fast_rcp(1.f + fast_exp2(-x * LOG2E)); }

#define XB_TMO      128
#define XB_XCNT(j)  (256  + 64 * (j))
#define XB_XSUB(j)  (1280 + 64 * (j))
#define XB_XGEN(j)  (2304 + 64 * (j))
#define XB_TOP      3328
#define XB_TOPGEN   3392
#define XCD_BAR_WORDS 3456
#define XB_SPIN_CAP (1u << 18)

__device__ __forceinline__ unsigned xb_ld(unsigned* p)              { return __hip_atomic_load(p, __ATOMIC_RELAXED, __HIP_MEMORY_SCOPE_AGENT); }
__device__ __forceinline__ unsigned xb_add(unsigned* p, unsigned v) { return __hip_atomic_fetch_add(p, v, __ATOMIC_RELAXED, __HIP_MEMORY_SCOPE_AGENT); }
__device__ __forceinline__ unsigned xb_xcc_id() { return (unsigned)__builtin_amdgcn_s_getreg((3 << 11) | 20) & 0xFu; }
#define XB_SPIN(cond, bar) do { unsigned _sp = 0; while (cond) { __builtin_amdgcn_s_sleep(1); \
    if ((++_sp & 255u) == 0u) { if (xb_ld(&(bar)[XB_TMO])) break; if (_sp > XB_SPIN_CAP) { atomicAdd(&(bar)[XB_TMO], 1u); break; } } } } while (0)

struct XcdBarrier { unsigned* bar; unsigned x; volatile LAS unsigned* st; };

__device__ __forceinline__ XcdBarrier xcd_barrier_post(unsigned* bar, volatile LAS unsigned* st) {
    XcdBarrier b; b.bar = bar; b.x = xb_xcc_id(); b.st = st;
    if (threadIdx.x == 0) (void)xb_add(&bar[XB_XCNT(b.x)], 1u);
    return b;
}
__device__ __forceinline__ void xcd_barrier_complete(unsigned* bar, unsigned x, unsigned& nloc, unsigned& nx) {
    const unsigned G = gridDim.x * gridDim.y * gridDim.z;
    unsigned sum, cnt, mine, sp = 0u;
    for (;;) {
        sum = 0u; cnt = 0u; mine = 0u;
#pragma unroll
        for (unsigned j = 0; j < 16; ++j) { const unsigned c = xb_ld(&bar[XB_XCNT(j)]); sum += c; cnt += (c > 0u) ? 1u : 0u; mine = (j == x) ? c : mine; }
        if (sum == G) break;
        __builtin_amdgcn_s_sleep(1);
        if ((++sp & 255u) == 0u) { if (xb_ld(&bar[XB_TMO])) break; if (sp > XB_SPIN_CAP) { atomicAdd(&bar[XB_TMO], 1u); break; } }
    }
    nloc = mine > 0u ? mine : 1u; nx = cnt > 0u ? cnt : 1u;
}
__device__ __forceinline__ void xcd_barrier(const XcdBarrier& b) {
    asm volatile("s_waitcnt vmcnt(0)" ::: "memory");
    __syncthreads();
    if (threadIdx.x == 0) {
        unsigned* bar = b.bar;
        __builtin_amdgcn_s_waitcnt(0);
        unsigned nloc = b.st[0], nx = b.st[1];
        if (nloc == 0u) { xcd_barrier_complete(bar, b.x, nloc, nx); b.st[0] = nloc; b.st[1] = nx; }
        const unsigned old = xb_add(&bar[XB_XSUB(b.x)], 1u);
        const unsigned gen = old / nloc;
        if (old + 1u == (gen + 1u) * nloc) {
            __builtin_amdgcn_fence(__ATOMIC_RELEASE, "agent");
            asm volatile("s_waitcnt vmcnt(0)" ::: "memory");
            const unsigned og = xb_add(&bar[XB_TOP], 1u);
            const unsigned tg = og / nx;
            if (og + 1u == (tg + 1u) * nx) xb_add(&bar[XB_TOPGEN], 1u);
            else XB_SPIN(xb_ld(&bar[XB_TOPGEN]) == tg, bar);
            __builtin_amdgcn_fence(__ATOMIC_ACQUIRE, "agent");
            xb_add(&bar[XB_XGEN(b.x)], 1u);
            asm volatile("s_waitcnt vmcnt(0)" ::: "memory");
        } else {
            XB_SPIN(xb_ld(&bar[XB_XGEN(b.x)]) == gen, bar);
            __builtin_amdgcn_fence(__ATOMIC_ACQUIRE, "agent");
            asm volatile("s_waitcnt vmcnt(0)" ::: "memory");
        }
    }
    __syncthreads();
}

namespace pg8 {
constexpr int BM = 256, BK = 64, HALF = 128, HTB = HALF * BK * 2, STAGE_BYTES = 8 * HTB, NXCD = 8, WGM = 8;
__host__ __device__ __forceinline__ int lds_byte(int r, int c) { const int st = (r >> 4) * 2 + (c >> 5), rr = r & 15, cc = c & 31, ob = rr * 64 + cc * 2; return st * 1024 + (ob ^ (((ob >> 9) & 1) << 5)); }
__host__ __device__ __forceinline__ void stage_rc(int b, int& R, int& C) { const int st = b / 1024, sb = b % 1024, swz = sb ^ (((sb >> 9) & 1) << 5); R = (st >> 1) * 16 + swz / 64; C = (st & 1) * 32 + (swz % 64) / 2; }

struct Unit { int pm, pn, sel; };
struct Gemm { const bf16_t* A0; const bf16_t* B0; const bf16_t* A1; const bf16_t* B1; int K; };

struct Order {
    int nM, nN, nwg, n1M, n1N, G, c;
    __device__ void init(int nM_, int nN_, int n1M_, int n1N_, int G_, int c_) { nM = nM_; nN = nN_; nwg = nM * nN; n1M = n1M_; n1N = n1N_; G = G_; c = c_; }
    __device__ bool next(int i, Unit& u) const {
        const long L = (long)i * G + c;
        if (L >= nwg + n1M * n1N) return false;
        if (L >= nwg) { const int r = (int)L - nwg; u.pm = r / n1N; u.pn = r % n1N; u.sel = 1; return true; }
        int wgid = (int)L; { const int q = nwg / NXCD, r = nwg % NXCD, xcd = wgid % NXCD, off = wgid / NXCD; wgid = (xcd < r ? xcd * (q + 1) : r * (q + 1) + (xcd - r) * q) + off; }
        const int nig = WGM * nN, gid = wgid / nig, fm = gid * WGM, gsz = (nM - fm) < WGM ? (nM - fm) : WGM;
        u.pm = fm + ((wgid % nig) % gsz); u.pn = (wgid % nig) / gsz; u.sel = 0; return true;
    }
};

template <class Epi>
__device__ __forceinline__ void gemm_phase(LAS unsigned char* lds, const Gemm g, const Order& S, const Epi& E) {
    const int tid = threadIdx.x, wid = __builtin_amdgcn_readfirstlane(tid >> 6), lane = tid & 63, wr = wid >> 2, wc = wid & 3, fr = lane & 15, fq = lane >> 4;
    const int K = g.K, nt = K / BK;
    unsigned voffA[2];
#pragma unroll
    for (int i = 0; i < 2; ++i) { int R, C; stage_rc(tid * 16 + i * 8192, R, C); voffA[i] = (unsigned)(R * K + C) * 2u; }
    const size_t kstep = (size_t)(BK * 2);
    const size_t hstep = (size_t)HALF * K * 2;
    const size_t tstep = 2 * hstep;
    const unsigned ldsw = (unsigned)wid * 1024u;
    const int aoff = lds_byte(wr * 64 + fr, fq * 8), boff = lds_byte(wc * 32 + fr, fq * 8);
#define PG8_SA(b, h) (((b) * 2 + (h)) * HTB)
#define PG8_SB(b, h) ((4 + (b) * 2 + (h)) * HTB)
#define PG8_STAGE(bufoff, gbase) do { _Pragma("unroll") for (int _i = 0; _i < 2; ++_i) \
        __builtin_amdgcn_global_load_lds((const unsigned*)((const char*)(gbase) + voffA[_i]), (LAS unsigned*)(lds + (bufoff) + ldsw + _i * 8192), 16, 0, 0); } while (0)
#define PG8_LDA(dst, b, h) do { _Pragma("unroll") for (int m = 0; m < 4; ++m) _Pragma("unroll") for (int k = 0; k < 2; ++k) dst[m][k] = *(const LAS bf16x8*)(lds + PG8_SA(b, h) + aoff + m * 2048 + k * 1024); } while (0)
#define PG8_LDB(dst, b, h) do { _Pragma("unroll") for (int n = 0; n < 2; ++n) _Pragma("unroll") for (int k = 0; k < 2; ++k) dst[n][k] = *(const LAS bf16x8*)(lds + PG8_SB(b, h) + boff + n * 2048 + k * 1024); } while (0)
#define PG8_MMA(ai, bj, At, Bt) do { __builtin_amdgcn_s_setprio(1); _Pragma("unroll") for (int m = 0; m < 4; ++m) _Pragma("unroll") for (int n = 0; n < 2; ++n) _Pragma("unroll") for (int k = 0; k < 2; ++k) \
        acc[ai][bj][m][n] = __builtin_amdgcn_mfma_f32_16x16x32_bf16(Bt[n][k], At[m][k], acc[ai][bj][m][n], 0, 0, 0); __builtin_amdgcn_s_setprio(0); } while (0)
#define PG8_WAIT_V(n) asm volatile("s_waitcnt vmcnt(" #n ")" ::: "memory")
#define PG8_WAIT_L(n) asm volatile("s_waitcnt lgkmcnt(" #n ")" ::: "memory")
#define PG8_BAR __builtin_amdgcn_s_barrier()
#define PG8_SCHED __builtin_amdgcn_sched_barrier(0)
    Unit cur, nxt; int ui = 0;
    if (!S.next(0, cur)) return;
    f32x4 acc[2][2][4][2];
#pragma unroll
    for (int a = 0; a < 2; ++a)
#pragma unroll
        for (int b = 0; b < 2; ++b)
#pragma unroll
            for (int m = 0; m < 4; ++m)
#pragma unroll
                for (int n = 0; n < 2; ++n) acc[a][b][m][n] = (f32x4){0.f, 0.f, 0.f, 0.f};
    bf16x8 At[4][2], B0[2][2], B1[2][2];
    const char* cA = (const char*)(cur.sel ? g.A1 : g.A0) + (size_t)cur.pm * tstep; const char* cB = (const char*)(cur.sel ? g.B1 : g.B0) + (size_t)cur.pn * tstep;
    PG8_STAGE(PG8_SB(0, 0), cB); PG8_STAGE(PG8_SB(0, 1), cB + hstep); PG8_STAGE(PG8_SA(0, 0), cA); PG8_STAGE(PG8_SA(0, 1), cA + hstep);
    if (wr == 1) PG8_BAR;
    PG8_WAIT_V(2); PG8_BAR;
    PG8_STAGE(PG8_SB(1, 0), cB + kstep); PG8_STAGE(PG8_SA(1, 0), cA + kstep); PG8_STAGE(PG8_SB(1, 1), cB + hstep + kstep);
    PG8_WAIT_V(6); PG8_BAR;
    for (;;) {
        const bool has_next = S.next(ui + 1, nxt);
        const char* nA = has_next ? (const char*)(nxt.sel ? g.A1 : g.A0) + (size_t)nxt.pm * tstep : cA; const char* nB = has_next ? (const char*)(nxt.sel ? g.B1 : g.B0) + (size_t)nxt.pn * tstep : cB;
        for (int t = 0; t < nt; t += 2) {
            const bool last = (t == nt - 2);
            const char* a1 = cA + (size_t)(t + 1) * kstep;
            const char* a2 = last ? nA : cA + (size_t)(t + 2) * kstep; const char* b2 = last ? nB : cB + (size_t)(t + 2) * kstep;
            const char* a3 = a2 + kstep; const char* b3 = b2 + kstep;
            if constexpr (Epi::MID > 0) { if (t == Epi::MID) E.mid(acc, cur, wr, fr); }
            PG8_LDB(B0, 0, 0); PG8_LDB(B1, 0, 1); PG8_SCHED; PG8_LDA(At, 0, 0); PG8_STAGE(PG8_SA(1, 1), a1 + hstep);
            PG8_WAIT_V(8); PG8_WAIT_L(0); PG8_BAR; PG8_MMA(0, 0, At, B0); PG8_MMA(0, 1, At, B1); PG8_BAR; PG8_SCHED;
            PG8_LDA(At, 0, 1); PG8_STAGE(PG8_SB(0, 0), b2); PG8_STAGE(PG8_SB(0, 1), b2 + hstep); PG8_STAGE(PG8_SA(0, 0), a2);
            PG8_WAIT_V(8); PG8_WAIT_L(0); PG8_BAR; PG8_MMA(1, 0, At, B0); PG8_MMA(1, 1, At, B1); PG8_BAR; PG8_SCHED;
            PG8_LDB(B0, 1, 0); PG8_LDB(B1, 1, 1); PG8_SCHED; PG8_LDA(At, 1, 0); PG8_STAGE(PG8_SA(0, 1), a2 + hstep);
            PG8_WAIT_V(8); PG8_WAIT_L(0); PG8_BAR; PG8_MMA(0, 0, At, B0); PG8_MMA(0, 1, At, B1); PG8_BAR; PG8_SCHED;
            PG8_LDA(At, 1, 1); PG8_STAGE(PG8_SB(1, 0), b3); PG8_STAGE(PG8_SB(1, 1), b3 + hstep); PG8_STAGE(PG8_SA(1, 0), a3);
            PG8_WAIT_V(8); PG8_WAIT_L(0); PG8_BAR; PG8_MMA(1, 0, At, B0); PG8_MMA(1, 1, At, B1); PG8_BAR; PG8_SCHED;
        }
        if (wr == 0) PG8_BAR;
        E(acc, cur, wr, wc, fr, fq);
        if (!has_next) break;
#pragma unroll
        for (int a = 0; a < 2; ++a)
#pragma unroll
            for (int b = 0; b < 2; ++b)
#pragma unroll
                for (int m = 0; m < 4; ++m)
#pragma unroll
                    for (int n = 0; n < 2; ++n) acc[a][b][m][n] = (f32x4){0.f, 0.f, 0.f, 0.f};
        cur = nxt; cA = nA; cB = nB; ++ui;
        if (wr == 1) PG8_BAR;
    }
    PG8_WAIT_V(0);
    PG8_BAR;
#undef PG8_SA
#undef PG8_SB
#undef PG8_STAGE
#undef PG8_LDA
#undef PG8_LDB
#undef PG8_MMA
#undef PG8_WAIT_V
#undef PG8_WAIT_L
#undef PG8_BAR
#undef PG8_SCHED
}
typedef f32x4 Acc[2][2][4][2];
__device__ __forceinline__ void store_f32(const Acc& acc, float* base, int ld, int rl0, int cl0, int valid) {
#pragma unroll
    for (int ai = 0; ai < 2; ++ai)
#pragma unroll
        for (int m = 0; m < 4; ++m) { const int row = rl0 + ai * HALF + m * 16; if (row < valid) { float* rp = base + (size_t)row * ld + cl0;
#pragma unroll
            for (int bj = 0; bj < 2; ++bj)
#pragma unroll
                for (int n = 0; n < 2; ++n) *(f32x4*)(rp + bj * HALF + n * 16) = acc[ai][bj][m][n]; } }
}
__device__ __forceinline__ void store_bf16(const Acc& acc, bf16_t* base, int ld, int rl0, int cl0) {
#pragma unroll
    for (int ai = 0; ai < 2; ++ai)
#pragma unroll
        for (int m = 0; m < 4; ++m) { const int row = rl0 + ai * HALF + m * 16; bf16_t* rp = base + (size_t)row * ld + cl0;
#pragma unroll
            for (int bj = 0; bj < 2; ++bj)
#pragma unroll
                for (int n = 0; n < 2; ++n) { const f32x4 a = acc[ai][bj][m][n]; u32x2 w; w.x = cvtpk(a[0], a[1]); w.y = cvtpk(a[2], a[3]); *(u32x2*)(rp + bj * HALF + n * 16) = w; } }
}
}

struct Params {
    const float* in[26];
    float* out;
    unsigned char* ws;
    int ph_lo, ph_hi;
};
enum { I_XP = 0, I_XS, I_CK, I_CV, I_SSM, I_SCONV, I_CMK, I_CMV, I_PT, I_MEM, I_NORMW, I_WIN, I_QNORM, I_KNORM, I_SBBIAS, I_CONVW, I_CONVB, I_DTBIAS, I_ALOG, I_DSKIP,
       I_SSDNW, I_MEMNW, I_WMEM, I_MQNORM, I_MKNORM, I_WOUT };

template <int MAP>
__device__ __forceinline__ void p0_transpose_item(const float* W, int K, int Nsrc, int N, bf16_t* WT, LAS float* scr, int item, int lane) {
    const int nblk = N / 128, kb = item / nblk, nb = item % nblk, k0 = 32 * kb, n0 = 128 * nb;
    const int ks0 = (MAP == 2) ? (k0 < 512 ? k0 + 1024 : (k0 < 1536 ? k0 - 512 : k0)) : k0;
    const int nd = n0 + 4 * (lane & 31);
    int ns = nd; bool ok = true;
    if (MAP == 1) { if (nd < 5632) ns = nd; else if (nd < 6656) ns = nd + 8; else if (nd < 6664) ns = nd - 1024; else { ns = 0; ok = false; } }
    f32x4 v[16];
#pragma unroll
    for (int i = 0; i < 16; ++i) { const int kk = 2 * i + (lane >> 5); v[i] = ok ? *(const f32x4*)(W + (size_t)(ks0 + kk) * Nsrc + ns) : f32x4{0.f, 0.f, 0.f, 0.f}; }
#pragma unroll
    for (int i = 0; i < 16; ++i) { const int kk = 2 * i + (lane >> 5); *(LAS f32x4*)(scr + kk * 132 + 4 * (lane & 31)) = v[i]; }
    asm volatile("s_waitcnt lgkmcnt(0)" ::: "memory");
    const int nl = lane & 15, c = lane >> 4;
#pragma unroll
    for (int j = 0; j < 8; ++j) { const LAS float* sp = scr + (8 * c) * 132 + nl + 16 * j;
        u32x4 o; o.x = cvtpk(sp[0 * 132], sp[1 * 132]); o.y = cvtpk(sp[2 * 132], sp[3 * 132]); o.z = cvtpk(sp[4 * 132], sp[5 * 132]); o.w = cvtpk(sp[6 * 132], sp[7 * 132]);
        *(u32x4*)(WT + (size_t)(n0 + nl + 16 * j) * K + k0 + 8 * c) = o; }
    asm volatile("s_waitcnt lgkmcnt(0)" ::: "memory");
}
__device__ __forceinline__ void rms_row_to_bf16(const float* xrow, const float* gain, bf16_t* orow, int lane) {
    const f32x4* xr = (const f32x4*)xrow + lane; const f32x4* gr = (const f32x4*)gain + lane;
    f32x4 v[8]; float s = 0.f;
#pragma unroll
    for (int j = 0; j < 8; ++j) { v[j] = xr[64 * j]; s += (v[j].x * v[j].x + v[j].y * v[j].y) + (v[j].z * v[j].z + v[j].w * v[j].w); }
    const float rs = 1.f / sqrtf(wave_sum(s) * (1.f / DM) + EPS);
    u32x2* o8 = (u32x2*)orow + lane;
#pragma unroll
    for (int j = 0; j < 8; ++j) { const f32x4 g = gr[64 * j]; u32x2 w; w.x = cvtpk(v[j].x * rs * g.x, v[j].y * rs * g.y); w.y = cvtpk(v[j].z * rs * g.z, v[j].w * rs * g.w); o8[64 * j] = w; }
}
__device__ __forceinline__ void phase0(const Params& p, LAS unsigned char* lds, int vcu, int G) {
    const int tid = threadIdx.x, lane = tid & 63, wave = __builtin_amdgcn_readfirstlane(tid >> 6);
    LAS float* scr = (LAS float*)(lds + wave * 16896);
    const int gw = vcu * 8 + wave, NGW = G * 8;
    bf16_t* WinT = (bf16_t*)(p.ws + WS_WIN); bf16_t* WmT = (bf16_t*)(p.ws + WS_WM); bf16_t* WoutT = (bf16_t*)(p.ws + WS_WOUT);
    constexpr int I_IN = (DM / 32) * (NPAD / 128), I_M = (DM / 32) * (1024 / 128), I_O = (DM / 32) * (DM / 128);
    for (int it = gw; it < I_IN + I_M + I_O; it += NGW) {
        int r = it;
        if (r < I_IN) { p0_transpose_item<1>(p.in[I_WIN], DM, NIN, NPAD, WinT, scr, r, lane); continue; } r -= I_IN;
        if (r < I_M) { p0_transpose_item<0>(p.in[I_WMEM], DM, 1024, 1024, WmT, scr, r, lane); continue; } r -= I_M;
        p0_transpose_item<2>(p.in[I_WOUT], DM, DM, DM, WoutT, scr, r, lane);
    }
    bf16_t* H = (bf16_t*)(p.ws + WS_H); bf16_t* HM = (bf16_t*)(p.ws + WS_HM);
    for (int m = gw; m < MVALID + MMEM; m += NGW) {
        if (m < MP) rms_row_to_bf16(p.in[I_XP] + (size_t)m * DM, p.in[I_NORMW], H + (size_t)m * DM, lane);
        else if (m < MVALID) rms_row_to_bf16(p.in[I_XS] + (size_t)(m - MP) * DM, p.in[I_NORMW], H + (size_t)m * DM, lane);
        else rms_row_to_bf16(p.in[I_MEM] + (size_t)(m - MVALID) * DM, p.in[I_MEMNW], HM + (size_t)(m - MVALID) * DM, lane);
    }
    const int gt = vcu * 512 + tid, NGT = G * 512;
    u32x4* cmk = (u32x4*)(p.ws + WS_CMK); u32x4* cmv = (u32x4*)(p.ws + WS_CMV);
    constexpr int N8 = DSEQ * MEMT * 512 / 8;
    for (int i = gt; i < 2 * N8; i += NGT) { const bool isk = i < N8; const int j = isk ? i : i - N8; const f32x4* s = (const f32x4*)(isk ? p.in[I_CMK] : p.in[I_CMV]) + 2 * (size_t)j;
        const f32x4 a = s[0], b = s[1]; u32x4 o; o.x = cvtpk(a.x, a.y); o.y = cvtpk(a.z, a.w); o.z = cvtpk(b.x, b.y); o.w = cvtpk(b.z, b.w); (isk ? cmk : cmv)[j] = o; }
}

struct Epi1 {
    static constexpr int MID = 0;
    bf16_t* PROJ; float* DT; float* out; const float* dtbias; const float* qn; const float* kn; const float* mqn; const float* mkn; bf16_t* MKn; bf16_t* MVb; LAS float* T;
    __device__ __forceinline__ void head_norm(pg8::Acc& acc, const float* gain, float gscale, int wr, int wc, int fr, int fq) const {
        float part[2][4][2];
#pragma unroll
        for (int ai = 0; ai < 2; ++ai)
#pragma unroll
            for (int m = 0; m < 4; ++m)
#pragma unroll
                for (int bj = 0; bj < 2; ++bj) { const f32x4 a = acc[ai][bj][m][0], b = acc[ai][bj][m][1];
                    float s = ((a.x * a.x + a.y * a.y) + (a.z * a.z + a.w * a.w)) + ((b.x * b.x + b.y * b.y) + (b.z * b.z + b.w * b.w));
                    s += __shfl_xor(s, 16); s += __shfl_xor(s, 32); part[ai][m][bj] = s; }
        if (fq == 0) {
#pragma unroll
            for (int ai = 0; ai < 2; ++ai)
#pragma unroll
                for (int m = 0; m < 4; ++m)
#pragma unroll
                    for (int bj = 0; bj < 2; ++bj) T[(((wr * 128 + ai * 64 + m * 16 + fr) * 2 + bj) << 2) + wc] = part[ai][m][bj];
        }
        asm volatile("s_waitcnt lgkmcnt(0)" ::: "memory");
        __builtin_amdgcn_s_barrier();
        asm volatile("" ::: "memory");
        int cg = wc * 32 + 4 * fq; asm volatile("" : "+v"(cg));
        const f32x4 g0 = *(const f32x4*)(gain + cg) * gscale, g1 = *(const f32x4*)(gain + cg + 16) * gscale;
#pragma unroll
        for (int ai = 0; ai < 2; ++ai)
#pragma unroll
            for (int m = 0; m < 4; ++m)
#pragma unroll
                for (int bj = 0; bj < 2; ++bj) { const f32x4 t = *(const LAS f32x4*)(T + (((wr * 128 + ai * 64 + m * 16 + fr) * 2 + bj) << 2));
                    const float rs = 1.f / sqrtf(((t.x + t.y) + (t.z + t.w)) * (1.f / 128.f) + EPS);
                    acc[ai][bj][m][0] = acc[ai][bj][m][0] * rs * g0; acc[ai][bj][m][1] = acc[ai][bj][m][1] * rs * g1;
                    asm volatile("" ::: "memory"); }
    }
    __device__ __forceinline__ void operator()(pg8::Acc& acc, const pg8::Unit& u, int wr, int wc, int fr, int fq) const {
        int rl0 = wr * 64 + fr, cl0 = wc * 32 + 4 * fq;
        asm volatile("" : "+v"(rl0), "+v"(cl0));
        const int pn = u.pn; const size_t r0 = (size_t)u.pm * 256;
        const float* gain = nullptr; float gs = 1.f;
        float* fbase = nullptr; int fld = 1024, valid = 256;
        bf16_t* bbase = PROJ + r0 * NPAD + pn * 256; int bld = NPAD;
        if (u.sel == 1) { if (pn < 2) gain = mkn; fbase = out + (pn < 2 ? O_PMK : O_PMV) + r0 * 512 + (pn & 1) * 256; fld = 512; bbase = (pn < 2 ? MKn : MVb) + r0 * 512 + (pn & 1) * 256; bld = 512; }
        else {
            if (pn < 4) { gain = qn; gs = QSCALE; } else if (pn < 8) gain = kn; else if (pn == 22 || pn == 23) { gain = mqn; gs = QSCALE; }
            if (pn >= 4 && pn < 12) { if (u.pm < 32) fbase = out + (pn < 8 ? O_PK : O_PV) + r0 * 1024 + (pn & 3) * 256; else { fbase = out + (pn < 8 ? O_SK : O_SV) + (pn & 3) * 256; valid = MS; } }
        }
        if (gain) head_norm(acc, gain, gs, wr, wc, fr, fq);
        if (fbase) pg8::store_f32(acc, fbase, fld, rl0, cl0, valid);
        pg8::store_bf16(acc, bbase, bld, rl0, cl0);
        if (u.sel == 1) return;
        if (pn >= 18 && pn < 22) {
#pragma unroll
            for (int ai = 0; ai < 2; ++ai)
#pragma unroll
                for (int m = 0; m < 4; ++m) { const int row = rl0 + ai * 128 + m * 16; float* dst = nullptr;
                    if (u.pm < 32) { if ((u.pm & 7) == 7 && row >= 253) dst = out + O_PCONV + (size_t)((u.pm >> 3) * 3 + row - 253) * 1024; }
                    else if (row < MS && (row & 7) >= 5) dst = out + O_SCONV + (size_t)((row >> 3) * 3 + (row & 7) - 5) * 1024;
                    if (dst) { dst += (pn - 18) * 256 + cl0;
#pragma unroll
                        for (int bj = 0; bj < 2; ++bj)
#pragma unroll
                            for (int n = 0; n < 2; ++n) *(f32x4*)(dst + bj * 128 + n * 16) = acc[ai][bj][m][n]; } }
        }
        if (pn == 26 && wc == 0 && fq < 2) {
            const f32x4 db = *(const f32x4*)(dtbias + 4 * fq);
#pragma unroll
            for (int ai = 0; ai < 2; ++ai)
#pragma unroll
                for (int m = 0; m < 4; ++m) { const int row = rl0 + ai * 128 + m * 16; f32x4 v = acc[ai][0][m][0] + db;
#pragma unroll
                    for (int e = 0; e < 4; ++e) v[e] = (v[e] > 20.f) ? v[e] : log1pf(__expf(v[e]));
                    *(f32x4*)(DT + (r0 + row) * 8 + 4 * fq) = v; }
        }
    }
};

__device__ __forceinline__ float group16_sum(float v) { v += __shfl_xor(v, 1); v += __shfl_xor(v, 2); v += __shfl_xor(v, 4); v += __shfl_xor(v, 8); return v; }

#define KSWZ(row, colB) ((row) * 256 + ((colB) ^ (((row) & 7) << 4)))
#define SBAR() __builtin_amdgcn_sched_barrier(0)
__device__ __forceinline__ int crow(int r, int hi) { return (r & 3) + 8 * (r >> 2) + 4 * hi; }
__device__ __forceinline__ int v_st(int k, int c) { const int kk = (k & ~0xC) | ((k & 4) << 1) | ((k & 8) >> 1); return ((kk >> 3) * 4 + (c >> 5)) * 512 + ((kk & 7) * 32 + (c & 31)) * 2; }
__device__ __forceinline__ int v_rd_base(int lane) { return ((lane & 3) << 3) | (((lane >> 2) & 3) << 6) | (((lane >> 4) & 1) << 5) | (((lane >> 5) & 1) << 8); }
constexpr int v_rd_off(int d0, int ks, int half) { return d0 * 512 + ks * 4096 + half * 2048; }
template <int OFF> __device__ __forceinline__ s16x4 tr_read(int vb) {
    s16x4 r; asm volatile("ds_read_b64_tr_b16 %0, %1 offset:%2" : "=&v"(r) : "v"(vb), "i"(OFF) : "memory"); return r;
}
#define PKV(L, H) (bf16x8){L[0], L[1], L[2], L[3], H[0], H[1], H[2], H[3]}
template <int D0, int KS0> __device__ __forceinline__ void pv_one(f32x16& od, int vb, const bf16x8* pa) {
    const s16x4 l0 = tr_read<v_rd_off(D0, KS0, 0)>(vb), h0 = tr_read<v_rd_off(D0, KS0, 1)>(vb), l1 = tr_read<v_rd_off(D0, KS0 + 1, 0)>(vb), h1 = tr_read<v_rd_off(D0, KS0 + 1, 1)>(vb);
    asm volatile("s_waitcnt lgkmcnt(0)" ::: "memory"); SBAR();
    od = __builtin_amdgcn_mfma_f32_32x32x16_bf16(pa[0], PKV(l0, h0), od, 0, 0, 0);
    od = __builtin_amdgcn_mfma_f32_32x32x16_bf16(pa[1], PKV(l1, h1), od, 0, 0, 0);
}
template <int KS0> __device__ __forceinline__ void pv_blk(f32x16* o, int vb, const bf16x8* pa) {
    pv_one<0, KS0>(o[0], vb, pa); pv_one<1, KS0>(o[1], vb, pa); pv_one<2, KS0>(o[2], vb, pa); pv_one<3, KS0>(o[3], vb, pa);
}
__device__ __forceinline__ void pack_p(const f32x16& P, bf16x8& out0, bf16x8& out1) {
#define PK4(BASE, OUT) do { unsigned a0 = cvtpk(P[BASE + 0], P[BASE + 1]), a1 = cvtpk(P[BASE + 2], P[BASE + 3]);   \
    unsigned b0 = cvtpk(P[BASE + 4], P[BASE + 5]), b1 = cvtpk(P[BASE + 6], P[BASE + 7]);                              \
    auto r0 = __builtin_amdgcn_permlane32_swap(a0, b0, false, false); auto r1 = __builtin_amdgcn_permlane32_swap(a1, b1, false, false); \
    u32x4 w = {r0[0], r1[0], r0[1], r1[1]}; OUT = *reinterpret_cast<bf16x8*>(&w); } while (0)
    PK4(0, out0); PK4(8, out1);
#undef PK4
}
template <int NB, bool MASK> __device__ __forceinline__ void sb_transform(f32x16* P, float& R, int hi, int kpos0, int qpos) {
    float T[NB][4];
#pragma unroll
    for (int b = 0; b < NB; ++b)
#pragma unroll
        for (int g = 0; g < 4; ++g) {
            float be[4], f[4];
#pragma unroll
            for (int i = 0; i < 4; ++i) {
                const float z = fmaxf(P[b][4 * g + i], -100.f);
                const float e = fast_exp2(-z), rc = fast_rcp(1.f + e);
                be[i] = rc; f[i] = e * rc;
                if (MASK) { const bool ok = (kpos0 + 32 * b + 8 * g + 4 * hi + i) < qpos; be[i] = ok ? be[i] : 0.f; f[i] = ok ? f[i] : 1.f; }
            }
            const float e2 = f[3], e1 = f[2] * f[3], e0 = f[1] * e1;
            T[b][g] = f[0] * e0;
            P[b][4 * g + 0] = be[0] * e0; P[b][4 * g + 1] = be[1] * e1; P[b][4 * g + 2] = be[2] * e2; P[b][4 * g + 3] = be[3];
        }
    float E = R;
#pragma unroll
    for (int b = NB - 1; b >= 0; --b)
#pragma unroll
        for (int g = 3; g >= 0; --g) {
            const float To = __shfl_xor(T[b][g], 32);
            const float Eg = hi ? E : E * To;
#pragma unroll
            for (int i = 0; i < 4; ++i) P[b][4 * g + i] *= Eg;
            E = E * T[b][g] * To;
        }
    R = E;
}

struct AttnArgs {
    const bf16_t* Q; int qstride;
    const bf16_t* K; const bf16_t* V; int kvstride;
    int ntiles;
    int qpos0;
    int nvalid;
    float bias2;
    const bf16_t* gate; int gstride;
    bf16_t* out; int ostride;
};
template <int MODE>
__device__ __forceinline__ void attn_unit(LAS unsigned char* lds, const bf16_t* aQ, int aqstride, const bf16_t* aK, const bf16_t* aV, int akvstride, int antiles, int aqpos0, int anvalid, float abias2,
                                      const bf16_t* agate, int agstride, bf16_t* aout, int aostride) {
    AttnArgs a; a.Q = aQ; a.qstride = aqstride; a.K = aK; a.V = aV; a.kvstride = akvstride; a.ntiles = antiles; a.qpos0 = aqpos0; a.nvalid = anvalid; a.bias2 = abias2;
    a.gate = agate; a.gstride = agstride; a.out = aout; a.ostride = aostride;
    int tid = threadIdx.x; asm volatile("" : "+v"(tid));
    const int wid = __builtin_amdgcn_readfirstlane(tid >> 6), lane = tid & 63, r32 = lane & 31, hi = lane >> 5;
    constexpr int SHM_V = 16384, SHM_K = 16384;
    LAS unsigned char* V_lds = lds; LAS unsigned char* K_lds = lds + 2 * SHM_V;
    LAS float* wsf = (LAS float*)(lds + 2 * SHM_V + 2 * SHM_K) + wid * 64;
    f32x16 o[4];
#pragma unroll
    for (int d = 0; d < 4; ++d) o[d] = f32x16{};
    bf16x8 qr[8];
    { int qrow = wid * 32 + r32; qrow = qrow < a.nvalid ? qrow : a.nvalid - 1;
      const bf16_t* Qw = a.Q + (size_t)qrow * a.qstride + hi * 8;
#pragma unroll
      for (int d0 = 0; d0 < 8; ++d0) qr[d0] = *(const bf16x8*)(Qw + d0 * 16); }
    const int sr = tid >> 4, sc = (tid & 15) * 8, vst0 = v_st(sr, sc), vst1 = v_st(32 + sr, sc);
    const int vb0 = (int)(uintptr_t)V_lds + v_rd_base(lane);
    bf16x8 sv0, sv1, sk0, sk1;
#define SLOAD(k0) do { sv0 = *(const bf16x8*)(a.V + (size_t)((k0) + sr) * a.kvstride + sc); sv1 = *(const bf16x8*)(a.V + (size_t)((k0) + 32 + sr) * a.kvstride + sc); \
    sk0 = *(const bf16x8*)(a.K + (size_t)((k0) + sr) * a.kvstride + sc); sk1 = *(const bf16x8*)(a.K + (size_t)((k0) + 32 + sr) * a.kvstride + sc); } while (0)
#define SWRITE(b) do { *(LAS bf16x8*)(V_lds + (b) * SHM_V + vst0) = sv0; *(LAS bf16x8*)(V_lds + (b) * SHM_V + vst1) = sv1; \
    *(LAS bf16x8*)(K_lds + (b) * SHM_K + KSWZ(sr, sc * 2)) = sk0; *(LAS bf16x8*)(K_lds + (b) * SHM_K + KSWZ(32 + sr, sc * 2)) = sk1; } while (0)
    const int nt = a.ntiles;
    float R = 1.f, lsum = 0.f;
    const int qpos = a.qpos0 + wid * 32 + r32;
    const int qmax_w = a.qpos0 + wid * 32 + 31;
    __syncthreads();
    { const int t0 = (MODE == 0) ? nt - 1 : 0; SLOAD(t0 * 64); SWRITE(0); }
    __syncthreads();
    for (int j = 0; j < nt; ++j) {
        const int cur = j & 1, t = (MODE == 0) ? nt - 1 - j : j;
        if (j + 1 < nt) { const int tn = (MODE == 0) ? t - 1 : t + 1; SLOAD(tn * 64); }
        const bool active = (MODE == 1) || (t * 64 < qmax_w);
        if (active) {
            const LAS unsigned char* Ks = K_lds + cur * SHM_K;
            const bool diag = (MODE == 0) && (t * 64 + 63 >= a.qpos0);
#define ATT_BLOCK(B) do { f32x16 pb_[1]; { const float init = (MODE == 0) ? a.bias2 : 0.f; _Pragma("unroll") for (int r = 0; r < 16; ++r) pb_[0][r] = init; } \
            _Pragma("unroll") for (int d0 = 0; d0 < 8; ++d0) { const int cb = (d0 * 16 + hi * 8) * 2; \
                const bf16x8 kf = *(const LAS bf16x8*)(Ks + KSWZ(32 * (B) + r32, cb)); \
                pb_[0] = __builtin_amdgcn_mfma_f32_32x32x16_bf16(kf, qr[d0], pb_[0], 0, 0, 0); } \
            if (MODE == 0) { if (diag) sb_transform<1, true>(pb_, R, hi, t * 64 + 32 * (B), qpos); else sb_transform<1, false>(pb_, R, hi, 0, 0); } \
            else { float ps = 0.f; _Pragma("unroll") for (int r = 0; r < 16; ++r) { pb_[0][r] = fast_exp2(pb_[0][r]); ps += pb_[0][r]; } lsum += ps; } \
            bf16x8 pa_[2]; pack_p(pb_[0], pa_[0], pa_[1]); SBAR(); \
            pv_blk<2 * (B)>(o, vb0 + cur * SHM_V, pa_); } while (0)
            ATT_BLOCK(1);
            ATT_BLOCK(0);
#undef ATT_BLOCK
        }
        if (j + 1 < nt) SWRITE(cur ^ 1);
        __syncthreads();
    }
#undef SLOAD
#undef SWRITE
    float rl[16];
    if (MODE == 1) {
        lsum += __shfl_xor(lsum, 32);
        if (hi == 0) wsf[r32] = lsum;
        asm volatile("s_waitcnt lgkmcnt(0)" ::: "memory");
#pragma unroll
        for (int r = 0; r < 16; ++r) rl[r] = fast_rcp(wsf[crow(r, hi)]);
    }
#pragma unroll
    for (int r = 0; r < 16; ++r) {
        const int row = wid * 32 + crow(r, hi);
        if (row < a.nvalid) {
#pragma unroll
            for (int d0 = 0; d0 < 4; ++d0) {
                const float gt = bf2f(a.gate[(size_t)row * a.gstride + d0 * 32 + r32]);
                float v = o[d0][r]; if (MODE == 1) v *= rl[r];
                a.out[(size_t)row * a.ostride + d0 * 32 + r32] = f2bf(v * silu_f(gt));
            }
        }
    }
}

__device__ __forceinline__ void decode_unit(const int* ptab, const float* ck, const float* cv, const float* sbbias, unsigned char* ws, LAS unsigned char* lds, int seq, int page) {
    int tid = threadIdx.x; asm volatile("" : "+v"(tid));
    const int wid = __builtin_amdgcn_readfirstlane(tid >> 6), lane = tid & 63, r32 = lane & 31, hi = lane >> 5;
    const int head = wid;
    LAS unsigned char* K_lds = lds + wid * 16384; LAS unsigned char* V_lds = K_lds + 8192;
    const int phys = __builtin_amdgcn_readfirstlane(ptab[seq * NPAGES + page]);
    const float* Kp = ck + (size_t)phys * (PAGE * 1024) + head * 128;
    const float* Vp = cv + (size_t)phys * (PAGE * 1024) + head * 128;
    const float bias2 = sbbias[head] * LOG2E;
    const bf16_t* PROJ = (const bf16_t*)(ws + WS_PROJ);
    LAS unsigned char* Q_lds = lds + RING_BYTES + wid * 2048;
    f32x16 o[4];
#pragma unroll
    for (int d = 0; d < 4; ++d) o[d] = f32x16{};
    float R = 1.f;
    const int srow = lane >> 4, scol = (lane & 15) * 8;
    const int vb0 = (int)(uintptr_t)V_lds + v_rd_base(lane);
    __syncthreads();
#pragma unroll
    for (int i = 0; i < 2; ++i) { const int c = lane + 64 * i, qrw = c >> 4, qc = (c & 15) * 8;
        *(LAS bf16x8*)(Q_lds + KSWZ(qrw, qc * 2)) = *(const bf16x8*)(PROJ + (size_t)(MP + seq * DTOK + qrw) * NPAD + PC_Q + head * 128 + qc); }
    f32x4 st[16];
#define DLOAD(src, kb) do { _Pragma("unroll") for (int i = 0; i < 8; ++i) { const f32x4* g_ = (const f32x4*)((src) + (size_t)((kb) * 32 + srow + 4 * i) * 1024 + scol); \
        st[2 * i] = __builtin_nontemporal_load(g_); st[2 * i + 1] = __builtin_nontemporal_load(g_ + 1); } } while (0)
    DLOAD(Kp, 3);
    for (int kb = 3; kb >= 0; --kb) {
#pragma unroll
        for (int i = 0; i < 8; ++i) { u32x4 w; w.x = cvtpk(st[2 * i].x, st[2 * i].y); w.y = cvtpk(st[2 * i].z, st[2 * i].w); w.z = cvtpk(st[2 * i + 1].x, st[2 * i + 1].y); w.w = cvtpk(st[2 * i + 1].z, st[2 * i + 1].w);
            *(LAS u32x4*)(K_lds + KSWZ(srow + 4 * i, scol * 2)) = w; }
        DLOAD(Vp, kb);
        f32x16 pp[1];
#pragma unroll
        for (int r = 0; r < 16; ++r) pp[0][r] = bias2;
#pragma unroll
        for (int d0 = 0; d0 < 8; ++d0) { const int cb = (d0 * 16 + hi * 8) * 2;
            const bf16x8 b0 = *(const LAS bf16x8*)(K_lds + KSWZ(r32, cb));
            const bf16x8 qf = *(const LAS bf16x8*)(Q_lds + KSWZ(r32 & 7, cb));
            pp[0] = __builtin_amdgcn_mfma_f32_32x32x16_bf16(b0, qf, pp[0], 0, 0, 0); }
        sb_transform<1, false>(pp, R, hi, 0, 0);
        bf16x8 pa[2];
        pack_p(pp[0], pa[0], pa[1]);
#pragma unroll
        for (int i = 0; i < 8; ++i) { u32x4 w; w.x = cvtpk(st[2 * i].x, st[2 * i].y); w.y = cvtpk(st[2 * i].z, st[2 * i].w); w.z = cvtpk(st[2 * i + 1].x, st[2 * i + 1].y); w.w = cvtpk(st[2 * i + 1].z, st[2 * i + 1].w);
            *(LAS u32x4*)(V_lds + v_st(srow + 4 * i, scol)) = w; }
        if (kb > 0) DLOAD(Kp, kb - 1);
        SBAR();
        pv_blk<0>(o, vb0, pa);
    }
#undef DLOAD
    float* Op = (float*)(ws + WS_OPART) + ((size_t)((seq * 8 + head) * NPAGES + page)) * (DTOK * 128);
#pragma unroll
    for (int r = 0; r < 4; ++r)
#pragma unroll
        for (int d0 = 0; d0 < 4; ++d0) Op[(r + 4 * hi) * 128 + d0 * 32 + r32] = o[d0][r];
    if (lane < 8) ((float*)(ws + WS_FPART))[((size_t)((seq * 8 + head) * NPAGES + page)) * DTOK + lane] = R;
}

constexpr int SS_LD = 272;
__device__ __forceinline__ void scan128(float& v0, float& v1, int lane) {
#pragma unroll
    for (int o = 1; o < 64; o <<= 1) { const float t0 = __shfl_up(v0, o), t1 = __shfl_up(v1, o); if (lane >= o) { v0 += t0; v1 += t1; } }
    v1 += __shfl(v0, 63);
}
__device__ __forceinline__ void tr4x8(const u32x4 (&w)[4], u32x2 (&o)[8]) {
#pragma unroll
    for (int k = 0; k < 8; ++k) { const int d = k >> 1;
        if (k & 1) { o[k].x = (w[0][d] >> 16) | (w[1][d] & 0xffff0000u); o[k].y = (w[2][d] >> 16) | (w[3][d] & 0xffff0000u); }
        else       { o[k].x = (w[0][d] & 0xffffu) | (w[1][d] << 16);     o[k].y = (w[2][d] & 0xffffu) | (w[3][d] << 16); } }
}
template <bool SAMPLE>
__device__ __forceinline__ void conv4x8(const bf16_t* PROJ, const float* sconv0, const float* convw, const float* convb, int rowbase, int bs, bool first_chunk, int l0, int ch0, float (&ov)[4][8]) {
    float raw[7][8];
#pragma unroll
    for (int r = 0; r < 7; ++r) { const int l = l0 - 3 + r;
        if (l >= 0 || !first_chunk) { const u32x4 w = *(const u32x4*)(PROJ + (size_t)(rowbase + l) * NPAD + PC_XBC + ch0);
            raw[r][0] = bf_lo(w.x); raw[r][1] = bf_hi(w.x); raw[r][2] = bf_lo(w.y); raw[r][3] = bf_hi(w.y); raw[r][4] = bf_lo(w.z); raw[r][5] = bf_hi(w.z); raw[r][6] = bf_lo(w.w); raw[r][7] = bf_hi(w.w); }
        else if (SAMPLE) { const f32x4* sp = (const f32x4*)(sconv0 + ((size_t)bs * 3 + (3 + l)) * 1024 + ch0); const f32x4 u0 = sp[0], u1 = sp[1];
            raw[r][0] = u0.x; raw[r][1] = u0.y; raw[r][2] = u0.z; raw[r][3] = u0.w; raw[r][4] = u1.x; raw[r][5] = u1.y; raw[r][6] = u1.z; raw[r][7] = u1.w; }
        else {
#pragma unroll
            for (int k = 0; k < 8; ++k) raw[r][k] = 0.f; } }
    float cw[4][8], cbv[8];
#pragma unroll
    for (int jj = 0; jj < 4; ++jj) { const f32x4* sp = (const f32x4*)(convw + jj * 1024 + ch0); const f32x4 u0 = sp[0], u1 = sp[1];
        cw[jj][0] = u0.x; cw[jj][1] = u0.y; cw[jj][2] = u0.z; cw[jj][3] = u0.w; cw[jj][4] = u1.x; cw[jj][5] = u1.y; cw[jj][6] = u1.z; cw[jj][7] = u1.w; }
    { const f32x4* sp = (const f32x4*)(convb + ch0); const f32x4 u0 = sp[0], u1 = sp[1];
        cbv[0] = u0.x; cbv[1] = u0.y; cbv[2] = u0.z; cbv[3] = u0.w; cbv[4] = u1.x; cbv[5] = u1.y; cbv[6] = u1.z; cbv[7] = u1.w; }
#pragma unroll
    for (int r = 0; r < 4; ++r)
#pragma unroll
        for (int k = 0; k < 8; ++k) { float t = cbv[k];
#pragma unroll
            for (int jj = 0; jj < 4; ++jj) t = fmaf(raw[r + jj][k], cw[jj][k], t);
            ov[r][k] = silu_f(t); }
}
constexpr int ST_BT = 0, ST_XTW = 34816, ST_F = 104448;
template <bool SAMPLE>
__device__ __forceinline__ void ssd_state_unit(unsigned char* ws, const float* alog, const float* sconv0, const float* convw, const float* convb, LAS unsigned char* lds, int bs, int c, int g) {
    int tid = threadIdx.x; asm volatile("" : "+v"(tid));
    const int wid = __builtin_amdgcn_readfirstlane(tid >> 6), lane = tid & 63, j16 = lane & 15, ig = lane >> 4;
    const int rowbase = SAMPLE ? MP + bs * DTOK : bs * SEQ + c * 128;
    constexpr int NTOK = SAMPLE ? DTOK : 128;
    const bf16_t* PROJ = (const bf16_t*)(ws + WS_PROJ);
    const bool first_chunk = SAMPLE || c == 0;
    const float* DTS = (const float*)(ws + WS_DT);
    LAS float* xwf = (LAS float*)(lds + ST_F);
    const int sidx0 = SAMPLE ? 512 + bs * 8 + 4 * g : (bs * 8 + 4 * g) * 16 + c;
    __syncthreads();
    if (wid < 4) {
        const int h = 4 * g + wid; const float a_h = -__expf(alog[h]);
        float d0 = (lane < NTOK) ? DTS[(size_t)(rowbase + lane) * 8 + h] : 0.f, d1 = (lane + 64 < NTOK) ? DTS[(size_t)(rowbase + lane + 64) * 8 + h] : 0.f;
        float c0 = d0 * a_h, c1 = d1 * a_h;
        scan128(c0, c1, lane);
        const float cs_end = __shfl(c1, 63);
        xwf[wid * 128 + lane] = d0 * __expf(cs_end - c0); xwf[wid * 128 + 64 + lane] = d1 * __expf(cs_end - c1);
        if (lane == 0) ((float*)(ws + WS_SUMDT))[sidx0 + (SAMPLE ? wid : 16 * wid)] = cs_end;
    }
    __syncthreads();
    {
        const int cc = tid & 15, l0 = 4 * (tid >> 4);
        float ov[4][8];
        conv4x8<SAMPLE>(PROJ, sconv0, convw, convb, rowbase, bs, first_chunk, l0, 512 + g * 128 + 8 * cc, ov);
#pragma unroll
        for (int k = 0; k < 8; ++k) { u32x2 o; o.x = cvtpk(ov[0][k], ov[1][k]); o.y = cvtpk(ov[2][k], ov[3][k]);
            *(LAS u32x2*)(lds + ST_BT + (8 * cc + k) * SS_LD + l0 * 2) = o; }
    }
#pragma unroll 1
    for (int i = 0; i < 2; ++i) {
        const int it = tid + 512 * i, hh = it >> 8, cc = it & 7, l0 = 4 * ((it & 255) >> 3);
        float xw[4];
#pragma unroll
        for (int r = 0; r < 4; ++r) xw[r] = xwf[hh * 128 + l0 + r];
        float ov[4][8];
        conv4x8<SAMPLE>(PROJ, sconv0, convw, convb, rowbase, bs, first_chunk, l0, (4 * g + hh) * 64 + 8 * cc, ov);
#pragma unroll
        for (int k = 0; k < 8; ++k) { u32x2 o; o.x = cvtpk(ov[0][k] * xw[0], ov[1][k] * xw[1]); o.y = cvtpk(ov[2][k] * xw[2], ov[3][k] * xw[3]);
            *(LAS u32x2*)(lds + ST_XTW + (hh * 64 + 8 * cc + k) * SS_LD + l0 * 2) = o; }
    }
    __syncthreads();
    f32x4 acc[16];
#pragma unroll
    for (int q = 0; q < 16; ++q) acc[q] = f32x4{0.f, 0.f, 0.f, 0.f};
#pragma unroll
    for (int ks = 0; ks < 4; ++ks) {
        const bf16x8 bf = *(const LAS bf16x8*)(lds + ST_BT + (16 * wid + j16) * SS_LD + (32 * ks + 8 * ig) * 2);
#pragma unroll
        for (int q = 0; q < 16; ++q) { const bf16x8 af = *(const LAS bf16x8*)(lds + ST_XTW + (16 * q + j16) * SS_LD + (32 * ks + 8 * ig) * 2);
            acc[q] = __builtin_amdgcn_mfma_f32_16x16x32_bf16(af, bf, acc[q], 0, 0, 0); } }
    float* SL = (float*)(ws + WS_SLOC);
#pragma unroll
    for (int q = 0; q < 16; ++q) { const int hh = q >> 2; const size_t sidx = (size_t)sidx0 + (SAMPLE ? hh : 16 * hh);
#pragma unroll
        for (int r = 0; r < 4; ++r) SL[(sidx * 64 + (16 * (q & 3) + 4 * ig + r)) * 128 + 16 * wid + j16] = acc[q][r]; }
}

constexpr int SO_CM = 0, SO_BM = 34816, SO_XT = 69632, SO_HB = 87040, SO_XS = 104448, SO_XS_LD = 144, SO_F = 122880;
template <bool SAMPLE>
__device__ __forceinline__ void ssd_out_unit(unsigned char* ws, float* outp, const float* alog, const float* dskip, const float* ssdnw, const float* ssm0, const float* sconv0, const float* convw, const float* convb,
                                         LAS unsigned char* lds, int bs, int c, int h) {
    int tid = threadIdx.x; asm volatile("" : "+v"(tid));
    const int wid = __builtin_amdgcn_readfirstlane(tid >> 6), lane = tid & 63, j16 = lane & 15, ig = lane >> 4;
    const int g = h >> 2;
    const int rowbase = SAMPLE ? MP + bs * DTOK : bs * SEQ + c * 128;
    constexpr int NTOK = SAMPLE ? DTOK : 128;
    const float a_h = -__expf(alog[h]), D_h = dskip[h];
    const bf16_t* PROJ = (const bf16_t*)(ws + WS_PROJ);
    const bool first_chunk = SAMPLE || c == 0;
    const float* DTS = (const float*)(ws + WS_DT); const float* SL = (const float*)(ws + WS_SLOC); const float* SUMDT = (const float*)(ws + WS_SUMDT);
    LAS float* csf = (LAS float*)(lds + SO_F); LAS float* dtf = csf + 128; LAS float* facf = csf + 256;
    const int sidx = SAMPLE ? 512 + bs * 8 + h : (bs * 8 + h) * 16 + c;
    __syncthreads();
    if (wid == 0) {
        float d0 = (lane < NTOK) ? DTS[(size_t)(rowbase + lane) * 8 + h] : 0.f, d1 = (lane + 64 < NTOK) ? DTS[(size_t)(rowbase + lane + 64) * 8 + h] : 0.f;
        float c0 = d0 * a_h, c1 = d1 * a_h;
        scan128(c0, c1, lane);
        csf[lane] = c0; csf[lane + 64] = c1; dtf[lane] = d0; dtf[lane + 64] = d1;
    } else if (wid == 1 && !SAMPLE) {
        if (lane < 16) { float sacc = 0.f; for (int q = lane + 1; q < c; ++q) sacc += SUMDT[(bs * 8 + h) * 16 + q]; facf[lane] = __expf(sacc); }
    }
    __syncthreads();
    const float cs_end = csf[127];
    {
        f32x4 hp[4];
#pragma unroll
        for (int pb = 0; pb < 4; ++pb) hp[pb] = f32x4{0.f, 0.f, 0.f, 0.f};
        if (SAMPLE) {
#pragma unroll
            for (int pb = 0; pb < 4; ++pb)
#pragma unroll
                for (int r = 0; r < 4; ++r) hp[pb][r] = ssm0[((size_t)(bs * 8 + h) * 64 + 16 * pb + 4 * ig + r) * 128 + 16 * wid + j16];
        } else {
            for (int q = 0; q < c; ++q) { const float f = facf[q]; const float* sp = SL + ((size_t)(sidx - c + q) * 64) * 128 + 16 * wid + j16;
#pragma unroll
                for (int pb = 0; pb < 4; ++pb)
#pragma unroll
                    for (int r = 0; r < 4; ++r) hp[pb][r] = fmaf(f, sp[(16 * pb + 4 * ig + r) * 128], hp[pb][r]); }
        }
#pragma unroll
        for (int pb = 0; pb < 4; ++pb)
#pragma unroll
            for (int r = 0; r < 4; ++r) *(LAS bf16_t*)(lds + SO_HB + (16 * pb + 4 * ig + r) * SS_LD + (16 * wid + j16) * 2) = f2bf(hp[pb][r]);
        if (SAMPLE || c == SEQ / 128 - 1) {
            const float dec = __expf(cs_end); const float* sp = SL + ((size_t)sidx * 64) * 128 + 16 * wid + j16;
            float* So = outp + (SAMPLE ? O_SSSM : O_PSSM) + (size_t)(bs * 8 + h) * 64 * 128 + 16 * wid + j16;
#pragma unroll
            for (int pb = 0; pb < 4; ++pb)
#pragma unroll
                for (int r = 0; r < 4; ++r) So[(16 * pb + 4 * ig + r) * 128] = fmaf(dec, hp[pb][r], sp[(16 * pb + 4 * ig + r) * 128]);
        }
    }
    {
        const int cc = tid & 15, l0 = 4 * (tid >> 4);
#pragma unroll 1
        for (int which = 0; which < 2; ++which) {
            float ov[4][8];
            conv4x8<SAMPLE>(PROJ, sconv0, convw, convb, rowbase, bs, first_chunk, l0, (which ? 512 : 768) + g * 128 + 8 * cc, ov);
#pragma unroll
            for (int r = 0; r < 4; ++r) { u32x4 w; w.x = cvtpk(ov[r][0], ov[r][1]); w.y = cvtpk(ov[r][2], ov[r][3]); w.z = cvtpk(ov[r][4], ov[r][5]); w.w = cvtpk(ov[r][6], ov[r][7]);
                *(LAS u32x4*)(lds + (which ? SO_BM : SO_CM) + (l0 + r) * SS_LD + cc * 16) = w; }
        }
        if (tid < 256) {
            const int cx = tid & 7, lx = 4 * (tid >> 3);
            float ov[4][8], dl[4];
            conv4x8<SAMPLE>(PROJ, sconv0, convw, convb, rowbase, bs, first_chunk, lx, h * 64 + 8 * cx, ov);
#pragma unroll
            for (int r = 0; r < 4; ++r) { dl[r] = dtf[lx + r]; u32x4 w; w.x = cvtpk(ov[r][0], ov[r][1]); w.y = cvtpk(ov[r][2], ov[r][3]); w.z = cvtpk(ov[r][4], ov[r][5]); w.w = cvtpk(ov[r][6], ov[r][7]);
                *(LAS u32x4*)(lds + SO_XS + (lx + r) * SO_XS_LD + cx * 16) = w; }
#pragma unroll
            for (int k = 0; k < 8; ++k) { u32x2 o; o.x = cvtpk(ov[0][k] * dl[0], ov[1][k] * dl[1]); o.y = cvtpk(ov[2][k] * dl[2], ov[3][k] * dl[3]);
                *(LAS u32x2*)(lds + SO_XT + (8 * cx + k) * SS_LD + lx * 2) = o; }
        }
    }
    __syncthreads();
    f32x4 cb[8];
#pragma unroll
    for (int sb = 0; sb < 8; ++sb) cb[sb] = f32x4{0.f, 0.f, 0.f, 0.f};
#pragma unroll
    for (int ks = 0; ks < 4; ++ks) {
        const bf16x8 af = *(const LAS bf16x8*)(lds + SO_CM + (16 * wid + j16) * SS_LD + (32 * ks + 8 * ig) * 2);
#pragma unroll
        for (int sb = 0; sb < 8; ++sb) { const bf16x8 bf = *(const LAS bf16x8*)(lds + SO_BM + (16 * sb + j16) * SS_LD + (32 * ks + 8 * ig) * 2);
            cb[sb] = __builtin_amdgcn_mfma_f32_16x16x32_bf16(af, bf, cb[sb], 0, 0, 0); } }
    __syncthreads();
    {
        float csl[4];
#pragma unroll
        for (int r = 0; r < 4; ++r) csl[r] = csf[16 * wid + 4 * ig + r];
#pragma unroll
        for (int sb = 0; sb < 8; ++sb) { const int sx = 16 * sb + j16; const float css = csf[sx];
#pragma unroll
            for (int r = 0; r < 4; ++r) { const int l = 16 * wid + 4 * ig + r; const float gv = (sx <= l) ? cb[sb][r] * __expf(csl[r] - css) : 0.f;
                *(LAS bf16_t*)(lds + SO_BM + l * SS_LD + sx * 2) = f2bf(gv); } }
    }
    f32x4 yd[4], yo[4];
#pragma unroll
    for (int pb = 0; pb < 4; ++pb) { yd[pb] = f32x4{0.f, 0.f, 0.f, 0.f}; yo[pb] = f32x4{0.f, 0.f, 0.f, 0.f}; }
#pragma unroll
    for (int ks = 0; ks < 4; ++ks) {
        const bf16x8 ag = *(const LAS bf16x8*)(lds + SO_BM + (16 * wid + j16) * SS_LD + (32 * ks + 8 * ig) * 2);
        const bf16x8 ac = *(const LAS bf16x8*)(lds + SO_CM + (16 * wid + j16) * SS_LD + (32 * ks + 8 * ig) * 2);
#pragma unroll
        for (int pb = 0; pb < 4; ++pb) {
            const bf16x8 bx = *(const LAS bf16x8*)(lds + SO_XT + (16 * pb + j16) * SS_LD + (32 * ks + 8 * ig) * 2);
            const bf16x8 bh = *(const LAS bf16x8*)(lds + SO_HB + (16 * pb + j16) * SS_LD + (32 * ks + 8 * ig) * 2);
            yd[pb] = __builtin_amdgcn_mfma_f32_16x16x32_bf16(ag, bx, yd[pb], 0, 0, 0);
            yo[pb] = __builtin_amdgcn_mfma_f32_16x16x32_bf16(ac, bh, yo[pb], 0, 0, 0); } }
    {
        bf16_t* MIX = (bf16_t*)(ws + WS_MIX); float* SSQ = (float*)(ws + WS_SSQ);
        float gw[4];
#pragma unroll
        for (int pb = 0; pb < 4; ++pb) gw[pb] = ssdnw[h * 64 + 16 * pb + j16];
#pragma unroll
        for (int r = 0; r < 4; ++r) { const int l = 16 * wid + 4 * ig + r; const float el = __expf(csf[l]); float sq = 0.f;
            const bool live = l < NTOK; const size_t grow = (size_t)(rowbase + l);
#pragma unroll
            for (int pb = 0; pb < 4; ++pb) { const int pp = 16 * pb + j16;
                const float xv = bf2f(*(const LAS bf16_t*)(lds + SO_XS + l * SO_XS_LD + pp * 2));
                float y = yd[pb][r] + el * yo[pb][r] + D_h * xv;
                if (live) { const float zv = bf2f(PROJ[grow * NPAD + PC_Z + h * 64 + pp]); y *= silu_f(zv); MIX[grow * 2048 + h * 64 + pp] = f2bf(y * gw[pb]); sq += y * y; } }
            sq = group16_sum(sq);
            if (live && j16 == 0) SSQ[grow * 8 + h] = sq; }
    }
}

constexpr int U_SSDP = NBATCH * 16 * 2, U_SSDSS = DSEQ * 2, U_SB = 256, U_DEC = DSEQ * NPAGES, U_MEMP = NBATCH * 8 * 4, U_SSDS = 64, U_MEMS = DSEQ * 4;
#define QUEUE_LOOP(qi, total, ...) for (;;) { __syncthreads(); if (threadIdx.x == 0) ctlw[16] = __hip_atomic_fetch_add(qbase + 64 * (qi), 1u, __ATOMIC_RELAXED, __HIP_MEMORY_SCOPE_AGENT); \
        __syncthreads(); const int u = (int)ctlw[16]; if (u >= (total)) break; __VA_ARGS__ }
template <int MASK> __device__ __forceinline__ void phase3(const Params& p, LAS unsigned char* lds, volatile LAS unsigned* ctlw, int qset) {
    unsigned* qbase = (unsigned*)(p.ws + WS_CTL) + CW_QUEUE + 1024 * qset;
    const bf16_t* PROJ = (const bf16_t*)(p.ws + WS_PROJ);
    bf16_t* MIX = (bf16_t*)(p.ws + WS_MIX);
    if (MASK & 1) QUEUE_LOOP(0, U_SSDP, { ssd_state_unit<false>(p.ws, p.in[I_ALOG], p.in[I_SCONV], p.in[I_CONVW], p.in[I_CONVB], lds, u >> 5, (u >> 1) & 15, u & 1); })
    if ((MASK & 2) && (blockIdx.x & 1)) {
        QUEUE_LOOP(1, U_DEC, { decode_unit((const int*)p.in[I_PT], p.in[I_CK], p.in[I_CV], p.in[I_SBBIAS], p.ws, lds, u >> 7, u & 127); })
    }
    if (MASK & 4) QUEUE_LOOP(2, U_SB, {
        const int i = 7 - (u >> 5), bh = u & 31, b = bh >> 3, h = bh & 7;
        attn_unit<0>(lds, PROJ + (size_t)(b * SEQ + i * 256) * NPAD + PC_Q + h * 128, NPAD,
                     PROJ + (size_t)(b * SEQ) * NPAD + PC_K + h * 128, PROJ + (size_t)(b * SEQ) * NPAD + PC_V + h * 128, NPAD,
                     4 * (i + 1), i * 256, 256, p.in[I_SBBIAS][h] * LOG2E,
                     PROJ + (size_t)(b * SEQ + i * 256) * NPAD + PC_GSB + h * 128, NPAD, MIX + (size_t)(b * SEQ + i * 256) * 2048 + 512 + h * 128, 2048); })
    if (MASK & 2) QUEUE_LOOP(1, U_DEC, { decode_unit((const int*)p.in[I_PT], p.in[I_CK], p.in[I_CV], p.in[I_SBBIAS], p.ws, lds, u >> 7, u & 127); })
    if (MASK & 8) QUEUE_LOOP(3, U_MEMP + U_MEMS, {
        if (u < U_MEMP) { const int hm = u & 3, qb = (u >> 2) & 7, b = u >> 5; const size_t r0 = (size_t)(b * SEQ + qb * 256);
            attn_unit<1>(lds, PROJ + r0 * NPAD + PC_MQ + hm * 128, NPAD, (const bf16_t*)(p.ws + WS_MKN) + (size_t)(b * MEMT) * 512 + hm * 128, (const bf16_t*)(p.ws + WS_MVB) + (size_t)(b * MEMT) * 512 + hm * 128, 512,
                         4, 0, 256, 0.f, PROJ + r0 * NPAD + PC_GM + hm * 128, NPAD, MIX + r0 * 2048 + 1536 + hm * 128, 2048); }
        else { const int v = u - U_MEMP, hm = v & 3, sq = v >> 2; const size_t r0 = (size_t)(MP + sq * DTOK);
            attn_unit<1>(lds, PROJ + r0 * NPAD + PC_MQ + hm * 128, NPAD, (const bf16_t*)(p.ws + WS_CMK) + (size_t)(sq * MEMT) * 512 + hm * 128, (const bf16_t*)(p.ws + WS_CMV) + (size_t)(sq * MEMT) * 512 + hm * 128, 512,
                         4, 0, DTOK, 0.f, PROJ + r0 * NPAD + PC_GM + hm * 128, NPAD, MIX + r0 * 2048 + 1536 + hm * 128, 2048); } })
    if (MASK & 16) QUEUE_LOOP(4, U_SSDSS, { ssd_state_unit<true>(p.ws, p.in[I_ALOG], p.in[I_SCONV], p.in[I_CONVW], p.in[I_CONVB], lds, u >> 1, 0, u & 1); })
}

__device__ __forceinline__ void phase4(const Params& p, LAS unsigned char* lds, volatile LAS unsigned* ctlw, int vcu, int G, int qset) {
    const int tid = threadIdx.x, lane = tid & 63, wave = __builtin_amdgcn_readfirstlane(tid >> 6);
    bf16_t* MIX = (bf16_t*)(p.ws + WS_MIX);
    const bf16_t* PROJ = (const bf16_t*)(p.ws + WS_PROJ);
    unsigned* qbase = (unsigned*)(p.ws + WS_CTL) + CW_QUEUE + 1024 * qset;
    QUEUE_LOOP(5, NBATCH * 16 * 8, { const int v = NBATCH * 16 * 8 - 1 - u;
        ssd_out_unit<false>(p.ws, p.out, p.in[I_ALOG], p.in[I_DSKIP], p.in[I_SSDNW], p.in[I_SSM], p.in[I_SCONV], p.in[I_CONVW], p.in[I_CONVB], lds, (v >> 3) & 3, v >> 5, v & 7); })
    QUEUE_LOOP(6, DSEQ * 8, { ssd_out_unit<true>(p.ws, p.out, p.in[I_ALOG], p.in[I_DSKIP], p.in[I_SSDNW], p.in[I_SSM], p.in[I_SCONV], p.in[I_CONVW], p.in[I_CONVB], lds, u >> 3, 0, u & 7); })
    for (int u = vcu; u < DSEQ * 8; u += G) {
        const int seq = u >> 3, head = u & 7, i = wave;
        const int row = MP + seq * DTOK + i;
        const float bias2 = p.in[I_SBBIAS][head] * LOG2E;
        const unsigned qw = *(const unsigned*)(PROJ + (size_t)row * NPAD + PC_Q + head * 128 + 2 * lane);
        const float q0 = bf_lo(qw), q1 = bf_hi(qw);
        float acc0 = 0.f, acc1 = 0.f, R = 1.f;
        for (int j = DTOK - 1; j >= 0; --j) {
            const f32x2 kv = *(const f32x2*)(p.out + O_SK + (size_t)(seq * DTOK + j) * 1024 + head * 128 + 2 * lane);
            const float kb0 = bf2f(f2bf(kv.x)), kb1 = bf2f(f2bf(kv.y));
            const float z = fmaxf(wave_sum(q0 * kb0 + q1 * kb1) + bias2, -100.f);
            if (j < i) {
                const float e = fast_exp2(-z), rc = fast_rcp(1.f + e);
                const f32x2 vv = *(const f32x2*)(p.out + O_SV + (size_t)(seq * DTOK + j) * 1024 + head * 128 + 2 * lane);
                const float w = rc * R; acc0 += w * vv.x; acc1 += w * vv.y; R *= e * rc;
            }
        }
        const float* Op = (const float*)(p.ws + WS_OPART) + (size_t)((seq * 8 + head) * NPAGES) * (DTOK * 128) + i * 128 + 2 * lane;
        const float* Fp = (const float*)(p.ws + WS_FPART) + (size_t)((seq * 8 + head) * NPAGES) * DTOK + i;
        for (int pg = NPAGES - 1; pg >= 0; --pg) {
            const f32x2 ov = *(const f32x2*)(Op + (size_t)pg * (DTOK * 128));
            acc0 += R * ov.x; acc1 += R * ov.y; R *= Fp[(size_t)pg * DTOK];
        }
        const unsigned gwd = *(const unsigned*)(PROJ + (size_t)row * NPAD + PC_GSB + head * 128 + 2 * lane);
        *(unsigned*)(MIX + (size_t)row * 2048 + 512 + head * 128 + 2 * lane) = cvtpk(acc0 * silu_f(bf_lo(gwd)), acc1 * silu_f(bf_hi(gwd)));
    }
}

struct Epi5 {
    static constexpr int MID = 8;
    const float* xp; float* out; const float* SSQ;
    __device__ __forceinline__ void mid(pg8::Acc& acc, const pg8::Unit& u, int wr, int fr) const {
        int rl0 = wr * 64 + fr; asm volatile("" : "+v"(rl0));
#pragma unroll
        for (int ai = 0; ai < 2; ++ai)
#pragma unroll
            for (int m = 0; m < 4; ++m) { const size_t row = (size_t)u.pm * 256 + rl0 + ai * 128 + m * 16;
                const f32x4 s0 = *(const f32x4*)(SSQ + row * 8), s1 = *(const f32x4*)(SSQ + row * 8 + 4);
                const float rs = 1.f / sqrtf((((s0.x + s0.y) + (s0.z + s0.w)) + ((s1.x + s1.y) + (s1.z + s1.w))) * (1.f / 512.f) + EPS);
#pragma unroll
                for (int bj = 0; bj < 2; ++bj)
#pragma unroll
                    for (int n = 0; n < 2; ++n) acc[ai][bj][m][n] = acc[ai][bj][m][n] * rs; }
    }
    __device__ __forceinline__ void operator()(pg8::Acc& acc, const pg8::Unit& u, int wr, int wc, int fr, int fq) const {
        int rl0 = wr * 64 + fr, cl0 = u.pn * 256 + wc * 32 + 4 * fq;
        asm volatile("" : "+v"(rl0), "+v"(cl0));
        const float* xb = xp + (size_t)u.pm * 256 * DM; float* ob = out + O_YP + (size_t)u.pm * 256 * DM;
#pragma unroll
        for (int ai = 0; ai < 2; ++ai)
#pragma unroll
            for (int m = 0; m < 4; ++m) { const int row = rl0 + ai * 128 + m * 16; const float* xr = xb + (size_t)row * DM + cl0; float* orow = ob + (size_t)row * DM + cl0;
#pragma unroll
                for (int bj = 0; bj < 2; ++bj)
#pragma unroll
                    for (int n = 0; n < 2; ++n) *(f32x4*)(orow + bj * 128 + n * 16) = *(const f32x4*)(xr + bj * 128 + n * 16) + acc[ai][bj][m][n]; }
    }
};
__device__ __forceinline__ void sample_outproj(const Params& p, LAS unsigned char* lds, int c) {
    int tid = threadIdx.x; asm volatile("" : "+v"(tid));
    const int wid = __builtin_amdgcn_readfirstlane(tid >> 6), lane = tid & 63, j16 = lane & 15, ig = lane >> 4;
    const bf16_t* MIX = (const bf16_t*)(p.ws + WS_MIX) + (size_t)MP * 2048; const bf16_t* WT = (const bf16_t*)(p.ws + WS_WOUT) + (size_t)(16 * c) * 2048;
    const float* SSQ = (const float*)(p.ws + WS_SSQ) + (size_t)MP * 8;
    f32x4 acc[4];
#pragma unroll
    for (int rb = 0; rb < 4; ++rb) acc[rb] = f32x4{0.f, 0.f, 0.f, 0.f};
#pragma unroll
    for (int ks = 0; ks < 8; ++ks) { const int k = 256 * wid + 32 * ks + 8 * ig;
        const bf16x8 bf = *(const bf16x8*)(WT + (size_t)j16 * 2048 + k);
#pragma unroll
        for (int rb = 0; rb < 4; ++rb) { const bf16x8 af = *(const bf16x8*)(MIX + (size_t)(16 * rb + j16) * 2048 + k);
            acc[rb] = __builtin_amdgcn_mfma_f32_16x16x32_bf16(af, bf, acc[rb], 0, 0, 0); } }
    if (wid < 2) {
#pragma unroll
        for (int rb = 0; rb < 4; ++rb)
#pragma unroll
            for (int r = 0; r < 4; ++r) { const int row = 16 * rb + 4 * ig + r; const f32x4 s0 = *(const f32x4*)(SSQ + row * 8), s1 = *(const f32x4*)(SSQ + row * 8 + 4);
                acc[rb][r] *= 1.f / sqrtf((((s0.x + s0.y) + (s0.z + s0.w)) + ((s1.x + s1.y) + (s1.z + s1.w))) * (1.f / 512.f) + EPS); }
    }
    __syncthreads();
    LAS float* red = (LAS float*)lds;
#pragma unroll
    for (int rb = 0; rb < 4; ++rb)
#pragma unroll
        for (int r = 0; r < 4; ++r) red[(wid * 64 + 16 * rb + 4 * ig + r) * 16 + j16] = acc[rb][r];
    __syncthreads();
#pragma unroll
    for (int i = 0; i < 2; ++i) { const int e = tid + 512 * i, row = e >> 4, col = e & 15; float v = 0.f;
#pragma unroll
        for (int w = 0; w < 8; ++w) v += red[(w * 64 + row) * 16 + col];
        p.out[O_YS + (size_t)row * DM + 16 * c + col] = p.in[I_XS][(size_t)row * DM + 16 * c + col] + v; }
}

constexpr int NPHASE = 6;
__global__ void __launch_bounds__(512, 2) hymba_fwd(Params p) {
    extern __shared__ __attribute__((aligned(16))) unsigned char lds_raw[];
    LAS unsigned char* lds = (LAS unsigned char*)lds_raw;
    const int tid = threadIdx.x;
    const int G = gridDim.x; const int bx = blockIdx.x; const int vcu = (G % 8 == 0) ? (bx % 8) * (G / 8) + bx / 8 : bx;
    volatile LAS unsigned* ctlw = (volatile LAS unsigned*)(lds + LDS_CTLW);
    if (tid < 64) ctlw[tid] = 0u;
    __syncthreads();
    unsigned* ctl = (unsigned*)(p.ws + WS_CTL);
    const int lo = p.ph_lo, hi = p.ph_hi;
    XcdBarrier bar; bar.bar = ctl + CW_BAR; bar.x = 0; bar.st = nullptr;
    if (hi - lo > 1) bar = xcd_barrier_post(ctl + CW_BAR, ctlw + 8);
#define IN(k) (lo <= (k) && (k) < hi)
#define BOTH(k) (IN(k) && IN((k) + 1))
    if (IN(0)) { phase0(p, lds, vcu, G); if (BOTH(0)) xcd_barrier(bar); }
    if (PROBE_DUP == 0) { phase0(p, lds, vcu, G); xcd_barrier(bar); }
    if (PROBE_DUP == 99) { for (int q = 0; q < 8; ++q) xcd_barrier(bar); }
    if (IN(1)) {
        pg8::Gemm g{(const bf16_t*)(p.ws + WS_H), (const bf16_t*)(p.ws + WS_WIN), (const bf16_t*)(p.ws + WS_HM), (const bf16_t*)(p.ws + WS_WM), DM};
        pg8::Order S; S.init(MROWS / 256, NPAD / 256, MMEM / 256, 1024 / 256, G, bx);
        Epi1 E{(bf16_t*)(p.ws + WS_PROJ), (float*)(p.ws + WS_DT), p.out, p.in[I_DTBIAS], p.in[I_QNORM], p.in[I_KNORM], p.in[I_MQNORM], p.in[I_MKNORM], (bf16_t*)(p.ws + WS_MKN), (bf16_t*)(p.ws + WS_MVB), (LAS float*)(lds + RING_BYTES)};
        pg8::gemm_phase<Epi1>(lds, g, S, E);
        if (BOTH(1)) xcd_barrier(bar);
        if (PROBE_DUP == 1) { pg8::gemm_phase<Epi1>(lds, g, S, E); xcd_barrier(bar); }
    }
    if (IN(3)) { phase3<31>(p, lds, ctlw, 0); if (BOTH(3)) xcd_barrier(bar); }
    if (PROBE_DUP >= 30) { phase3<(PROBE_DUP >= 30 ? PROBE_DUP - 30 : 31)>(p, lds, ctlw, 1); xcd_barrier(bar); }
    if (IN(4)) { phase4(p, lds, ctlw, vcu, G, 0); if (BOTH(4)) xcd_barrier(bar); }
    if (PROBE_DUP == 4) { phase4(p, lds, ctlw, vcu, G, 1); xcd_barrier(bar); }
    if (IN(5)) {
        pg8::Gemm g{(const bf16_t*)(p.ws + WS_MIX), (const bf16_t*)(p.ws + WS_WOUT), nullptr, nullptr, DM};
        pg8::Order S; S.init(MP / 256, DM / 256, 0, 1, G, bx);
        Epi5 E{p.in[I_XP], p.out, (const float*)(p.ws + WS_SSQ)};
        pg8::gemm_phase<Epi5>(lds, g, S, E);
        if (bx < 128) sample_outproj(p, lds, bx);
        if (PROBE_DUP == 5) { xcd_barrier(bar); pg8::gemm_phase<Epi5>(lds, g, S, E); if (bx < 128) sample_outproj(p, lds, bx); }
    }
#undef IN
#undef BOTH
}

extern "C" void kernel_launch(void* const* d_in, const int* in_sizes, int n_in, void* d_out, int out_size, void* d_ws, size_t ws_size, hipStream_t stream) {
    static int grid = 0;
    if (grid == 0) {
        if (n_in != 26 || ws_size < WS_END) { fprintf(stderr, "kernel_launch: unexpected n_in %d / ws %zu\n", n_in, ws_size); grid = -1; return; }
        int dev = 0, cus = 0, per_cu = 0;
        if (hipGetDevice(&dev) != hipSuccess || hipDeviceGetAttribute(&cus, hipDeviceAttributeMultiprocessorCount, dev) != hipSuccess) { grid = -1; return; }
        if (hipFuncSetAttribute((const void*)hymba_fwd, hipFuncAttributeMaxDynamicSharedMemorySize, LDS_BYTES) != hipSuccess) { fprintf(stderr, "kernel_launch: hipFuncSetAttribute failed\n"); grid = -1; return; }
        if (hipOccupancyMaxActiveBlocksPerMultiprocessor(&per_cu, (const void*)hymba_fwd, 512, LDS_BYTES) != hipSuccess || per_cu < 1) fprintf(stderr, "kernel_launch: occupancy query says %d\n", per_cu);
        (void)hipGetLastError();
        grid = cus;
    }
    if (grid < 0) return;
    (void)hipMemsetAsync((char*)d_ws + WS_CTL, 0, CTL_BYTES, stream);
    Params p{};
    for (int i = 0; i < 26; ++i) p.in[i] = (const float*)d_in[i];
    p.out = (float*)d_out; p.ws = (unsigned char*)d_ws;
    if (MK_N_LAUNCHES == 1) { p.ph_lo = 0; p.ph_hi = NPHASE; hipLaunchKernelGGL(hymba_fwd, dim3(grid), dim3(512), LDS_BYTES, stream, p); }
    else for (int ph = 0; ph < NPHASE; ++ph) { p.ph_lo = ph; p.ph_hi = ph + 1; hipLaunchKernelGGL(hymba_fwd, dim3(grid), dim3(512), LDS_BYTES, stream, p); }
    const hipError_t le = hipPeekAtLastError();
    if (le != hipSuccess) fprintf(stderr, "kernel_launch: launch failed: %s\n", hipGetErrorName(le));
}
```

```cpp
#include <hip/hip_runtime.h>
#include <cstdio>
#include <cstdint>

#ifndef PROBE_DUP
#define PROBE_DUP -1
#endif
#ifndef PROBE_SEG
#define PROBE_SEG -1
#endif
#ifndef MK_N_LAUNCHES
#define MK_N_LAUNCHES 1
#endif

constexpr int DM = 2048, NBATCH = 4, SEQ = 2048, MP = NBATCH * SEQ;
constexpr int DSEQ = 8, DTOK = 8, MS = DSEQ * DTOK;
constexpr int MVALID = MP + MS, MROWS = 8448;
constexpr int NIN = 6664, NPAD = 6912;
constexpr int MEMT = 256, MMEM = NBATCH * MEMT;
constexpr int NPAGES = 128, PAGE = 128, PAST = NPAGES * PAGE;
constexpr float EPS = 1e-6f;
constexpr float LOG2E = 1.4426950408889634f;
constexpr float QSCALE = 0.08838834764831845f * LOG2E;

constexpr size_t O_YP = 0, O_YS = 16777216, O_PK = 16908288, O_PV = 25296896, O_PSSM = 33685504, O_PCONV = 33947648,
                 O_PMK = 33959936, O_PMV = 34484224, O_SK = 35008512, O_SV = 35074048, O_SSSM = 35139584, O_SCONV = 35663872;

constexpr size_t MiB = 1u << 20;
constexpr size_t WS_CTL = 0, CTL_BYTES = 1 * MiB;
constexpr size_t WS_WIN = 2 * MiB;
constexpr size_t WS_WM = 32 * MiB;
constexpr size_t WS_WOUT = 38 * MiB;
constexpr size_t WS_H = 48 * MiB;
constexpr size_t WS_HM = 84 * MiB;
constexpr size_t WS_PROJ = 90 * MiB;
constexpr int PC_Q = 0, PC_K = 1024, PC_V = 2048, PC_GSB = 3072, PC_Z = 4096, PC_XBC = 4608, PC_MQ = 5632, PC_GM = 6144;
constexpr size_t WS_DT = 210 * MiB;
constexpr size_t WS_MKN = 211 * MiB;
constexpr size_t WS_MVB = 213 * MiB;
constexpr size_t WS_CMK = 215 * MiB;
constexpr size_t WS_CMV = 218 * MiB;
constexpr size_t WS_SSQ = 221 * MiB;
constexpr size_t WS_FPART = 222 * MiB;
constexpr size_t WS_MIX = 224 * MiB;
constexpr size_t WS_YZ = 260 * MiB;
constexpr size_t WS_OPART = 280 * MiB;
constexpr size_t WS_XA = 316 * MiB;
constexpr size_t WS_SLOC = 334 * MiB;
constexpr size_t WS_SUMDT = 354 * MiB;
constexpr size_t WS_END = 355 * MiB;

constexpr int CW_BAR = 4096;
constexpr int CW_QUEUE = 64;

constexpr int LDS_BYTES = 163840;
constexpr int RING_BYTES = 131072;
constexpr int LDS_CTLW = LDS_BYTES - 512;

#define LAS __attribute__((address_space(3)))
typedef unsigned short bf16_t;
typedef short bf16x8 __attribute__((ext_vector_type(8)));
typedef short s16x4 __attribute__((ext_vector_type(4)));
typedef float f32x2 __attribute__((ext_vector_type(2)));
typedef float f32x4 __attribute__((ext_vector_type(4)));
typedef float f32x16 __attribute__((ext_vector_type(16)));
typedef unsigned u32x2 __attribute__((ext_vector_type(2)));
typedef unsigned u32x4 __attribute__((ext_vector_type(4)));

__device__ __forceinline__ unsigned cvtpk(float lo, float hi) { unsigned r; asm volatile("v_cvt_pk_bf16_f32 %0, %1, %2" : "=v"(r) : "v"(lo), "v"(hi)); return r; }
__device__ __forceinline__ float bf_lo(unsigned w) { return __uint_as_float(w << 16); }
__device__ __forceinline__ float bf_hi(unsigned w) { return __uint_as_float(w & 0xffff0000u); }
__device__ __forceinline__ float bf2f(bf16_t b) { return __uint_as_float(((unsigned)b) << 16); }
__device__ __forceinline__ bf16_t f2bf(float f) { return (bf16_t)(cvtpk(f, 0.f) & 0xffffu); }
__device__ __forceinline__ float wave_sum(float v) {
#pragma unroll
    for (int o = 1; o < 64; o <<= 1) v += __shfl_xor(v, o);
    return v;
}
__device__ __forceinline__ float fast_exp2(float x) { return __builtin_amdgcn_exp2f(x); }
__device__ __forceinline__ float fast_rcp(float x) { return __builtin_amdgcn_rcpf(x); }
__device__ __forceinline__ float silu_f(float x) { return x * fast_rcp(1.f + fast_exp2(-x * LOG2E)); }

#define XB_TMO      128
#define XB_XCNT(j)  (256  + 64 * (j))
#define XB_XSUB(j)  (1280 + 64 * (j))
#define XB_XGEN(j)  (2304 + 64 * (j))
#define XB_TOP      3328
#define XB_TOPGEN   3392
#define XCD_BAR_WORDS 3456
#define XB_SPIN_CAP (1u << 18)
#ifndef XB_SLEEP
#define XB_SLEEP 1
#endif

__device__ __forceinline__ unsigned xb_ld(unsigned* p)              { return __hip_atomic_load(p, __ATOMIC_RELAXED, __HIP_MEMORY_SCOPE_AGENT); }
__device__ __forceinline__ unsigned xb_add(unsigned* p, unsigned v) { return __hip_atomic_fetch_add(p, v, __ATOMIC_RELAXED, __HIP_MEMORY_SCOPE_AGENT); }
__device__ __forceinline__ unsigned xb_xcc_id() { return (unsigned)__builtin_amdgcn_s_getreg((3 << 11) | 20) & 0xFu; }
#define XB_SPIN(cond, bar) do { unsigned _sp = 0; while (cond) { __builtin_amdgcn_s_sleep(XB_SLEEP); \
    if ((++_sp & 255u) == 0u) { if (xb_ld(&(bar)[XB_TMO])) break; if (_sp > XB_SPIN_CAP) { atomicAdd(&(bar)[XB_TMO], 1u); break; } } } } while (0)

struct XcdBarrier { unsigned* bar; unsigned x; volatile LAS unsigned* st; };

__device__ __forceinline__ XcdBarrier xcd_barrier_post(unsigned* bar, volatile LAS unsigned* st) {
    XcdBarrier b; b.bar = bar; b.x = xb_xcc_id(); b.st = st;
    if (threadIdx.x == 0) (void)xb_add(&bar[XB_XCNT(b.x)], 1u);
    return b;
}
__device__ __forceinline__ void xcd_barrier_complete(unsigned* bar, unsigned x, unsigned& nloc, unsigned& nx) {
    const unsigned G = gridDim.x * gridDim.y * gridDim.z;
    unsigned sum, cnt, mine, sp = 0u;
    for (;;) {
        sum = 0u; cnt = 0u; mine = 0u;
#pragma unroll
        for (unsigned j = 0; j < 16; ++j) { const unsigned c = xb_ld(&bar[XB_XCNT(j)]); sum += c; cnt += (c > 0u) ? 1u : 0u; mine = (j == x) ? c : mine; }
        if (sum == G) break;
        __builtin_amdgcn_s_sleep(1);
        if ((++sp & 255u) == 0u) { if (xb_ld(&bar[XB_TMO])) break; if (sp > XB_SPIN_CAP) { atomicAdd(&bar[XB_TMO], 1u); break; } }
    }
    nloc = mine > 0u ? mine : 1u; nx = cnt > 0u ? cnt : 1u;
}
__device__ __forceinline__ void xcd_barrier(const XcdBarrier& b) {
    asm volatile("s_waitcnt vmcnt(0)" ::: "memory");
    __syncthreads();
    if (threadIdx.x == 0) {
        unsigned* bar = b.bar;
        __builtin_amdgcn_s_waitcnt(0);
        unsigned nloc = b.st[0], nx = b.st[1];
        if (nloc == 0u) { xcd_barrier_complete(bar, b.x, nloc, nx); b.st[0] = nloc; b.st[1] = nx; }
        const unsigned old = xb_add(&bar[XB_XSUB(b.x)], 1u);
        const unsigned gen = old / nloc;
        if (old + 1u == (gen + 1u) * nloc) {
            __builtin_amdgcn_fence(__ATOMIC_RELEASE, "agent");
            asm volatile("s_waitcnt vmcnt(0)" ::: "memory");
            const unsigned og = xb_add(&bar[XB_TOP], 1u);
            const unsigned tg = og / nx;
            if (og + 1u == (tg + 1u) * nx) xb_add(&bar[XB_TOPGEN], 1u);
            else XB_SPIN(xb_ld(&bar[XB_TOPGEN]) == tg, bar);
            __builtin_amdgcn_fence(__ATOMIC_ACQUIRE, "agent");
            xb_add(&bar[XB_XGEN(b.x)], 1u);
            asm volatile("s_waitcnt vmcnt(0)" ::: "memory");
        } else {
            XB_SPIN(xb_ld(&bar[XB_XGEN(b.x)]) == gen, bar);
            __builtin_amdgcn_fence(__ATOMIC_ACQUIRE, "agent");
            asm volatile("s_waitcnt vmcnt(0)" ::: "memory");
        }
    }
    __syncthreads();
}

#define XB2_BASE     8192
#define XB2_XREP(x, i) (XB2_BASE + 256 * (32 * (x) + (i)))
#define XB2_TOPREP(x)  (XB2_BASE + 256 * (512 + (x)))
struct XcdBarrier2 { unsigned* bar; unsigned x, idx; volatile LAS unsigned* st; };
__device__ __forceinline__ XcdBarrier2 xcd_barrier2_post(unsigned* bar, volatile LAS unsigned* st) {
    XcdBarrier2 b; b.bar = bar; b.x = xb_xcc_id(); b.st = st; b.idx = 0;
    if (threadIdx.x < 64) { unsigned i = 0; if (threadIdx.x == 0) i = xb_add(&bar[XB_XCNT(b.x)], 1u); b.idx = __builtin_amdgcn_readfirstlane(i); }
    return b;
}
__device__ __forceinline__ void xcd_barrier2(const XcdBarrier2& b) {
    asm volatile("s_waitcnt vmcnt(0)" ::: "memory");
    __syncthreads();
    if (threadIdx.x < 64) {
        unsigned* bar = b.bar; const unsigned lane = threadIdx.x;
        unsigned nloc = b.st[0], nx = b.st[1]; const unsigned gen = b.st[2];
        if (nloc == 0u) { if (lane == 0) { xcd_barrier_complete(bar, b.x, nloc, nx); b.st[0] = nloc; b.st[1] = nx; }
            asm volatile("s_waitcnt lgkmcnt(0)" ::: "memory"); nloc = b.st[0]; nx = b.st[1]; }
        nloc = __builtin_amdgcn_readfirstlane(nloc); nx = __builtin_amdgcn_readfirstlane(nx);
        unsigned old = 0; if (lane == 0) old = xb_add(&bar[XB_XSUB(b.x)], 1u);
        old = __builtin_amdgcn_readfirstlane(old);
        if (old + 1u == (gen + 1u) * nloc) {
            if (lane == 0) { __builtin_amdgcn_fence(__ATOMIC_RELEASE, "agent"); asm volatile("s_waitcnt vmcnt(0)" ::: "memory"); }
            unsigned og = 0; if (lane == 0) og = xb_add(&bar[XB_TOP], 1u);
            og = __builtin_amdgcn_readfirstlane(og);
            if (og + 1u == (gen + 1u) * nx) { if (lane < 16) __hip_atomic_store(&bar[XB2_TOPREP(lane)], gen + 1u, __ATOMIC_RELAXED, __HIP_MEMORY_SCOPE_AGENT); }
            else if (lane == 0) XB_SPIN(xb_ld(&bar[XB2_TOPREP(b.x)]) < gen + 1u, bar);
            if (lane == 0) __builtin_amdgcn_fence(__ATOMIC_ACQUIRE, "agent");
            if (lane < nloc && lane < 32) __hip_atomic_store(&bar[XB2_XREP(b.x, lane)], gen + 1u, __ATOMIC_RELAXED, __HIP_MEMORY_SCOPE_AGENT);
            asm volatile("s_waitcnt vmcnt(0)" ::: "memory");
        } else {
            if (lane == 0) { XB_SPIN(xb_ld(&bar[XB2_XREP(b.x, b.idx)]) < gen + 1u, bar);
                __builtin_amdgcn_fence(__ATOMIC_ACQUIRE, "agent"); asm volatile("s_waitcnt vmcnt(0)" ::: "memory"); }
        }
        if (lane == 0) b.st[2] = gen + 1u;
    }
    __syncthreads();
}
template <int FENCES> __device__ __forceinline__ void xcd_barrier_probe(const XcdBarrier& b) {
    asm volatile("s_waitcnt vmcnt(0)" ::: "memory");
    __syncthreads();
    if (threadIdx.x == 0) {
        unsigned* bar = b.bar;
        unsigned nloc = b.st[0], nx = b.st[1];
        if (nloc == 0u) { xcd_barrier_complete(bar, b.x, nloc, nx); b.st[0] = nloc; b.st[1] = nx; }
        const unsigned old = xb_add(&bar[XB_XSUB(b.x)], 1u);
        const unsigned gen = old / nloc;
        if (old + 1u == (gen + 1u) * nloc) {
            if (FENCES & 1) { __builtin_amdgcn_fence(__ATOMIC_RELEASE, "agent"); asm volatile("s_waitcnt vmcnt(0)" ::: "memory"); }
            const unsigned og = xb_add(&bar[XB_TOP], 1u);
            const unsigned tg = og / nx;
            if (og + 1u == (tg + 1u) * nx) xb_add(&bar[XB_TOPGEN], 1u);
            else XB_SPIN(xb_ld(&bar[XB_TOPGEN]) == tg, bar);
            if (FENCES & 2) __builtin_amdgcn_fence(__ATOMIC_ACQUIRE, "agent");
            xb_add(&bar[XB_XGEN(b.x)], 1u);
            asm volatile("s_waitcnt vmcnt(0)" ::: "memory");
        } else {
            XB_SPIN(xb_ld(&bar[XB_XGEN(b.x)]) == gen, bar);
        }
    }
    __syncthreads();
}
__device__ __forceinline__ void flat_barrier(unsigned* bar, volatile LAS unsigned* gen) {
    asm volatile("s_waitcnt vmcnt(0)" ::: "memory");
    __syncthreads();
    if (threadIdx.x == 0) {
        const unsigned g = gen[0] + 1u; gen[0] = g;
        __builtin_amdgcn_fence(__ATOMIC_RELEASE, "agent");
        asm volatile("s_waitcnt vmcnt(0)" ::: "memory");
        xb_add(&bar[XB_TOP], 1u);
        const unsigned target = g * gridDim.x;
        XB_SPIN(xb_ld(&bar[XB_TOP]) < target, bar);
        __builtin_amdgcn_fence(__ATOMIC_ACQUIRE, "agent");
        asm volatile("s_waitcnt vmcnt(0)" ::: "memory");
    }
    __syncthreads();
}
namespace pg8 {
constexpr int BM = 256, BK = 64, HALF = 128, HTB = HALF * BK * 2, STAGE_BYTES = 8 * HTB, NXCD = 8, WGM = 8;
__host__ __device__ __forceinline__ int lds_byte(int r, int c) { const int st = (r >> 4) * 2 + (c >> 5), rr = r & 15, cc = c & 31, ob = rr * 64 + cc * 2; return st * 1024 + (ob ^ (((ob >> 9) & 1) << 5)); }
__host__ __device__ __forceinline__ void stage_rc(int b, int& R, int& C) { const int st = b / 1024, sb = b % 1024, swz = sb ^ (((sb >> 9) & 1) << 5); R = (st >> 1) * 16 + swz / 64; C = (st & 1) * 32 + (swz % 64) / 2; }

struct Unit { int pm, pn, sel; };
struct Gemm { const bf16_t* A0; const bf16_t* B0; const bf16_t* A1; const bf16_t* B1; int K; };

struct Order {
    int nM, nN, nwg, n1M, n1N, G, c;
    __device__ void init(int nM_, int nN_, int n1M_, int n1N_, int G_, int c_) { nM = nM_; nN = nN_; nwg = nM * nN; n1M = n1M_; n1N = n1N_; G = G_; c = c_; }
    __device__ bool next(int i, Unit& u) const {
        const long L = (long)i * G + c;
        if (L >= nwg + n1M * n1N) return false;
        if (L >= nwg) { const int r = (int)L - nwg; u.pm = r / n1N; u.pn = r % n1N; u.sel = 1; return true; }
        int wgid = (int)L; { const int q = nwg / NXCD, r = nwg % NXCD, xcd = wgid % NXCD, off = wgid / NXCD; wgid = (xcd < r ? xcd * (q + 1) : r * (q + 1) + (xcd - r) * q) + off; }
        const int nig = WGM * nN, gid = wgid / nig, fm = gid * WGM, gsz = (nM - fm) < WGM ? (nM - fm) : WGM;
        u.pm = fm + ((wgid % nig) % gsz); u.pn = (wgid % nig) / gsz; u.sel = 0; return true;
    }
};

template <class Epi>
__device__ __forceinline__ void gemm_phase(LAS unsigned char* lds, const Gemm g, const Order& S, const Epi& E) {
    const int tid = threadIdx.x, wid = __builtin_amdgcn_readfirstlane(tid >> 6), lane = tid & 63, wr = wid >> 2, wc = wid & 3, fr = lane & 15, fq = lane >> 4;
    const int K = g.K, nt = K / BK;
    unsigned voffA[2];
#pragma unroll
    for (int i = 0; i < 2; ++i) { int R, C; stage_rc(tid * 16 + i * 8192, R, C); voffA[i] = (unsigned)(R * K + C) * 2u; }
    const size_t kstep = (size_t)(BK * 2);
    const size_t hstep = (size_t)HALF * K * 2;
    const size_t tstep = 2 * hstep;
    const unsigned ldsw = (unsigned)wid * 1024u;
    const int aoff = lds_byte(wr * 64 + fr, fq * 8), boff = lds_byte(wc * 32 + fr, fq * 8);
#define PG8_SA(b, h) (((b) * 2 + (h)) * HTB)
#define PG8_SB(b, h) ((4 + (b) * 2 + (h)) * HTB)
#define PG8_STAGE(bufoff, gbase) do { _Pragma("unroll") for (int _i = 0; _i < 2; ++_i) \
        __builtin_amdgcn_global_load_lds((const unsigned*)((const char*)(gbase) + voffA[_i]), (LAS unsigned*)(lds + (bufoff) + ldsw + _i * 8192), 16, 0, 0); } while (0)
#define PG8_LDA(dst, b, h) do { _Pragma("unroll") for (int m = 0; m < 4; ++m) _Pragma("unroll") for (int k = 0; k < 2; ++k) dst[m][k] = *(const LAS bf16x8*)(lds + PG8_SA(b, h) + aoff + m * 2048 + k * 1024); } while (0)
#define PG8_LDB(dst, b, h) do { _Pragma("unroll") for (int n = 0; n < 2; ++n) _Pragma("unroll") for (int k = 0; k < 2; ++k) dst[n][k] = *(const LAS bf16x8*)(lds + PG8_SB(b, h) + boff + n * 2048 + k * 1024); } while (0)
#define PG8_MMA(ai, bj, At, Bt) do { __builtin_amdgcn_s_setprio(1); _Pragma("unroll") for (int m = 0; m < 4; ++m) _Pragma("unroll") for (int n = 0; n < 2; ++n) _Pragma("unroll") for (int k = 0; k < 2; ++k) \
        acc[ai][bj][m][n] = __builtin_amdgcn_mfma_f32_16x16x32_bf16(Bt[n][k], At[m][k], acc[ai][bj][m][n], 0, 0, 0); __builtin_amdgcn_s_setprio(0); } while (0)
#define PG8_WAIT_V(n) asm volatile("s_waitcnt vmcnt(" #n ")" ::: "memory")
#define PG8_WAIT_L(n) asm volatile("s_waitcnt lgkmcnt(" #n ")" ::: "memory")
#define PG8_BAR __builtin_amdgcn_s_barrier()
#define PG8_SCHED __builtin_amdgcn_sched_barrier(0)
    Unit cur, nxt; int ui = 0;
    if (!S.next(0, cur)) return;
    f32x4 acc[2][2][4][2];
#pragma unroll
    for (int a = 0; a < 2; ++a)
#pragma unroll
        for (int b = 0; b < 2; ++b)
#pragma unroll
            for (int m = 0; m < 4; ++m)
#pragma unroll
                for (int n = 0; n < 2; ++n) acc[a][b][m][n] = (f32x4){0.f, 0.f, 0.f, 0.f};
    bf16x8 At[4][2], B0[2][2], B1[2][2];
    const char* cA = (const char*)(cur.sel ? g.A1 : g.A0) + (size_t)cur.pm * tstep; const char* cB = (const char*)(cur.sel ? g.B1 : g.B0) + (size_t)cur.pn * tstep;
    PG8_STAGE(PG8_SB(0, 0), cB); PG8_STAGE(PG8_SB(0, 1), cB + hstep); PG8_STAGE(PG8_SA(0, 0), cA); PG8_STAGE(PG8_SA(0, 1), cA + hstep);
    if (wr == 1) PG8_BAR;
    PG8_WAIT_V(2); PG8_BAR;
    PG8_STAGE(PG8_SB(1, 0), cB + kstep); PG8_STAGE(PG8_SA(1, 0), cA + kstep); PG8_STAGE(PG8_SB(1, 1), cB + hstep + kstep);
    PG8_WAIT_V(6); PG8_BAR;
    for (;;) {
        const bool has_next = S.next(ui + 1, nxt);
        const char* nA = has_next ? (const char*)(nxt.sel ? g.A1 : g.A0) + (size_t)nxt.pm * tstep : cA; const char* nB = has_next ? (const char*)(nxt.sel ? g.B1 : g.B0) + (size_t)nxt.pn * tstep : cB;
        for (int t = 0; t < nt; t += 2) {
            const bool last = (t == nt - 2);
            const char* a1 = cA + (size_t)(t + 1) * kstep;
            const char* a2 = last ? nA : cA + (size_t)(t + 2) * kstep; const char* b2 = last ? nB : cB + (size_t)(t + 2) * kstep;
            const char* a3 = a2 + kstep; const char* b3 = b2 + kstep;
            if constexpr (Epi::MID > 0) { if (t == Epi::MID) E.mid(acc, cur, wr, fr); }
            PG8_LDB(B0, 0, 0); PG8_LDB(B1, 0, 1); PG8_SCHED; PG8_LDA(At, 0, 0); PG8_STAGE(PG8_SA(1, 1), a1 + hstep);
            PG8_WAIT_V(8); PG8_WAIT_L(0); PG8_BAR; PG8_MMA(0, 0, At, B0); PG8_MMA(0, 1, At, B1); PG8_BAR; PG8_SCHED;
            PG8_LDA(At, 0, 1); PG8_STAGE(PG8_SB(0, 0), b2); PG8_STAGE(PG8_SB(0, 1), b2 + hstep); PG8_STAGE(PG8_SA(0, 0), a2);
            PG8_WAIT_V(8); PG8_WAIT_L(0); PG8_BAR; PG8_MMA(1, 0, At, B0); PG8_MMA(1, 1, At, B1); PG8_BAR; PG8_SCHED;
            PG8_LDB(B0, 1, 0); PG8_LDB(B1, 1, 1); PG8_SCHED; PG8_LDA(At, 1, 0); PG8_STAGE(PG8_SA(0, 1), a2 + hstep);
            PG8_WAIT_V(8); PG8_WAIT_L(0); PG8_BAR; PG8_MMA(0, 0, At, B0); PG8_MMA(0, 1, At, B1); PG8_BAR; PG8_SCHED;
            PG8_LDA(At, 1, 1); PG8_STAGE(PG8_SB(1, 0), b3); PG8_STAGE(PG8_SB(1, 1), b3 + hstep); PG8_STAGE(PG8_SA(1, 0), a3);
            PG8_WAIT_V(8); PG8_WAIT_L(0); PG8_BAR; PG8_MMA(1, 0, At, B0); PG8_MMA(1, 1, At, B1); PG8_BAR; PG8_SCHED;
        }
        if (wr == 0) PG8_BAR;
        E(acc, cur, wr, wc, fr, fq);
        if (!has_next) break;
#pragma unroll
        for (int a = 0; a < 2; ++a)
#pragma unroll
            for (int b = 0; b < 2; ++b)
#pragma unroll
                for (int m = 0; m < 4; ++m)
#pragma unroll
                    for (int n = 0; n < 2; ++n) acc[a][b][m][n] = (f32x4){0.f, 0.f, 0.f, 0.f};
        cur = nxt; cA = nA; cB = nB; ++ui;
        if (wr == 1) PG8_BAR;
    }
    PG8_WAIT_V(0);
    PG8_BAR;
#undef PG8_SA
#undef PG8_SB
#undef PG8_STAGE
#undef PG8_LDA
#undef PG8_LDB
#undef PG8_MMA
#undef PG8_WAIT_V
#undef PG8_WAIT_L
#undef PG8_BAR
#undef PG8_SCHED
}
typedef f32x4 Acc[2][2][4][2];
__device__ __forceinline__ void store_f32(const Acc& acc, float* base, int ld, int rl0, int cl0, int valid) {
#pragma unroll
    for (int ai = 0; ai < 2; ++ai)
#pragma unroll
        for (int m = 0; m < 4; ++m) { const int row = rl0 + ai * HALF + m * 16; if (row < valid) { float* rp = base + (size_t)row * ld + cl0;
#pragma unroll
            for (int bj = 0; bj < 2; ++bj)
#pragma unroll
                for (int n = 0; n < 2; ++n) *(f32x4*)(rp + bj * HALF + n * 16) = acc[ai][bj][m][n]; } }
}
__device__ __forceinline__ void store_bf16(const Acc& acc, bf16_t* base, int ld, int rl0, int cl0) {
#pragma unroll
    for (int ai = 0; ai < 2; ++ai)
#pragma unroll
        for (int m = 0; m < 4; ++m) { const int row = rl0 + ai * HALF + m * 16; bf16_t* rp = base + (size_t)row * ld + cl0;
#pragma unroll
            for (int bj = 0; bj < 2; ++bj)
#pragma unroll
                for (int n = 0; n < 2; ++n) { const f32x4 a = acc[ai][bj][m][n]; u32x2 w; w.x = cvtpk(a[0], a[1]); w.y = cvtpk(a[2], a[3]); *(u32x2*)(rp + bj * HALF + n * 16) = w; } }
}
}

struct Params {
    const float* in[26];
    float* out;
    unsigned char* ws;
    int ph_lo, ph_hi;
};
enum { I_XP = 0, I_XS, I_CK, I_CV, I_SSM, I_SCONV, I_CMK, I_CMV, I_PT, I_MEM, I_NORMW, I_WIN, I_QNORM, I_KNORM, I_SBBIAS, I_CONVW, I_CONVB, I_DTBIAS, I_ALOG, I_DSKIP,
       I_SSDNW, I_MEMNW, I_WMEM, I_MQNORM, I_MKNORM, I_WOUT };

#define PSTAMP0(i) do { if (PROBE_SEG >= 40 && blockIdx.x == 0 && threadIdx.x == 0) ((volatile LAS unsigned long long*)(ctlw + 32))[20 + (i)] = __builtin_amdgcn_s_memrealtime(); } while (0)
struct TrItem { const float* src; bf16_t* dst; bool ok; };
__device__ __forceinline__ TrItem tr_item(const Params& p, int it, int lane) {
    constexpr int I_IN = (DM / 32) * (NPAD / 128), I_M = (DM / 32) * (1024 / 128);
    const float* W; bf16_t* WT; int Nsrc, N, map;
    if (it < I_IN) { W = p.in[I_WIN]; WT = (bf16_t*)(p.ws + WS_WIN); Nsrc = NIN; N = NPAD; map = 1; }
    else if (it < I_IN + I_M) { it -= I_IN; W = p.in[I_WMEM]; WT = (bf16_t*)(p.ws + WS_WM); Nsrc = 1024; N = 1024; map = 0; }
    else { it -= I_IN + I_M; W = p.in[I_WOUT]; WT = (bf16_t*)(p.ws + WS_WOUT); Nsrc = DM; N = DM; map = 2; }
    const int nblk = N / 128, kb = it / nblk, nb = it % nblk, k0 = 32 * kb, n0 = 128 * nb;
    const int ks0 = (map == 2) ? (k0 < 512 ? k0 + 1024 : (k0 < 1536 ? k0 - 512 : k0)) : k0;
    const int nd = n0 + 4 * (lane & 31);
    int ns = nd; bool ok = true;
    if (map == 1) { if (nd < 5632) ns = nd; else if (nd < 6656) ns = nd + 8; else if (nd < 6664) ns = nd - 1024; else { ns = 0; ok = false; } }
    TrItem t; t.src = W + (size_t)(ks0 + (lane >> 5)) * Nsrc + ns; t.dst = WT + (size_t)(n0 + (lane & 15)) * DM + k0 + 8 * (lane >> 4); t.ok = ok;
    return t;
}
__device__ __forceinline__ int tr_nsrc(int it) { constexpr int I_IN = (DM / 32) * (NPAD / 128), I_M = (DM / 32) * (1024 / 128); return it < I_IN ? NIN : (it < I_IN + I_M ? 1024 : DM); }
__device__ __forceinline__ void tr_load(const TrItem& t, int nsrc, f32x4 (&v)[16]) {
#pragma unroll
    for (int i = 0; i < 16; ++i) v[i] = t.ok ? *(const f32x4*)(t.src + (size_t)(2 * i) * nsrc) : f32x4{0.f, 0.f, 0.f, 0.f};
}
__device__ __forceinline__ void tr_finish(const TrItem& t, const f32x4 (&v)[16], LAS float* scr, int lane) {
#pragma unroll
    for (int i = 0; i < 16; ++i) { const int kk = 2 * i + (lane >> 5); *(LAS f32x4*)(scr + kk * 132 + 4 * (lane & 31)) = v[i]; }
    asm volatile("s_waitcnt lgkmcnt(0)" ::: "memory");
    const int nl = lane & 15, c = lane >> 4;
#pragma unroll
    for (int j = 0; j < 8; ++j) { const LAS float* sp = scr + (8 * c) * 132 + nl + 16 * j;
        u32x4 o; o.x = cvtpk(sp[0 * 132], sp[1 * 132]); o.y = cvtpk(sp[2 * 132], sp[3 * 132]); o.z = cvtpk(sp[4 * 132], sp[5 * 132]); o.w = cvtpk(sp[6 * 132], sp[7 * 132]);
        *(u32x4*)(t.dst + (size_t)(16 * j) * DM) = o; }
    asm volatile("s_waitcnt lgkmcnt(0)" ::: "memory");
}
__device__ __forceinline__ const float* p0_row_src(const Params& p, int m) { return m < MP ? p.in[I_XP] + (size_t)m * DM : (m < MVALID ? p.in[I_XS] + (size_t)(m - MP) * DM : p.in[I_MEM] + (size_t)(m - MVALID) * DM); }
__device__ __forceinline__ void p0_row_finish(const Params& p, int m, const f32x4 (&v)[8], int lane) {
    float s = 0.f;
#pragma unroll
    for (int j = 0; j < 8; ++j) s += (v[j].x * v[j].x + v[j].y * v[j].y) + (v[j].z * v[j].z + v[j].w * v[j].w);
    const float rs = 1.f / sqrtf(wave_sum(s) * (1.f / DM) + EPS);
    const f32x4* gr = (const f32x4*)(m < MVALID ? p.in[I_NORMW] : p.in[I_MEMNW]) + lane;
    bf16_t* orow = m < MVALID ? (bf16_t*)(p.ws + WS_H) + (size_t)m * DM : (bf16_t*)(p.ws + WS_HM) + (size_t)(m - MVALID) * DM;
    u32x2* o8 = (u32x2*)orow + lane;
#pragma unroll
    for (int j = 0; j < 8; ++j) { const f32x4 g = gr[64 * j]; u32x2 w; w.x = cvtpk(v[j].x * rs * g.x, v[j].y * rs * g.y); w.y = cvtpk(v[j].z * rs * g.z, v[j].w * rs * g.w); o8[64 * j] = w; }
}
__device__ __forceinline__ void phase0(const Params& p, LAS unsigned char* lds, int vcu, int G, volatile LAS unsigned* ctlw) {
    const int tid = threadIdx.x, lane = tid & 63, wave = __builtin_amdgcn_readfirstlane(tid >> 6);
    LAS float* scr = (LAS float*)(lds + wave * 16896);
    const int gw = vcu * 8 + wave, NGW = G * 8;
    constexpr int NITEMS = (DM / 32) * (NPAD / 128) + (DM / 32) * (1024 / 128) + (DM / 32) * (DM / 128);
    PSTAMP0(0);
    {
        f32x4 va[16], vb[16];
        int it = gw;
        TrItem ta{}, tb{};
        if (it < NITEMS) { ta = tr_item(p, it, lane); tr_load(ta, tr_nsrc(it), va); }
        while (it < NITEMS) {
            const int itb = it + NGW;
            if (itb < NITEMS) { tb = tr_item(p, itb, lane); tr_load(tb, tr_nsrc(itb), vb); }
            tr_finish(ta, va, scr, lane);
            if (itb >= NITEMS) break;
            const int ita = itb + NGW;
            if (ita < NITEMS) { ta = tr_item(p, ita, lane); tr_load(ta, tr_nsrc(ita), va); }
            tr_finish(tb, vb, scr, lane);
            it = ita;
        }
    }
    PSTAMP0(1);
    {
        f32x4 va[8], vb[8];
        int m = gw;
        if (m < MVALID + MMEM) { const f32x4* xr = (const f32x4*)p0_row_src(p, m) + lane;
#pragma unroll
            for (int j = 0; j < 8; ++j) va[j] = xr[64 * j]; }
        while (m < MVALID + MMEM) {
            const int mb = m + NGW;
            if (mb < MVALID + MMEM) { const f32x4* xr = (const f32x4*)p0_row_src(p, mb) + lane;
#pragma unroll
                for (int j = 0; j < 8; ++j) vb[j] = xr[64 * j]; }
            p0_row_finish(p, m, va, lane);
            if (mb >= MVALID + MMEM) break;
            const int ma = mb + NGW;
            if (ma < MVALID + MMEM) { const f32x4* xr = (const f32x4*)p0_row_src(p, ma) + lane;
#pragma unroll
                for (int j = 0; j < 8; ++j) va[j] = xr[64 * j]; }
            p0_row_finish(p, mb, vb, lane);
            m = ma;
        }
    }
    PSTAMP0(2);
    const int gt = vcu * 512 + tid, NGT = G * 512;
    u32x4* cmk = (u32x4*)(p.ws + WS_CMK); u32x4* cmv = (u32x4*)(p.ws + WS_CMV);
    constexpr int N8 = DSEQ * MEMT * 512 / 8;
    for (int i = gt; i < 2 * N8; i += NGT) { const bool isk = i < N8; const int j = isk ? i : i - N8; const f32x4* s = (const f32x4*)(isk ? p.in[I_CMK] : p.in[I_CMV]) + 2 * (size_t)j;
        const f32x4 a = s[0], b = s[1]; u32x4 o; o.x = cvtpk(a.x, a.y); o.y = cvtpk(a.z, a.w); o.z = cvtpk(b.x, b.y); o.w = cvtpk(b.z, b.w); (isk ? cmk : cmv)[j] = o; }
    PSTAMP0(3);
}

struct Epi1 {
    static constexpr int MID = 0;
    bf16_t* PROJ; float* DT; float* out; const float* dtbias; const float* qn; const float* kn; const float* mqn; const float* mkn; bf16_t* MKn; bf16_t* MVb; LAS float* T;
    __device__ __forceinline__ void head_norm(pg8::Acc& acc, const float* gain, float gscale, int wr, int wc, int fr, int fq) const {
        float part[2][4][2];
#pragma unroll
        for (int ai = 0; ai < 2; ++ai)
#pragma unroll
            for (int m = 0; m < 4; ++m)
#pragma unroll
                for (int bj = 0; bj < 2; ++bj) { const f32x4 a = acc[ai][bj][m][0], b = acc[ai][bj][m][1];
                    float s = ((a.x * a.x + a.y * a.y) + (a.z * a.z + a.w * a.w)) + ((b.x * b.x + b.y * b.y) + (b.z * b.z + b.w * b.w));
                    s += __shfl_xor(s, 16); s += __shfl_xor(s, 32); part[ai][m][bj] = s; }
        if (fq == 0) {
#pragma unroll
            for (int ai = 0; ai < 2; ++ai)
#pragma unroll
                for (int m = 0; m < 4; ++m)
#pragma unroll
                    for (int bj = 0; bj < 2; ++bj) T[(((wr * 128 + ai * 64 + m * 16 + fr) * 2 + bj) << 2) + wc] = part[ai][m][bj];
        }
        asm volatile("s_waitcnt lgkmcnt(0)" ::: "memory");
        __builtin_amdgcn_s_barrier();
        asm volatile("" ::: "memory");
        int cg = wc * 32 + 4 * fq; asm volatile("" : "+v"(cg));
        const f32x4 g0 = *(const f32x4*)(gain + cg) * gscale, g1 = *(const f32x4*)(gain + cg + 16) * gscale;
#pragma unroll
        for (int ai = 0; ai < 2; ++ai)
#pragma unroll
            for (int m = 0; m < 4; ++m)
#pragma unroll
                for (int bj = 0; bj < 2; ++bj) { const f32x4 t = *(const LAS f32x4*)(T + (((wr * 128 + ai * 64 + m * 16 + fr) * 2 + bj) << 2));
                    const float rs = 1.f / sqrtf(((t.x + t.y) + (t.z + t.w)) * (1.f / 128.f) + EPS);
                    acc[ai][bj][m][0] = acc[ai][bj][m][0] * rs * g0; acc[ai][bj][m][1] = acc[ai][bj][m][1] * rs * g1;
                    asm volatile("" ::: "memory"); }
    }
    __device__ __forceinline__ void operator()(pg8::Acc& acc, const pg8::Unit& u, int wr, int wc, int fr, int fq) const {
        int rl0 = wr * 64 + fr, cl0 = wc * 32 + 4 * fq;
        asm volatile("" : "+v"(rl0), "+v"(cl0));
        const int pn = u.pn; const size_t r0 = (size_t)u.pm * 256;
        const float* gain = nullptr; float gs = 1.f;
        float* fbase = nullptr; int fld = 1024, valid = 256;
        bf16_t* bbase = PROJ + r0 * NPAD + pn * 256; int bld = NPAD;
        if (u.sel == 1) { if (pn < 2) gain = mkn; fbase = out + (pn < 2 ? O_PMK : O_PMV) + r0 * 512 + (pn & 1) * 256; fld = 512; bbase = (pn < 2 ? MKn : MVb) + r0 * 512 + (pn & 1) * 256; bld = 512; }
        else {
            if (pn < 4) { gain = qn; gs = QSCALE; } else if (pn < 8) gain = kn; else if (pn == 22 || pn == 23) { gain = mqn; gs = QSCALE; }
            if (pn >= 4 && pn < 12) { if (u.pm < 32) fbase = out + (pn < 8 ? O_PK : O_PV) + r0 * 1024 + (pn & 3) * 256; else { fbase = out + (pn < 8 ? O_SK : O_SV) + (pn & 3) * 256; valid = MS; } }
        }
        if (gain) head_norm(acc, gain, gs, wr, wc, fr, fq);
        if (fbase) pg8::store_f32(acc, fbase, fld, rl0, cl0, valid);
        pg8::store_bf16(acc, bbase, bld, rl0, cl0);
        if (u.sel == 1) return;
        if (pn >= 18 && pn < 22) {
#pragma unroll
            for (int ai = 0; ai < 2; ++ai)
#pragma unroll
                for (int m = 0; m < 4; ++m) { const int row = rl0 + ai * 128 + m * 16; float* dst = nullptr;
                    if (u.pm < 32) { if ((u.pm & 7) == 7 && row >= 253) dst = out + O_PCONV + (size_t)((u.pm >> 3) * 3 + row - 253) * 1024; }
                    else if (row < MS && (row & 7) >= 5) dst = out + O_SCONV + (size_t)((row >> 3) * 3 + (row & 7) - 5) * 1024;
                    if (dst) { dst += (pn - 18) * 256 + cl0;
#pragma unroll
                        for (int bj = 0; bj < 2; ++bj)
#pragma unroll
                            for (int n = 0; n < 2; ++n) *(f32x4*)(dst + bj * 128 + n * 16) = acc[ai][bj][m][n]; } }
        }
        if (pn == 26 && wc == 0 && fq < 2) {
            const f32x4 db = *(const f32x4*)(dtbias + 4 * fq);
#pragma unroll
            for (int ai = 0; ai < 2; ++ai)
#pragma unroll
                for (int m = 0; m < 4; ++m) { const int row = rl0 + ai * 128 + m * 16; f32x4 v = acc[ai][0][m][0] + db;
#pragma unroll
                    for (int e = 0; e < 4; ++e) v[e] = (v[e] > 20.f) ? v[e] : log1pf(__expf(v[e]));
                    *(f32x4*)(DT + (r0 + row) * 8 + 4 * fq) = v; }
        }
    }
};

__device__ __forceinline__ float group16_sum(float v) { v += __shfl_xor(v, 1); v += __shfl_xor(v, 2); v += __shfl_xor(v, 4); v += __shfl_xor(v, 8); return v; }

#define KSWZ(row, colB) ((row) * 256 + ((colB) ^ (((row) & 7) << 4)))
#define SBAR() __builtin_amdgcn_sched_barrier(0)
__device__ __forceinline__ int crow(int r, int hi) { return (r & 3) + 8 * (r >> 2) + 4 * hi; }
__device__ __forceinline__ int v_st(int k, int c) { const int kk = (k & ~0xC) | ((k & 4) << 1) | ((k & 8) >> 1); return ((kk >> 3) * 4 + (c >> 5)) * 512 + ((kk & 7) * 32 + (c & 31)) * 2; }
__device__ __forceinline__ int v_rd_base(int lane) { return ((lane & 3) << 3) | (((lane >> 2) & 3) << 6) | (((lane >> 4) & 1) << 5) | (((lane >> 5) & 1) << 8); }
constexpr int v_rd_off(int d0, int ks, int half) { return d0 * 512 + ks * 4096 + half * 2048; }
template <int OFF> __device__ __forceinline__ s16x4 tr_read(int vb) {
    s16x4 r; asm volatile("ds_read_b64_tr_b16 %0, %1 offset:%2" : "=&v"(r) : "v"(vb), "i"(OFF) : "memory"); return r;
}
#define PKV(L, H) (bf16x8){L[0], L[1], L[2], L[3], H[0], H[1], H[2], H[3]}
template <int D0, int KS0> __device__ __forceinline__ void pv_one(f32x16& od, int vb, const bf16x8* pa) {
    const s16x4 l0 = tr_read<v_rd_off(D0, KS0, 0)>(vb), h0 = tr_read<v_rd_off(D0, KS0, 1)>(vb), l1 = tr_read<v_rd_off(D0, KS0 + 1, 0)>(vb), h1 = tr_read<v_rd_off(D0, KS0 + 1, 1)>(vb);
    asm volatile("s_waitcnt lgkmcnt(0)" ::: "memory"); SBAR();
    od = __builtin_amdgcn_mfma_f32_32x32x16_bf16(pa[0], PKV(l0, h0), od, 0, 0, 0);
    od = __builtin_amdgcn_mfma_f32_32x32x16_bf16(pa[1], PKV(l1, h1), od, 0, 0, 0);
}
template <int KS0> __device__ __forceinline__ void pv_blk(f32x16* o, int vb, const bf16x8* pa) {
    pv_one<0, KS0>(o[0], vb, pa); pv_one<1, KS0>(o[1], vb, pa); pv_one<2, KS0>(o[2], vb, pa); pv_one<3, KS0>(o[3], vb, pa);
}
__device__ __forceinline__ void pack_p(const f32x16& P, bf16x8& out0, bf16x8& out1) {
#define PK4(BASE, OUT) do { unsigned a0 = cvtpk(P[BASE + 0], P[BASE + 1]), a1 = cvtpk(P[BASE + 2], P[BASE + 3]);   \
    unsigned b0 = cvtpk(P[BASE + 4], P[BASE + 5]), b1 = cvtpk(P[BASE + 6], P[BASE + 7]);                              \
    auto r0 = __builtin_amdgcn_permlane32_swap(a0, b0, false, false); auto r1 = __builtin_amdgcn_permlane32_swap(a1, b1, false, false); \
    u32x4 w = {r0[0], r1[0], r0[1], r1[1]}; OUT = *reinterpret_cast<bf16x8*>(&w); } while (0)
    PK4(0, out0); PK4(8, out1);
#undef PK4
}
template <int NB, bool MASK> __device__ __forceinline__ void sb_transform(f32x16* P, float& R, int hi, int kpos0, int qpos) {
    float T[NB][4];
#pragma unroll
    for (int b = 0; b < NB; ++b)
#pragma unroll
        for (int g = 0; g < 4; ++g) {
            float be[4], f[4];
#pragma unroll
            for (int i = 0; i < 4; ++i) {
                const float z = fmaxf(P[b][4 * g + i], -100.f);
                const float e = fast_exp2(-z), rc = fast_rcp(1.f + e);
                be[i] = rc; f[i] = e * rc;
                if (MASK) { const bool ok = (kpos0 + 32 * b + 8 * g + 4 * hi + i) < qpos; be[i] = ok ? be[i] : 0.f; f[i] = ok ? f[i] : 1.f; }
            }
            const float e2 = f[3], e1 = f[2] * f[3], e0 = f[1] * e1;
            T[b][g] = f[0] * e0;
            P[b][4 * g + 0] = be[0] * e0; P[b][4 * g + 1] = be[1] * e1; P[b][4 * g + 2] = be[2] * e2; P[b][4 * g + 3] = be[3];
        }
    float E = R;
#pragma unroll
    for (int b = NB - 1; b >= 0; --b)
#pragma unroll
        for (int g = 3; g >= 0; --g) {
            const float To = __shfl_xor(T[b][g], 32);
            const float Eg = hi ? E : E * To;
#pragma unroll
            for (int i = 0; i < 4; ++i) P[b][4 * g + i] *= Eg;
            E = E * T[b][g] * To;
        }
    R = E;
}

struct AttnArgs {
    const bf16_t* Q; int qstride;
    const bf16_t* K; const bf16_t* V; int kvstride;
    int ntiles;
    int qpos0;
    int nvalid;
    float bias2;
    const bf16_t* gate; int gstride;
    bf16_t* out; int ostride;
};
struct GroupBar { volatile LAS unsigned* cnt; unsigned gen; };
__device__ __forceinline__ void group_bar(GroupBar& gb, int lane) {
    asm volatile("s_waitcnt lgkmcnt(0)" ::: "memory");
    gb.gen += 4u;
    if (lane == 0) (void)__hip_atomic_fetch_add((LAS unsigned*)gb.cnt, 1u, __ATOMIC_RELAXED, __HIP_MEMORY_SCOPE_WORKGROUP);
    while (__hip_atomic_load((LAS unsigned*)gb.cnt, __ATOMIC_RELAXED, __HIP_MEMORY_SCOPE_WORKGROUP) < gb.gen) __builtin_amdgcn_s_sleep(0);
    asm volatile("" ::: "memory");
}
template <int MODE>
__device__ __forceinline__ void attn_unit(LAS unsigned char* lds, GroupBar& gb, const bf16_t* aQ, int aqstride, const bf16_t* aK, const bf16_t* aV, int akvstride, int antiles, int aqpos0, int anvalid, float abias2,
                                      const bf16_t* agate, int agstride, bf16_t* aout, int aostride) {
    AttnArgs a; a.Q = aQ; a.qstride = aqstride; a.K = aK; a.V = aV; a.kvstride = akvstride; a.ntiles = antiles; a.qpos0 = aqpos0; a.nvalid = anvalid; a.bias2 = abias2;
    a.gate = agate; a.gstride = agstride; a.out = aout; a.ostride = aostride;
    int tid = threadIdx.x; asm volatile("" : "+v"(tid));
    const int wid = __builtin_amdgcn_readfirstlane(tid >> 6), lane = tid & 63, r32 = lane & 31, hi = lane >> 5;
    constexpr int SHM_V = 16384, SHM_K = 16384;
    LAS unsigned char* V_lds = lds; LAS unsigned char* K_lds = lds + 2 * SHM_V;
    LAS float* wsf = (LAS float*)(lds + 73728) + wid * 64;
    f32x16 o[4];
#pragma unroll
    for (int d = 0; d < 4; ++d) o[d] = f32x16{};
    bf16x8 qr[8];
    { int qrow = wid * 32 + r32; qrow = qrow < a.nvalid ? qrow : a.nvalid - 1;
      const bf16_t* Qw = a.Q + (size_t)qrow * a.qstride + hi * 8;
#pragma unroll
      for (int d0 = 0; d0 < 8; ++d0) qr[d0] = *(const bf16x8*)(Qw + d0 * 16); }
    const int sr = tid >> 4, sc = (tid & 15) * 8;
    const int vb0 = (int)(uintptr_t)V_lds + v_rd_base(lane);
    bf16x8 sv[4], sk[4];
#define SLOAD(k0) do { _Pragma("unroll") for (int j_ = 0; j_ < 4; ++j_) { sv[j_] = *(const bf16x8*)(a.V + (size_t)((k0) + sr + 16 * j_) * a.kvstride + sc); \
        sk[j_] = *(const bf16x8*)(a.K + (size_t)((k0) + sr + 16 * j_) * a.kvstride + sc); } } while (0)
#define SWRITE(b) do { _Pragma("unroll") for (int j_ = 0; j_ < 4; ++j_) { *(LAS bf16x8*)(V_lds + (b) * SHM_V + v_st(sr + 16 * j_, sc)) = sv[j_]; \
        *(LAS bf16x8*)(K_lds + (b) * SHM_K + KSWZ(sr + 16 * j_, sc * 2)) = sk[j_]; } } while (0)
    const int nt = a.ntiles;
    float R = 1.f, lsum = 0.f;
    const int qpos = a.qpos0 + wid * 32 + r32;
    const int qmax_w = a.qpos0 + wid * 32 + 31;
    group_bar(gb, lane);
    { const int t0 = (MODE == 0) ? nt - 1 : 0; SLOAD(t0 * 64); SWRITE(0); }
    group_bar(gb, lane);
    for (int j = 0; j < nt; ++j) {
        const int cur = j & 1, t = (MODE == 0) ? nt - 1 - j : j;
        if (j + 1 < nt) { const int tn = (MODE == 0) ? t - 1 : t + 1; SLOAD(tn * 64); }
        const bool active = (MODE == 1) || (t * 64 < qmax_w);
        if (active) {
            const LAS unsigned char* Ks = K_lds + cur * SHM_K;
            const bool diag = (MODE == 0) && (t * 64 + 63 >= a.qpos0);
#define ATT_BLOCK(B) do { f32x16 pb_[1]; { const float init = (MODE == 0) ? a.bias2 : 0.f; _Pragma("unroll") for (int r = 0; r < 16; ++r) pb_[0][r] = init; } \
            _Pragma("unroll") for (int d0 = 0; d0 < 8; ++d0) { const int cb = (d0 * 16 + hi * 8) * 2; \
                const bf16x8 kf = *(const LAS bf16x8*)(Ks + KSWZ(32 * (B) + r32, cb)); \
                pb_[0] = __builtin_amdgcn_mfma_f32_32x32x16_bf16(kf, qr[d0], pb_[0], 0, 0, 0); } \
            if (MODE == 0) { if (diag) sb_transform<1, true>(pb_, R, hi, t * 64 + 32 * (B), qpos); else sb_transform<1, false>(pb_, R, hi, 0, 0); } \
            else { float ps = 0.f; _Pragma("unroll") for (int r = 0; r < 16; ++r) { pb_[0][r] = fast_exp2(pb_[0][r]); ps += pb_[0][r]; } lsum += ps; } \
            bf16x8 pa_[2]; pack_p(pb_[0], pa_[0], pa_[1]); SBAR(); \
            pv_blk<2 * (B)>(o, vb0 + cur * SHM_V, pa_); } while (0)
            ATT_BLOCK(1);
            ATT_BLOCK(0);
#undef ATT_BLOCK
        }
        if (j + 1 < nt) SWRITE(cur ^ 1);
        group_bar(gb, lane);
    }
#undef SLOAD
#undef SWRITE
    float rl[16];
    if (MODE == 1) {
        lsum += __shfl_xor(lsum, 32);
        if (hi == 0) wsf[r32] = lsum;
        asm volatile("s_waitcnt lgkmcnt(0)" ::: "memory");
#pragma unroll
        for (int r = 0; r < 16; ++r) rl[r] = fast_rcp(wsf[crow(r, hi)]);
    }
    LAS unsigned char* ost = lds + wid * (32 * 272);
#pragma unroll
    for (int r = 0; r < 16; ++r)
#pragma unroll
        for (int d0 = 0; d0 < 4; ++d0) { float v = o[d0][r]; if (MODE == 1) v *= rl[r];
            *(LAS bf16_t*)(ost + crow(r, hi) * 272 + (d0 * 32 + r32) * 2) = f2bf(v); }
    asm volatile("s_waitcnt lgkmcnt(0)" ::: "memory");
    {
        const int row = wid * 32 + (lane >> 1), c0 = (lane & 1) * 64;
        if (row < a.nvalid) {
            const bf16_t* gp = a.gate + (size_t)row * a.gstride + c0; bf16_t* op = a.out + (size_t)row * a.ostride + c0;
            u32x4 gv[8];
#pragma unroll
            for (int j = 0; j < 8; ++j) gv[j] = *(const u32x4*)(gp + 8 * j);
#pragma unroll
            for (int j = 0; j < 8; ++j) { const u32x4 ov = *(const LAS u32x4*)(ost + (lane >> 1) * 272 + (c0 + 8 * j) * 2); u32x4 w;
#pragma unroll
                for (int e = 0; e < 4; ++e) w[e] = cvtpk(bf_lo(ov[e]) * silu_f(bf_lo(gv[j][e])), bf_hi(ov[e]) * silu_f(bf_hi(gv[j][e])));
                *(u32x4*)(op + 8 * j) = w; }
        }
    }
}

__device__ __forceinline__ void sb_transform16(f32x4 (&st)[2], float& R, int lane, int kg) {
    float T[2];
#pragma unroll
    for (int rb = 0; rb < 2; ++rb) {
        float be[4], f[4];
#pragma unroll
        for (int i = 0; i < 4; ++i) { const float z = fmaxf(st[rb][i], -100.f); const float e = fast_exp2(-z), rc = fast_rcp(1.f + e); be[i] = rc; f[i] = e * rc; }
        const float e2 = f[3], e1 = f[2] * f[3], e0 = f[1] * e1;
        T[rb] = f[0] * e0;
        st[rb][0] = be[0] * e0; st[rb][1] = be[1] * e1; st[rb][2] = be[2] * e2; st[rb][3] = be[3];
    }
    float Tg[8];
#pragma unroll
    for (int k2 = 0; k2 < 4; ++k2) { const int src = ((lane & 15) + 16 * k2) * 4;
        Tg[k2] = __builtin_bit_cast(float, __builtin_amdgcn_ds_bpermute(src, __builtin_bit_cast(int, T[0])));
        Tg[4 + k2] = __builtin_bit_cast(float, __builtin_amdgcn_ds_bpermute(src, __builtin_bit_cast(int, T[1]))); }
    float S[8]; S[7] = R;
#pragma unroll
    for (int G = 6; G >= 0; --G) S[G] = S[G + 1] * Tg[G + 1];
    const float E0 = kg == 0 ? S[0] : kg == 1 ? S[1] : kg == 2 ? S[2] : S[3];
    const float E1 = kg == 0 ? S[4] : kg == 1 ? S[5] : kg == 2 ? S[6] : S[7];
    st[0] = st[0] * E0; st[1] = st[1] * E1;
    R = S[0] * Tg[0];
}

constexpr int L0_FIRST = 96, L0_PAGES = NPAGES - L0_FIRST;
constexpr float SKIP_THR = 1.4551915e-11f;
constexpr int CW_L0CNT = 8192;
constexpr int N_DEC_L0 = DSEQ * 8 * L0_PAGES, N_DEC_ITEMS = N_DEC_L0 + DSEQ * 8 * (L0_FIRST / 2);
template <bool SC1>
__device__ __forceinline__ bool decode_skip_old_pages(const float* FPARTp, int seq, int head, int lane) {
    const float* Fp = FPARTp + ((size_t)((seq * 8 + head) * NPAGES + L0_FIRST)) * DTOK;
    const int q = lane & 7, grp = lane >> 3;
    float f[4];
#pragma unroll
    for (int k = 0; k < 4; ++k) { const float* a = Fp + (grp * 4 + k) * DTOK + q;
        f[k] = SC1 ? __builtin_bit_cast(float, __hip_atomic_load((const unsigned*)a, __ATOMIC_RELAXED, __HIP_MEMORY_SCOPE_AGENT)) : *a; }
    float pr = (f[0] * f[1]) * (f[2] * f[3]);
    pr *= __shfl_xor(pr, 8); pr *= __shfl_xor(pr, 16); pr *= __shfl_xor(pr, 32);
    float m = pr; m = fmaxf(m, __shfl_xor(m, 1)); m = fmaxf(m, __shfl_xor(m, 2)); m = fmaxf(m, __shfl_xor(m, 4));
    return m < SKIP_THR;
}

__device__ __forceinline__ void decode_page(const int* ptab, const float* ck, const float* cv, const float* sbbias, unsigned char* ws, LAS unsigned char* wlds, int seq, int page, int head, int lane) {
    const int j16 = lane & 15, kg = lane >> 4;
    constexpr int VLD = 272;
    LAS unsigned char* K_lds = wlds; LAS unsigned char* V_lds = wlds + 8192; LAS unsigned char* Q_lds = wlds + 8192 + 8704;
    const bf16_t* PROJ = (const bf16_t*)(ws + WS_PROJ);
    const int phys = __builtin_amdgcn_readfirstlane(ptab[seq * NPAGES + page]);
    const float bias2 = sbbias[head] * LOG2E;
    f32x4 o[8];
#pragma unroll
    for (int d = 0; d < 8; ++d) o[d] = f32x4{0.f, 0.f, 0.f, 0.f};
    float R = 1.f;
    const int srow = lane >> 4, scol = (lane & 15) * 8;
    const int vtr = (int)(uintptr_t)V_lds + (4 * kg + (j16 >> 2)) * VLD + 8 * (j16 & 3);
#pragma unroll
    for (int i = 0; i < 2; ++i) { const int c = lane + 64 * i, qrw = c >> 4, qc = (c & 15) * 8;
        *(LAS bf16x8*)(Q_lds + KSWZ(qrw, qc * 2)) = *(const bf16x8*)(PROJ + (size_t)(MP + seq * DTOK + qrw) * NPAD + PC_Q + head * 128 + qc); }
    f32x4 sk[16], sv[16];
    const __amdgpu_buffer_rsrc_t rK = __builtin_amdgcn_make_buffer_rsrc((void*)(ck + (size_t)phys * (PAGE * 1024)), 0, PAGE * 1024 * 4, 0x00020000);
    const __amdgpu_buffer_rsrc_t rV = __builtin_amdgcn_make_buffer_rsrc((void*)(cv + (size_t)phys * (PAGE * 1024)), 0, PAGE * 1024 * 4, 0x00020000);
    const int voff = (srow * 1024 + head * 128 + scol) * 4;
#define DLOAD(dst, rs, kb) do { _Pragma("unroll") for (int i = 0; i < 8; ++i) { const int so_ = ((kb) * 32 + 4 * i) * 4096; \
        dst[2 * i] = __builtin_bit_cast(f32x4, __builtin_amdgcn_raw_buffer_load_b128(rs, voff, so_, 2)); dst[2 * i + 1] = __builtin_bit_cast(f32x4, __builtin_amdgcn_raw_buffer_load_b128(rs, voff + 16, so_, 2)); } } while (0)
    DLOAD(sk, rK, 3); DLOAD(sv, rV, 3);
#pragma unroll 1
    for (int kb = 3; kb >= 0; --kb) {
#pragma unroll
        for (int i = 0; i < 8; ++i) { u32x4 w; w.x = cvtpk(sk[2 * i].x, sk[2 * i].y); w.y = cvtpk(sk[2 * i].z, sk[2 * i].w); w.z = cvtpk(sk[2 * i + 1].x, sk[2 * i + 1].y); w.w = cvtpk(sk[2 * i + 1].z, sk[2 * i + 1].w);
            *(LAS u32x4*)(K_lds + KSWZ(srow + 4 * i, scol * 2)) = w; }
        if (kb > 0) DLOAD(sk, rK, kb - 1);
        f32x4 st[2];
        st[0] = f32x4{bias2, bias2, bias2, bias2}; st[1] = st[0];
#pragma unroll
        for (int ks = 0; ks < 4; ++ks) { const int cb = (32 * ks + 8 * kg) * 2;
            const bf16x8 qf = *(const LAS bf16x8*)(Q_lds + KSWZ(j16 & 7, cb));
            const bf16x8 k0 = *(const LAS bf16x8*)(K_lds + KSWZ(j16, cb)), k1 = *(const LAS bf16x8*)(K_lds + KSWZ(16 + j16, cb));
            st[0] = __builtin_amdgcn_mfma_f32_16x16x32_bf16(k0, qf, st[0], 0, 0, 0);
            st[1] = __builtin_amdgcn_mfma_f32_16x16x32_bf16(k1, qf, st[1], 0, 0, 0); }
        sb_transform16(st, R, lane, kg);
        u32x4 af; af.x = cvtpk(st[0][0], st[0][1]); af.y = cvtpk(st[0][2], st[0][3]); af.z = cvtpk(st[1][0], st[1][1]); af.w = cvtpk(st[1][2], st[1][3]);
        const bf16x8 pfrag = __builtin_bit_cast(bf16x8, af);
#pragma unroll
        for (int i = 0; i < 8; ++i) { u32x4 w; w.x = cvtpk(sv[2 * i].x, sv[2 * i].y); w.y = cvtpk(sv[2 * i].z, sv[2 * i].w); w.z = cvtpk(sv[2 * i + 1].x, sv[2 * i + 1].y); w.w = cvtpk(sv[2 * i + 1].z, sv[2 * i + 1].w);
            *(LAS u32x4*)(V_lds + (srow + 4 * i) * VLD + scol * 2) = w; }
        if (kb > 0) DLOAD(sv, rV, kb - 1);
        SBAR();
#define DPV(DB) do { const s16x4 l_ = tr_read<(DB) * 32>(vtr), h_ = tr_read<(DB) * 32 + 16 * VLD>(vtr); asm volatile("s_waitcnt lgkmcnt(0)" ::: "memory"); SBAR(); \
        o[DB] = __builtin_amdgcn_mfma_f32_16x16x32_bf16(pfrag, PKV(l_, h_), o[DB], 0, 0, 0); } while (0)
        DPV(0); DPV(1); DPV(2); DPV(3); DPV(4); DPV(5); DPV(6); DPV(7);
#undef DPV
    }
#undef DLOAD
    if (kg < 2) {
        float* Op = (float*)(ws + WS_OPART) + ((size_t)((seq * 8 + head) * NPAGES + page)) * (DTOK * 128);
#pragma unroll
        for (int db = 0; db < 8; ++db)
#pragma unroll
            for (int r = 0; r < 4; ++r) Op[(4 * kg + r) * 128 + 16 * db + j16] = o[db][r];
    }
    if (lane < 8) __hip_atomic_store((unsigned*)(ws + WS_FPART) + ((size_t)((seq * 8 + head) * NPAGES + page)) * DTOK + lane, __builtin_bit_cast(unsigned, R), __ATOMIC_RELAXED, __HIP_MEMORY_SCOPE_AGENT);
}
__device__ __forceinline__ void decode_wave_loop(const int* ptab, const float* ck, const float* cv, const float* sbbias, unsigned char* ws, LAS unsigned char* wlds, unsigned* qhead, int lane) {
    int ckey = -1; bool cskip = false;
    unsigned* l0cnt = (unsigned*)(ws + WS_CTL) + CW_L0CNT;
    for (;;) {
        unsigned it = 0; if (lane == 0) it = __hip_atomic_fetch_add(qhead, 1u, __ATOMIC_RELAXED, __HIP_MEMORY_SCOPE_AGENT);
        it = __builtin_amdgcn_readfirstlane(it);
        if (it >= (unsigned)N_DEC_ITEMS) break;
        int seq, head, page0, npages;
        if (it < (unsigned)N_DEC_L0) { head = it & 7; page0 = L0_FIRST + ((it >> 3) & 31); seq = it >> 8; npages = 1; }
        else {
            const int j = (int)it - N_DEC_L0, rem = j % (DSEQ * (L0_FIRST / 2));
            head = 7 - j / (DSEQ * (L0_FIRST / 2)); seq = rem / (L0_FIRST / 2); page0 = 2 * (rem % (L0_FIRST / 2)); npages = 2;
            const int key = seq * 8 + head;
            if (key != ckey) {
                unsigned ok = 1u, sp = 0u;
                while (__builtin_amdgcn_readfirstlane(__hip_atomic_load(l0cnt + 64 * key, __ATOMIC_RELAXED, __HIP_MEMORY_SCOPE_AGENT)) < (unsigned)L0_PAGES) { __builtin_amdgcn_s_sleep(8); if (++sp > (1u << 20)) { ok = 0u; break; } }
                cskip = ok ? decode_skip_old_pages<true>((const float*)(ws + WS_FPART), seq, head, lane) : false; ckey = key;
            }
            if (cskip) continue;
        }
#pragma unroll 1
        for (int pg = 0; pg < npages; ++pg) decode_page(ptab, ck, cv, sbbias, ws, wlds, seq, page0 + pg, head, lane);
        if (npages == 1) {
            asm volatile("s_waitcnt vmcnt(0)" ::: "memory");
            if (lane == 0) __hip_atomic_fetch_add(l0cnt + 64 * (seq * 8 + head), 1u, __ATOMIC_RELAXED, __HIP_MEMORY_SCOPE_AGENT);
        }
    }
}

constexpr int SS_LD = 272;
__device__ __forceinline__ void scan128(float& v0, float& v1, int lane) {
#pragma unroll
    for (int o = 1; o < 64; o <<= 1) { const float t0 = __shfl_up(v0, o), t1 = __shfl_up(v1, o); if (lane >= o) { v0 += t0; v1 += t1; } }
    v1 += __shfl(v0, 63);
}
__device__ __forceinline__ void tr4x8(const u32x4 (&w)[4], u32x2 (&o)[8]) {
#pragma unroll
    for (int k = 0; k < 8; ++k) { const int d = k >> 1;
        if (k & 1) { o[k].x = (w[0][d] >> 16) | (w[1][d] & 0xffff0000u); o[k].y = (w[2][d] >> 16) | (w[3][d] & 0xffff0000u); }
        else       { o[k].x = (w[0][d] & 0xffffu) | (w[1][d] << 16);     o[k].y = (w[2][d] & 0xffffu) | (w[3][d] << 16); } }
}
template <bool SAMPLE>
__device__ __forceinline__ void conv_load(const bf16_t* PROJ, const float* sconv0, int rowbase, int bs, bool first_chunk, int l0, int ch0, u32x4 (&rw)[7]) {
#pragma unroll
    for (int r = 0; r < 7; ++r) { const int l = l0 - 3 + r;
        if (l >= 0 || !first_chunk) rw[r] = *(const u32x4*)(PROJ + (size_t)(rowbase + l) * NPAD + PC_XBC + ch0);
        else if (SAMPLE) { const f32x4* sp = (const f32x4*)(sconv0 + ((size_t)bs * 3 + (3 + l)) * 1024 + ch0); const f32x4 u0 = sp[0], u1 = sp[1];
            rw[r].x = cvtpk(u0.x, u0.y); rw[r].y = cvtpk(u0.z, u0.w); rw[r].z = cvtpk(u1.x, u1.y); rw[r].w = cvtpk(u1.z, u1.w); }
        else rw[r] = u32x4{0u, 0u, 0u, 0u}; }
}
__device__ __forceinline__ void conv_apply(const float* convw, const float* convb, int ch0, const u32x4 (&rw)[7], float (&ov)[4][8]) {
    float cw[4][8], cbv[8];
#pragma unroll
    for (int jj = 0; jj < 4; ++jj) { const f32x4* sp = (const f32x4*)(convw + jj * 1024 + ch0); const f32x4 u0 = sp[0], u1 = sp[1];
        cw[jj][0] = u0.x; cw[jj][1] = u0.y; cw[jj][2] = u0.z; cw[jj][3] = u0.w; cw[jj][4] = u1.x; cw[jj][5] = u1.y; cw[jj][6] = u1.z; cw[jj][7] = u1.w; }
    { const f32x4* sp = (const f32x4*)(convb + ch0); const f32x4 u0 = sp[0], u1 = sp[1];
        cbv[0] = u0.x; cbv[1] = u0.y; cbv[2] = u0.z; cbv[3] = u0.w; cbv[4] = u1.x; cbv[5] = u1.y; cbv[6] = u1.z; cbv[7] = u1.w; }
#pragma unroll
    for (int r = 0; r < 4; ++r)
#pragma unroll
        for (int k = 0; k < 8; ++k) { float t = cbv[k];
#pragma unroll
            for (int jj = 0; jj < 4; ++jj) { const unsigned w = rw[r + jj][k >> 1]; t = fmaf((k & 1) ? bf_hi(w) : bf_lo(w), cw[jj][k], t); }
            ov[r][k] = silu_f(t); }
}
constexpr int ST_BT = 0, ST_XTW = 34816, ST_F = 104448;
template <bool SAMPLE>
__device__ __forceinline__ void ssd_state_unit(unsigned char* ws, const float* alog, const float* sconv0, const float* convw, const float* convb, LAS unsigned char* lds, int bs, int c, int g) {
    int tid = threadIdx.x; asm volatile("" : "+v"(tid));
    const int wid = __builtin_amdgcn_readfirstlane(tid >> 6), lane = tid & 63, j16 = lane & 15, ig = lane >> 4;
    const int rowbase = SAMPLE ? MP + bs * DTOK : bs * SEQ + c * 128;
    constexpr int NTOK = SAMPLE ? DTOK : 128;
    const bf16_t* PROJ = (const bf16_t*)(ws + WS_PROJ);
    const bool first_chunk = SAMPLE || c == 0;
    const float* DTS = (const float*)(ws + WS_DT);
    LAS float* xwf = (LAS float*)(lds + ST_F);
    const int sidx0 = SAMPLE ? 512 + bs * 8 + 4 * g : (bs * 8 + 4 * g) * 16 + c;
    __syncthreads();
    if (wid < 4) {
        const int h = 4 * g + wid; const float a_h = -__expf(alog[h]);
        float d0 = (lane < NTOK) ? DTS[(size_t)(rowbase + lane) * 8 + h] : 0.f, d1 = (lane + 64 < NTOK) ? DTS[(size_t)(rowbase + lane + 64) * 8 + h] : 0.f;
        float c0 = d0 * a_h, c1 = d1 * a_h;
        scan128(c0, c1, lane);
        const float cs_end = __shfl(c1, 63);
        xwf[wid * 128 + lane] = d0 * __expf(cs_end - c0); xwf[wid * 128 + 64 + lane] = d1 * __expf(cs_end - c1);
        if (lane == 0) ((float*)(ws + WS_SUMDT))[sidx0 + (SAMPLE ? wid : 16 * wid)] = cs_end;
    }
    __syncthreads();
    {
        const int ccb = tid & 15, lb = 4 * (tid >> 4);
        const int hx0 = tid >> 8, cx0 = tid & 7, lx0 = 4 * ((tid & 255) >> 3);
        bf16_t* XA = (bf16_t*)(ws + WS_XA);
        u32x4 rb[7], rc[7], rx0[7], rx1[7];
        conv_load<SAMPLE>(PROJ, sconv0, rowbase, bs, first_chunk, lb, 512 + g * 128 + 8 * ccb, rb);
        conv_load<SAMPLE>(PROJ, sconv0, rowbase, bs, first_chunk, lb, 768 + g * 128 + 8 * ccb, rc);
        conv_load<SAMPLE>(PROJ, sconv0, rowbase, bs, first_chunk, lx0, (4 * g + hx0) * 64 + 8 * cx0, rx0);
        conv_load<SAMPLE>(PROJ, sconv0, rowbase, bs, first_chunk, lx0, (4 * g + hx0 + 2) * 64 + 8 * cx0, rx1);
        float ov[4][8];
        conv_apply(convw, convb, 512 + g * 128 + 8 * ccb, rb, ov);
#pragma unroll
        for (int k = 0; k < 8; ++k) { u32x2 o; o.x = cvtpk(ov[0][k], ov[1][k]); o.y = cvtpk(ov[2][k], ov[3][k]);
            *(LAS u32x2*)(lds + ST_BT + (8 * ccb + k) * SS_LD + lb * 2) = o; }
#pragma unroll
        for (int r = 0; r < 4; ++r) { u32x4 w; w.x = cvtpk(ov[r][0], ov[r][1]); w.y = cvtpk(ov[r][2], ov[r][3]); w.z = cvtpk(ov[r][4], ov[r][5]); w.w = cvtpk(ov[r][6], ov[r][7]);
            if (!SAMPLE || lb + r < NTOK) *(u32x4*)(XA + (size_t)(rowbase + lb + r) * 1024 + 512 + g * 128 + 8 * ccb) = w; }
        conv_apply(convw, convb, 768 + g * 128 + 8 * ccb, rc, ov);
#pragma unroll
        for (int r = 0; r < 4; ++r) { u32x4 w; w.x = cvtpk(ov[r][0], ov[r][1]); w.y = cvtpk(ov[r][2], ov[r][3]); w.z = cvtpk(ov[r][4], ov[r][5]); w.w = cvtpk(ov[r][6], ov[r][7]);
            if (!SAMPLE || lb + r < NTOK) *(u32x4*)(XA + (size_t)(rowbase + lb + r) * 1024 + 768 + g * 128 + 8 * ccb) = w; }
#pragma unroll
        for (int i = 0; i < 2; ++i) { const int hh = hx0 + 2 * i;
            float xw[4];
#pragma unroll
            for (int r = 0; r < 4; ++r) xw[r] = xwf[hh * 128 + lx0 + r];
            conv_apply(convw, convb, (4 * g + hh) * 64 + 8 * cx0, i ? rx1 : rx0, ov);
#pragma unroll
            for (int r = 0; r < 4; ++r) { u32x4 w; w.x = cvtpk(ov[r][0], ov[r][1]); w.y = cvtpk(ov[r][2], ov[r][3]); w.z = cvtpk(ov[r][4], ov[r][5]); w.w = cvtpk(ov[r][6], ov[r][7]);
                if (!SAMPLE || lx0 + r < NTOK) *(u32x4*)(XA + (size_t)(rowbase + lx0 + r) * 1024 + (4 * g + hh) * 64 + 8 * cx0) = w; }
#pragma unroll
            for (int k = 0; k < 8; ++k) { u32x2 o; o.x = cvtpk(ov[0][k] * xw[0], ov[1][k] * xw[1]); o.y = cvtpk(ov[2][k] * xw[2], ov[3][k] * xw[3]);
                *(LAS u32x2*)(lds + ST_XTW + (hh * 64 + 8 * cx0 + k) * SS_LD + lx0 * 2) = o; } }
    }
    __syncthreads();
    f32x4 acc[16];
#pragma unroll
    for (int q = 0; q < 16; ++q) acc[q] = f32x4{0.f, 0.f, 0.f, 0.f};
#pragma unroll
    for (int ks = 0; ks < 4; ++ks) {
        const bf16x8 bf = *(const LAS bf16x8*)(lds + ST_BT + (16 * wid + j16) * SS_LD + (32 * ks + 8 * ig) * 2);
#pragma unroll
        for (int q = 0; q < 16; ++q) { const bf16x8 af = *(const LAS bf16x8*)(lds + ST_XTW + (16 * q + j16) * SS_LD + (32 * ks + 8 * ig) * 2);
            acc[q] = __builtin_amdgcn_mfma_f32_16x16x32_bf16(bf, af, acc[q], 0, 0, 0); } }
    float* SL = (float*)(ws + WS_SLOC);
#pragma unroll
    for (int q = 0; q < 16; ++q) { const int hh = q >> 2; const size_t sidx = (size_t)sidx0 + (SAMPLE ? hh : 16 * hh);
        *(f32x4*)(SL + (sidx * 64 + (16 * (q & 3) + j16)) * 128 + 16 * wid + 4 * ig) = acc[q]; }
}

constexpr int SO_CM = 0, SO_BM = 34816, SO_XT = 69632, SO_HB = 87040, SO_XS = 104448, SO_XS_LD = 144, SO_F = 122880;
template <bool SAMPLE>
__device__ __forceinline__ void ssd_out_unit(unsigned char* ws, float* outp, const float* alog, const float* dskip, const float* ssdnw, const float* ssm0, const float* sconv0, const float* convw, const float* convb,
                                         LAS unsigned char* lds, int bs, int c, int h) {
    int tid = threadIdx.x; asm volatile("" : "+v"(tid));
    const int wid = __builtin_amdgcn_readfirstlane(tid >> 6), lane = tid & 63, j16 = lane & 15, ig = lane >> 4;
    const int g = h >> 2;
    const int rowbase = SAMPLE ? MP + bs * DTOK : bs * SEQ + c * 128;
    constexpr int NTOK = SAMPLE ? DTOK : 128;
    const float a_h = -__expf(alog[h]), D_h = dskip[h];
    const bf16_t* PROJ = (const bf16_t*)(ws + WS_PROJ);
    const bool first_chunk = SAMPLE || c == 0;
    const float* DTS = (const float*)(ws + WS_DT); const float* SL = (const float*)(ws + WS_SLOC); const float* SUMDT = (const float*)(ws + WS_SUMDT);
    LAS float* csf = (LAS float*)(lds + SO_F); LAS float* dtf = csf + 128; LAS float* facf = csf + 256;
    const int sidx = SAMPLE ? 512 + bs * 8 + h : (bs * 8 + h) * 16 + c;
    __syncthreads();
    if (wid == 0) {
        float d0 = (lane < NTOK) ? DTS[(size_t)(rowbase + lane) * 8 + h] : 0.f, d1 = (lane + 64 < NTOK) ? DTS[(size_t)(rowbase + lane + 64) * 8 + h] : 0.f;
        float c0 = d0 * a_h, c1 = d1 * a_h;
        scan128(c0, c1, lane);
        csf[lane] = c0; csf[lane + 64] = c1; dtf[lane] = d0; dtf[lane + 64] = d1;
    } else if (wid == 1 && !SAMPLE) {
        if (lane < 16) { float sacc = 0.f; for (int q = lane + 1; q < c; ++q) sacc += SUMDT[(bs * 8 + h) * 16 + q]; facf[lane] = __expf(sacc); }
    }
    __syncthreads();
    const float cs_end = csf[127];
    {
        f32x4 hp[4];
#pragma unroll
        for (int pb = 0; pb < 4; ++pb) hp[pb] = f32x4{0.f, 0.f, 0.f, 0.f};
        if (SAMPLE) {
#pragma unroll
            for (int pb = 0; pb < 4; ++pb) hp[pb] = *(const f32x4*)(ssm0 + ((size_t)(bs * 8 + h) * 64 + 16 * pb + j16) * 128 + 16 * wid + 4 * ig);
        } else {
            const float* sp0 = SL + ((size_t)(sidx - c) * 64 + j16) * 128 + 16 * wid + 4 * ig;
#pragma unroll
            for (int q = 0; q < SEQ / 128 - 1; ++q) if (q < c) { const float f = facf[q];
#pragma unroll
                for (int pb = 0; pb < 4; ++pb) hp[pb] = hp[pb] + f * *(const f32x4*)(sp0 + ((size_t)q * 64 + 16 * pb) * 128); }
        }
#pragma unroll
        for (int pb = 0; pb < 4; ++pb) { u32x2 w; w.x = cvtpk(hp[pb].x, hp[pb].y); w.y = cvtpk(hp[pb].z, hp[pb].w);
            *(LAS u32x2*)(lds + SO_HB + (16 * pb + j16) * SS_LD + (16 * wid + 4 * ig) * 2) = w; }
        if (SAMPLE || c == SEQ / 128 - 1) {
            const float dec = __expf(cs_end); const float* sp = SL + ((size_t)sidx * 64 + j16) * 128 + 16 * wid + 4 * ig;
            float* So = outp + (SAMPLE ? O_SSSM : O_PSSM) + ((size_t)(bs * 8 + h) * 64 + j16) * 128 + 16 * wid + 4 * ig;
#pragma unroll
            for (int pb = 0; pb < 4; ++pb) *(f32x4*)(So + (16 * pb) * 128) = hp[pb] * dec + *(const f32x4*)(sp + (16 * pb) * 128);
        }
    }
    {
        const bf16_t* XA = (const bf16_t*)(ws + WS_XA);
        const int cc = tid & 15, l0 = 4 * (tid >> 4), cx = tid & 7, lx = 4 * ((tid & 255) >> 3);
        u32x4 wc[4], wb[4], wx[4];
#pragma unroll
        for (int r = 0; r < 4; ++r) { const bool lv = !SAMPLE || (l0 + r) < NTOK;
            wc[r] = lv ? *(const u32x4*)(XA + (size_t)(rowbase + l0 + r) * 1024 + 768 + g * 128 + 8 * cc) : u32x4{0u, 0u, 0u, 0u};
            wb[r] = lv ? *(const u32x4*)(XA + (size_t)(rowbase + l0 + r) * 1024 + 512 + g * 128 + 8 * cc) : u32x4{0u, 0u, 0u, 0u}; }
        if (tid < 256) {
#pragma unroll
            for (int r = 0; r < 4; ++r) wx[r] = (!SAMPLE || (lx + r) < NTOK) ? *(const u32x4*)(XA + (size_t)(rowbase + lx + r) * 1024 + h * 64 + 8 * cx) : u32x4{0u, 0u, 0u, 0u}; }
#pragma unroll
        for (int r = 0; r < 4; ++r) { *(LAS u32x4*)(lds + SO_CM + (l0 + r) * SS_LD + cc * 16) = wc[r]; *(LAS u32x4*)(lds + SO_BM + (l0 + r) * SS_LD + cc * 16) = wb[r]; }
        if (tid < 256) {
            float dl[4];
#pragma unroll
            for (int r = 0; r < 4; ++r) { dl[r] = dtf[lx + r]; *(LAS u32x4*)(lds + SO_XS + (lx + r) * SO_XS_LD + cx * 16) = wx[r]; }
#pragma unroll
            for (int k = 0; k < 8; ++k) { const int d = k >> 1; float v[4];
#pragma unroll
                for (int r = 0; r < 4; ++r) v[r] = ((k & 1) ? bf_hi(wx[r][d]) : bf_lo(wx[r][d])) * dl[r];
                u32x2 o; o.x = cvtpk(v[0], v[1]); o.y = cvtpk(v[2], v[3]);
                *(LAS u32x2*)(lds + SO_XT + (8 * cx + k) * SS_LD + lx * 2) = o; }
        }
    }
    __syncthreads();
    f32x4 cb[8];
#pragma unroll
    for (int sb = 0; sb < 8; ++sb) cb[sb] = f32x4{0.f, 0.f, 0.f, 0.f};
#pragma unroll
    for (int ks = 0; ks < 4; ++ks) {
        const bf16x8 af = *(const LAS bf16x8*)(lds + SO_CM + (16 * wid + j16) * SS_LD + (32 * ks + 8 * ig) * 2);
#pragma unroll
        for (int sb = 0; sb < 8; ++sb) { const bf16x8 bf = *(const LAS bf16x8*)(lds + SO_BM + (16 * sb + j16) * SS_LD + (32 * ks + 8 * ig) * 2);
            cb[sb] = __builtin_amdgcn_mfma_f32_16x16x32_bf16(af, bf, cb[sb], 0, 0, 0); } }
    __syncthreads();
    {
        float csl[4];
#pragma unroll
        for (int r = 0; r < 4; ++r) csl[r] = csf[16 * wid + 4 * ig + r];
#pragma unroll
        for (int sb = 0; sb < 8; ++sb) { const int sx = 16 * sb + j16; const float css = csf[sx];
#pragma unroll
            for (int r = 0; r < 4; ++r) { const int l = 16 * wid + 4 * ig + r; const float gv = (sx <= l) ? cb[sb][r] * __expf(csl[r] - css) : 0.f;
                *(LAS bf16_t*)(lds + SO_BM + l * SS_LD + sx * 2) = f2bf(gv); } }
    }
    f32x4 yd[4], yo[4];
#pragma unroll
    for (int pb = 0; pb < 4; ++pb) { yd[pb] = f32x4{0.f, 0.f, 0.f, 0.f}; yo[pb] = f32x4{0.f, 0.f, 0.f, 0.f}; }
#pragma unroll
    for (int ks = 0; ks < 4; ++ks) {
        const bf16x8 ag = *(const LAS bf16x8*)(lds + SO_BM + (16 * wid + j16) * SS_LD + (32 * ks + 8 * ig) * 2);
        const bf16x8 ac = *(const LAS bf16x8*)(lds + SO_CM + (16 * wid + j16) * SS_LD + (32 * ks + 8 * ig) * 2);
#pragma unroll
        for (int pb = 0; pb < 4; ++pb) {
            const bf16x8 bx = *(const LAS bf16x8*)(lds + SO_XT + (16 * pb + j16) * SS_LD + (32 * ks + 8 * ig) * 2);
            const bf16x8 bh = *(const LAS bf16x8*)(lds + SO_HB + (16 * pb + j16) * SS_LD + (32 * ks + 8 * ig) * 2);
            yd[pb] = __builtin_amdgcn_mfma_f32_16x16x32_bf16(ag, bx, yd[pb], 0, 0, 0);
            yo[pb] = __builtin_amdgcn_mfma_f32_16x16x32_bf16(ac, bh, yo[pb], 0, 0, 0); } }
    {
        bf16_t* MIX = (bf16_t*)(ws + WS_MIX); float* SSQ = (float*)(ws + WS_SSQ);
        float gw[4];
#pragma unroll
        for (int pb = 0; pb < 4; ++pb) gw[pb] = ssdnw[h * 64 + 16 * pb + j16];
#pragma unroll
        for (int r = 0; r < 4; ++r) { const int l = 16 * wid + 4 * ig + r; const float el = __expf(csf[l]); float sq = 0.f;
            const bool live = l < NTOK; const size_t grow = (size_t)(rowbase + l);
#pragma unroll
            for (int pb = 0; pb < 4; ++pb) { const int pp = 16 * pb + j16;
                const float xv = bf2f(*(const LAS bf16_t*)(lds + SO_XS + l * SO_XS_LD + pp * 2));
                float y = yd[pb][r] + el * yo[pb][r] + D_h * xv;
                if (live) { const float zv = bf2f(PROJ[grow * NPAD + PC_Z + h * 64 + pp]); y *= silu_f(zv); MIX[grow * 2048 + h * 64 + pp] = f2bf(y * gw[pb]); sq += y * y; } }
            sq = group16_sum(sq);
            if (live && j16 == 0) SSQ[grow * 8 + h] = sq; }
    }
}

constexpr int U_SSDP = NBATCH * 16 * 2, U_SSDSS = DSEQ * 2, U_SB = NBATCH * 8 * 16, U_MEMP = NBATCH * 16 * 4, U_MEMS = DSEQ * 4;
#ifndef PROBE_BLK
#define PROBE_BLK 0
#endif
#define PSTAMP(i) do { if (PROBE_SEG >= 20 && blockIdx.x == PROBE_BLK && threadIdx.x == 0) ((volatile LAS unsigned long long*)(ctlw + 32))[8 + (i)] = __builtin_amdgcn_s_memrealtime(); } while (0)
#define QUEUE_LOOP(qi, total, ...) for (;;) { __syncthreads(); if (threadIdx.x == 0) ctlw[16] = __hip_atomic_fetch_add(qbase + 64 * (qi), 1u, __ATOMIC_RELAXED, __HIP_MEMORY_SCOPE_AGENT); \
        __syncthreads(); const int u = (int)ctlw[16]; if (u >= (total)) break; __VA_ARGS__ }
#define GROUP_LOOP(qi, total, ...) for (int gi_ = 0;; ++gi_) { if (threadIdx.x == 0) ctlw[22 + (gi_ & 1)] = __hip_atomic_fetch_add(qbase + 64 * (qi), 1u, __ATOMIC_RELAXED, __HIP_MEMORY_SCOPE_AGENT); \
        group_bar(gb, lane); const int u = (int)ctlw[22 + (gi_ & 1)]; if (u >= (total)) break; __VA_ARGS__ }
template <int MASK> __device__ __forceinline__ void phase3(const Params& p, LAS unsigned char* lds, volatile LAS unsigned* ctlw, int qset) {
    unsigned* qbase = (unsigned*)(p.ws + WS_CTL) + CW_QUEUE + 1024 * qset;
    const bf16_t* PROJ = (const bf16_t*)(p.ws + WS_PROJ);
    bf16_t* MIX = (bf16_t*)(p.ws + WS_MIX);
    PSTAMP(4);
    QUEUE_LOOP(0, U_SSDP, { ssd_state_unit<false>(p.ws, p.in[I_ALOG], p.in[I_SCONV], p.in[I_CONVW], p.in[I_CONVB], lds, u >> 5, (u >> 1) & 15, u & 1); })
    QUEUE_LOOP(4, U_SSDSS, { ssd_state_unit<true>(p.ws, p.in[I_ALOG], p.in[I_SCONV], p.in[I_CONVW], p.in[I_CONVB], lds, u >> 1, 0, u & 1); })
    PSTAMP(5);
    const unsigned gb0 = __builtin_amdgcn_readfirstlane(ctlw[20]);
    __syncthreads();
    {
        int tid = threadIdx.x; asm volatile("" : "+v"(tid));
        const int wid = __builtin_amdgcn_readfirstlane(tid >> 6), lane = tid & 63;
        if (wid < 4) {
            GroupBar gb; gb.cnt = ctlw + 20; gb.gen = gb0;
            __builtin_amdgcn_s_setprio(1);
            GROUP_LOOP(2, U_SB, {
                const int i = 15 - (u >> 5), bh = u & 31, b = bh >> 3, h = bh & 7;
                attn_unit<0>(lds, gb, PROJ + (size_t)(b * SEQ + i * 128) * NPAD + PC_Q + h * 128, NPAD,
                             PROJ + (size_t)(b * SEQ) * NPAD + PC_K + h * 128, PROJ + (size_t)(b * SEQ) * NPAD + PC_V + h * 128, NPAD,
                             2 * (i + 1), i * 128, 128, p.in[I_SBBIAS][h] * LOG2E,
                             PROJ + (size_t)(b * SEQ + i * 128) * NPAD + PC_GSB + h * 128, NPAD, MIX + (size_t)(b * SEQ + i * 128) * 2048 + 512 + h * 128, 2048); })
            PSTAMP(6);
            GROUP_LOOP(3, U_MEMP + U_MEMS, {
                if (u < U_MEMP) { const int hm = u & 3, qb = (u >> 2) & 15, b = u >> 6; const size_t r0 = (size_t)(b * SEQ + qb * 128);
                    attn_unit<1>(lds, gb, PROJ + r0 * NPAD + PC_MQ + hm * 128, NPAD, (const bf16_t*)(p.ws + WS_MKN) + (size_t)(b * MEMT) * 512 + hm * 128, (const bf16_t*)(p.ws + WS_MVB) + (size_t)(b * MEMT) * 512 + hm * 128, 512,
                                 4, 0, 128, 0.f, PROJ + r0 * NPAD + PC_GM + hm * 128, NPAD, MIX + r0 * 2048 + 1536 + hm * 128, 2048); }
                else { const int v = u - U_MEMP, hm = v & 3, sq = v >> 2; const size_t r0 = (size_t)(MP + sq * DTOK);
                    attn_unit<1>(lds, gb, PROJ + r0 * NPAD + PC_MQ + hm * 128, NPAD, (const bf16_t*)(p.ws + WS_CMK) + (size_t)(sq * MEMT) * 512 + hm * 128, (const bf16_t*)(p.ws + WS_CMV) + (size_t)(sq * MEMT) * 512 + hm * 128, 512,
                                 4, 0, DTOK, 0.f, PROJ + r0 * NPAD + PC_GM + hm * 128, NPAD, MIX + r0 * 2048 + 1536 + hm * 128, 2048); } })
            group_bar(gb, lane);
            __builtin_amdgcn_s_setprio(0);
            PSTAMP(7);
        }
        LAS unsigned char* wlds = lds + (wid < 4 ? wid * 19456 : 77824 + (wid - 4) * 19456);
        decode_wave_loop((const int*)p.in[I_PT], p.in[I_CK], p.in[I_CV], p.in[I_SBBIAS], p.ws, wlds, qbase + 64 * 1, lane);
    }
    __syncthreads();
    PSTAMP(8);
}

__device__ __forceinline__ void phase4(const Params& p, LAS unsigned char* lds, volatile LAS unsigned* ctlw, int vcu, int G, int qset) {
    const int tid = threadIdx.x, lane = tid & 63, wave = __builtin_amdgcn_readfirstlane(tid >> 6);
    bf16_t* MIX = (bf16_t*)(p.ws + WS_MIX);
    const bf16_t* PROJ = (const bf16_t*)(p.ws + WS_PROJ);
    unsigned* qbase = (unsigned*)(p.ws + WS_CTL) + CW_QUEUE + 1024 * qset;
    PSTAMP(2);
    for (int u = G - 1 - (int)blockIdx.x; u < DSEQ * 8; u += G) {
        const int seq = u >> 3, head = u & 7, i = wave;
        const int row = MP + seq * DTOK + i;
        const float bias2 = p.in[I_SBBIAS][head] * LOG2E;
        const unsigned qw = *(const unsigned*)(PROJ + (size_t)row * NPAD + PC_Q + head * 128 + 2 * lane);
        const float q0 = bf_lo(qw), q1 = bf_hi(qw);
        float acc0 = 0.f, acc1 = 0.f, R = 1.f;
        for (int j = DTOK - 1; j >= 0; --j) {
            const f32x2 kv = *(const f32x2*)(p.out + O_SK + (size_t)(seq * DTOK + j) * 1024 + head * 128 + 2 * lane);
            const float kb0 = bf2f(f2bf(kv.x)), kb1 = bf2f(f2bf(kv.y));
            const float z = fmaxf(wave_sum(q0 * kb0 + q1 * kb1) + bias2, -100.f);
            if (j < i) {
                const float e = fast_exp2(-z), rc = fast_rcp(1.f + e);
                const f32x2 vv = *(const f32x2*)(p.out + O_SV + (size_t)(seq * DTOK + j) * 1024 + head * 128 + 2 * lane);
                const float w = rc * R; acc0 += w * vv.x; acc1 += w * vv.y; R *= e * rc;
            }
        }
        const float* Op = (const float*)(p.ws + WS_OPART) + (size_t)((seq * 8 + head) * NPAGES) * (DTOK * 128) + i * 128 + 2 * lane;
        const float* Fp = (const float*)(p.ws + WS_FPART) + (size_t)((seq * 8 + head) * NPAGES) * DTOK + i;
        const int pg_lo = decode_skip_old_pages<false>((const float*)(p.ws + WS_FPART), seq, head, lane) ? L0_FIRST : 0;
        for (int pg0 = NPAGES - 16; pg0 >= pg_lo; pg0 -= 16) {
            f32x2 ov[16]; float fv[16];
#pragma unroll
            for (int q = 0; q < 16; ++q) { ov[q] = *(const f32x2*)(Op + (size_t)(pg0 + q) * (DTOK * 128)); fv[q] = Fp[(size_t)(pg0 + q) * DTOK]; }
#pragma unroll
            for (int q = 15; q >= 0; --q) { acc0 += R * ov[q].x; acc1 += R * ov[q].y; R *= fv[q]; }
        }
        const unsigned gwd = *(const unsigned*)(PROJ + (size_t)row * NPAD + PC_GSB + head * 128 + 2 * lane);
        *(unsigned*)(MIX + (size_t)row * 2048 + 512 + head * 128 + 2 * lane) = cvtpk(acc0 * silu_f(bf_lo(gwd)), acc1 * silu_f(bf_hi(gwd)));
    }
    PSTAMP(3);
    PSTAMP(0);
    QUEUE_LOOP(5, NBATCH * 16 * 8, { const int v = NBATCH * 16 * 8 - 1 - u;
        ssd_out_unit<false>(p.ws, p.out, p.in[I_ALOG], p.in[I_DSKIP], p.in[I_SSDNW], p.in[I_SSM], p.in[I_SCONV], p.in[I_CONVW], p.in[I_CONVB], lds, (v >> 3) & 3, v >> 5, v & 7); })
    PSTAMP(1);
    QUEUE_LOOP(6, DSEQ * 8, { ssd_out_unit<true>(p.ws, p.out, p.in[I_ALOG], p.in[I_DSKIP], p.in[I_SSDNW], p.in[I_SSM], p.in[I_SCONV], p.in[I_CONVW], p.in[I_CONVB], lds, u >> 3, 0, u & 7); })
}

struct Epi5 {
    static constexpr int MID = 8;
    const float* xp; float* out; const float* SSQ;
    __device__ __forceinline__ void mid(pg8::Acc& acc, const pg8::Unit& u, int wr, int fr) const {
        int rl0 = wr * 64 + fr; asm volatile("" : "+v"(rl0));
#pragma unroll
        for (int ai = 0; ai < 2; ++ai)
#pragma unroll
            for (int m = 0; m < 4; ++m) { const size_t row = (size_t)u.pm * 256 + rl0 + ai * 128 + m * 16;
                const f32x4 s0 = *(const f32x4*)(SSQ + row * 8), s1 = *(const f32x4*)(SSQ + row * 8 + 4);
                const float rs = 1.f / sqrtf((((s0.x + s0.y) + (s0.z + s0.w)) + ((s1.x + s1.y) + (s1.z + s1.w))) * (1.f / 512.f) + EPS);
#pragma unroll
                for (int bj = 0; bj < 2; ++bj)
#pragma unroll
                    for (int n = 0; n < 2; ++n) acc[ai][bj][m][n] = acc[ai][bj][m][n] * rs; }
    }
    __device__ __forceinline__ void operator()(pg8::Acc& acc, const pg8::Unit& u, int wr, int wc, int fr, int fq) const {
        int rl0 = wr * 64 + fr, cl0 = u.pn * 256 + wc * 32 + 4 * fq;
        asm volatile("" : "+v"(rl0), "+v"(cl0));
        const float* xb = xp + (size_t)u.pm * 256 * DM; float* ob = out + O_YP + (size_t)u.pm * 256 * DM;
#pragma unroll
        for (int ai = 0; ai < 2; ++ai)
#pragma unroll
            for (int m = 0; m < 4; ++m) { const int row = rl0 + ai * 128 + m * 16; const float* xr = xb + (size_t)row * DM + cl0; float* orow = ob + (size_t)row * DM + cl0;
#pragma unroll
                for (int bj = 0; bj < 2; ++bj)
#pragma unroll
                    for (int n = 0; n < 2; ++n) *(f32x4*)(orow + bj * 128 + n * 16) = *(const f32x4*)(xr + bj * 128 + n * 16) + acc[ai][bj][m][n]; }
    }
};
__device__ __forceinline__ void sample_outproj(const Params& p, LAS unsigned char* lds, int c) {
    int tid = threadIdx.x; asm volatile("" : "+v"(tid));
    const int wid = __builtin_amdgcn_readfirstlane(tid >> 6), lane = tid & 63, j16 = lane & 15, ig = lane >> 4;
    const bf16_t* MIX = (const bf16_t*)(p.ws + WS_MIX) + (size_t)MP * 2048; const bf16_t* WT = (const bf16_t*)(p.ws + WS_WOUT) + (size_t)(16 * c) * 2048;
    const float* SSQ = (const float*)(p.ws + WS_SSQ) + (size_t)MP * 8;
    f32x4 acc[4];
#pragma unroll
    for (int rb = 0; rb < 4; ++rb) acc[rb] = f32x4{0.f, 0.f, 0.f, 0.f};
#pragma unroll
    for (int ks = 0; ks < 8; ++ks) { const int k = 256 * wid + 32 * ks + 8 * ig;
        const bf16x8 bf = *(const bf16x8*)(WT + (size_t)j16 * 2048 + k);
#pragma unroll
        for (int rb = 0; rb < 4; ++rb) { const bf16x8 af = *(const bf16x8*)(MIX + (size_t)(16 * rb + j16) * 2048 + k);
            acc[rb] = __builtin_amdgcn_mfma_f32_16x16x32_bf16(af, bf, acc[rb], 0, 0, 0); } }
    if (wid < 2) {
#pragma unroll
        for (int rb = 0; rb < 4; ++rb)
#pragma unroll
            for (int r = 0; r < 4; ++r) { const int row = 16 * rb + 4 * ig + r; const f32x4 s0 = *(const f32x4*)(SSQ + row * 8), s1 = *(const f32x4*)(SSQ + row * 8 + 4);
                acc[rb][r] *= 1.f / sqrtf((((s0.x + s0.y) + (s0.z + s0.w)) + ((s1.x + s1.y) + (s1.z + s1.w))) * (1.f / 512.f) + EPS); }
    }
    __syncthreads();
    LAS float* red = (LAS float*)lds;
#pragma unroll
    for (int rb = 0; rb < 4; ++rb)
#pragma unroll
        for (int r = 0; r < 4; ++r) red[(wid * 64 + 16 * rb + 4 * ig + r) * 16 + j16] = acc[rb][r];
    __syncthreads();
#pragma unroll
    for (int i = 0; i < 2; ++i) { const int e = tid + 512 * i, row = e >> 4, col = e & 15; float v = 0.f;
#pragma unroll
        for (int w = 0; w < 8; ++w) v += red[(w * 64 + row) * 16 + col];
        p.out[O_YS + (size_t)row * DM + 16 * c + col] = p.in[I_XS][(size_t)row * DM + 16 * c + col] + v; }
}

__device__ __forceinline__ void probe_flush(const Params& p, int vcu, int G) {
    const f32x4* src = (const f32x4*)p.in[I_CK]; const size_t n16 = (size_t)40 * 1024 * 1024; f32x4 a = f32x4{0.f, 0.f, 0.f, 0.f};
    for (size_t i = (size_t)vcu * 512 + threadIdx.x; i < n16; i += (size_t)G * 512) a = a + __builtin_nontemporal_load(src + i);
    if (a.x + a.y + a.z + a.w == 1.2345e-30f) ((float*)(p.ws + WS_CTL))[2048] = a.x;
}
constexpr int NPHASE = 6;
__global__ void __launch_bounds__(512, 2) hymba_fwd(Params p) {
    extern __shared__ __attribute__((aligned(16))) unsigned char lds_raw[];
    LAS unsigned char* lds = (LAS unsigned char*)lds_raw;
    const int tid = threadIdx.x;
    const int G = gridDim.x; const int bx = blockIdx.x; const int vcu = (G % 8 == 0) ? (bx % 8) * (G / 8) + bx / 8 : bx;
    volatile LAS unsigned* ctlw = (volatile LAS unsigned*)(lds + LDS_CTLW);
    if (tid < 128) ctlw[tid] = 0u;
    __syncthreads();
    unsigned* ctl = (unsigned*)(p.ws + WS_CTL);
    const int lo = p.ph_lo, hi = p.ph_hi;
    XcdBarrier bar; bar.bar = ctl + CW_BAR; bar.x = 0; bar.st = nullptr;
    if (hi - lo > 1) bar = xcd_barrier_post(ctl + CW_BAR, ctlw + 8);
    volatile LAS unsigned long long* tst = (volatile LAS unsigned long long*)(ctlw + 32); volatile LAS unsigned long long* tarr = tst + 32; int nst = 0, nbar = 0;
#define STAMP() do { if (PROBE_SEG >= 0 && bx == 0 && tid == 0) { tst[nst] = __builtin_amdgcn_s_memrealtime(); } ++nst; } while (0)
#define GBAR() do { if (PROBE_SEG >= 0) { if (tid == 0) __hip_atomic_fetch_max((unsigned long long*)(ctl + 200000) + 8 * nbar, (unsigned long long)__builtin_amdgcn_s_memrealtime(), __ATOMIC_RELAXED, __HIP_MEMORY_SCOPE_AGENT); } \
        xcd_barrier(bar); if (PROBE_SEG >= 0 && bx == 0 && tid == 0) tarr[nbar] = __hip_atomic_load((unsigned long long*)(ctl + 200000) + 8 * nbar, __ATOMIC_RELAXED, __HIP_MEMORY_SCOPE_AGENT); ++nbar; } while (0)
    STAMP();
#define IN(k) (lo <= (k) && (k) < hi)
#define BOTH(k) (IN(k) && IN((k) + 1))
    if (IN(0)) { phase0(p, lds, vcu, G, ctlw); if (BOTH(0)) GBAR(); STAMP(); }
    if (PROBE_DUP == 0) { phase0(p, lds, vcu, G, ctlw); xcd_barrier(bar); }
    if (PROBE_DUP == 100) { probe_flush(p, vcu, G); xcd_barrier(bar); }
    if (PROBE_DUP == 101) { probe_flush(p, vcu, G); xcd_barrier(bar); phase0(p, lds, vcu, G, ctlw); xcd_barrier(bar); }
    if (PROBE_DUP == 99) { for (int q = 0; q < 8; ++q) xcd_barrier(bar); }
    if (PROBE_DUP == 97) { for (int q = 0; q < 8; ++q) { __syncthreads(); if (threadIdx.x == 0) { const unsigned g = ctlw[12] + 1u; ctlw[12] = g; xb_add(&(ctl + CW_BAR + 4096)[XB_TOP], 1u); const unsigned target = g * gridDim.x; XB_SPIN(xb_ld(&(ctl + CW_BAR + 4096)[XB_TOP]) < target, (ctl + CW_BAR + 4096)); } __syncthreads(); } }
    if (PROBE_DUP == 96) { for (int q = 0; q < 8; ++q) { __syncthreads(); if (threadIdx.x == 0) { __builtin_amdgcn_fence(__ATOMIC_RELEASE, "agent"); asm volatile("s_waitcnt vmcnt(0)" ::: "memory"); __builtin_amdgcn_fence(__ATOMIC_ACQUIRE, "agent"); asm volatile("s_waitcnt vmcnt(0)" ::: "memory"); } __syncthreads(); } }
    if (PROBE_DUP == 95) { unsigned acc_ = 0; for (int q = 0; q < 64; ++q) { __syncthreads(); if (threadIdx.x == 0) acc_ += xb_add(&(ctl + 65536)[64 * blockIdx.x], 1u); __syncthreads(); } if (acc_ == 0xdeadbeefu) ctl[3] = acc_; }
    if (PROBE_DUP == 94) { unsigned acc_ = 0; for (int q = 0; q < 64; ++q) { __syncthreads(); if (threadIdx.x == 0) acc_ += xb_add(&(ctl + 65536)[0], 1u); __syncthreads(); } if (acc_ == 0xdeadbeefu) ctl[3] = acc_; }
    if (PROBE_DUP == 93) { unsigned acc_ = 0; for (int q = 0; q < 64; ++q) { __syncthreads(); if (threadIdx.x == 0) acc_ += xb_ld(&(ctl + 65536)[0]); __syncthreads(); } if (acc_ == 0xdeadbeefu) ctl[3] = acc_; }
    if (PROBE_DUP == 92) { for (int q = 0; q < 16; ++q) { __syncthreads(); if (threadIdx.x == 0) { __builtin_amdgcn_fence(__ATOMIC_ACQUIRE, "agent"); asm volatile("s_waitcnt vmcnt(0)" ::: "memory"); } __syncthreads(); } }
    if (PROBE_DUP == 91) { for (int q = 0; q < 16; ++q) { __syncthreads(); if (threadIdx.x == 0) { __builtin_amdgcn_fence(__ATOMIC_RELEASE, "agent"); asm volatile("s_waitcnt vmcnt(0)" ::: "memory"); } __syncthreads(); } }
    if (PROBE_DUP == 90) { for (int q = 0; q < 8; ++q) xcd_barrier_probe<0>(bar); }
    if (PROBE_DUP == 89) { for (int q = 0; q < 8; ++q) xcd_barrier_probe<1>(bar); }
    if (PROBE_DUP == 88) { XcdBarrier2 b2 = xcd_barrier2_post(ctl + 131072, ctlw + 20); for (int q = 0; q < 8; ++q) xcd_barrier2(b2); }
    if (PROBE_DUP == 98) { for (int q = 0; q < 8; ++q) flat_barrier(ctl + CW_BAR + 4096, ctlw + 12); }
    if (IN(1)) {
        pg8::Gemm g{(const bf16_t*)(p.ws + WS_H), (const bf16_t*)(p.ws + WS_WIN), (const bf16_t*)(p.ws + WS_HM), (const bf16_t*)(p.ws + WS_WM), DM};
        pg8::Order S; S.init(MROWS / 256, NPAD / 256, MMEM / 256, 1024 / 256, G, bx);
        Epi1 E{(bf16_t*)(p.ws + WS_PROJ), (float*)(p.ws + WS_DT), p.out, p.in[I_DTBIAS], p.in[I_QNORM], p.in[I_KNORM], p.in[I_MQNORM], p.in[I_MKNORM], (bf16_t*)(p.ws + WS_MKN), (bf16_t*)(p.ws + WS_MVB), (LAS float*)(lds + RING_BYTES)};
        pg8::gemm_phase<Epi1>(lds, g, S, E);
        if (BOTH(1)) GBAR(); STAMP();
        if (PROBE_DUP == 1) { pg8::gemm_phase<Epi1>(lds, g, S, E); xcd_barrier(bar); }
    }
    if (IN(3)) { phase3<31>(p, lds, ctlw, 0); if (BOTH(3)) GBAR(); STAMP(); }
    if (PROBE_DUP >= 30) { phase3<31>(p, lds, ctlw, 1); xcd_barrier(bar); }
    if (IN(4)) { phase4(p, lds, ctlw, vcu, G, 0); if (BOTH(4)) GBAR(); STAMP(); }
    if (PROBE_DUP == 4) { phase4(p, lds, ctlw, vcu, G, 1); xcd_barrier(bar); }
    if (IN(5)) {
        pg8::Gemm g{(const bf16_t*)(p.ws + WS_MIX), (const bf16_t*)(p.ws + WS_WOUT), nullptr, nullptr, DM};
        pg8::Order S; S.init(MP / 256, DM / 256, 0, 1, G, bx);
        Epi5 E{p.in[I_XP], p.out, (const float*)(p.ws + WS_SSQ)};
        PSTAMP0(4);
        pg8::gemm_phase<Epi5>(lds, g, S, E);
        PSTAMP0(5);
        if (bx < 128) sample_outproj(p, lds, bx);
        PSTAMP0(6);
        STAMP();
        if (PROBE_DUP == 5) { xcd_barrier(bar); pg8::gemm_phase<Epi5>(lds, g, S, E); if (bx < 128) sample_outproj(p, lds, bx); }
    }
    if (PROBE_SEG >= 0 && bx == ((PROBE_SEG >= 20 && PROBE_SEG < 30) ? PROBE_BLK : 0) && tid == 0) {
        unsigned long long iv = 0;
        if (PROBE_SEG == 29) iv = tst[8 + 9] - tst[8 + 5];
        else if (PROBE_SEG == 28) iv = tst[8 + 6] - tst[8 + 9];
        else if (PROBE_SEG >= 40) iv = tst[20 + PROBE_SEG - 40 + 1] - tst[20 + PROBE_SEG - 40];
        else if (PROBE_SEG == 30) iv = tst[9] - tst[8];
        else if (PROBE_SEG >= 20) iv = tst[8 + PROBE_SEG - 20 + 1] - tst[8 + PROBE_SEG - 20];
        else if (PROBE_SEG < 10) iv = tst[PROBE_SEG + 1] - tst[PROBE_SEG];
        else iv = tst[PROBE_SEG - 10 + 1] - tarr[PROBE_SEG - 10];
        const unsigned long long t0 = __builtin_amdgcn_s_memrealtime();
        while (__builtin_amdgcn_s_memrealtime() - t0 < 8ull * iv) __builtin_amdgcn_s_sleep(8);
    }
    if (PROBE_DUP == 200) {
        xcd_barrier(bar);
        phase0(p, lds, vcu, G, ctlw); xcd_barrier(bar);
        { pg8::Gemm g{(const bf16_t*)(p.ws + WS_H), (const bf16_t*)(p.ws + WS_WIN), (const bf16_t*)(p.ws + WS_HM), (const bf16_t*)(p.ws + WS_WM), DM};
          pg8::Order S; S.init(MROWS / 256, NPAD / 256, MMEM / 256, 1024 / 256, G, bx);
          Epi1 E{(bf16_t*)(p.ws + WS_PROJ), (float*)(p.ws + WS_DT), p.out, p.in[I_DTBIAS], p.in[I_QNORM], p.in[I_KNORM], p.in[I_MQNORM], p.in[I_MKNORM], (bf16_t*)(p.ws + WS_MKN), (bf16_t*)(p.ws + WS_MVB), (LAS float*)(lds + RING_BYTES)};
          pg8::gemm_phase<Epi1>(lds, g, S, E); xcd_barrier(bar); }
        phase3<31>(p, lds, ctlw, 1); xcd_barrier(bar);
        phase4(p, lds, ctlw, vcu, G, 1); xcd_barrier(bar);
        { pg8::Gemm g{(const bf16_t*)(p.ws + WS_MIX), (const bf16_t*)(p.ws + WS_WOUT), nullptr, nullptr, DM};
          pg8::Order S; S.init(MP / 256, DM / 256, 0, 1, G, bx);
          Epi5 E{p.in[I_XP], p.out, (const float*)(p.ws + WS_SSQ)};
          pg8::gemm_phase<Epi5>(lds, g, S, E);
          if (bx < 128) sample_outproj(p, lds, bx); }
    }
#undef IN
#undef BOTH
}

extern "C" void kernel_launch(void* const* d_in, const int* in_sizes, int n_in, void* d_out, int out_size, void* d_ws, size_t ws_size, hipStream_t stream) {
    static int grid = 0;
    if (grid == 0) {
        if (n_in != 26 || ws_size < WS_END) { fprintf(stderr, "kernel_launch: unexpected n_in %d / ws %zu\n", n_in, ws_size); grid = -1; return; }
        int dev = 0, cus = 0, per_cu = 0;
        if (hipGetDevice(&dev) != hipSuccess || hipDeviceGetAttribute(&cus, hipDeviceAttributeMultiprocessorCount, dev) != hipSuccess) { grid = -1; return; }
        if (hipFuncSetAttribute((const void*)hymba_fwd, hipFuncAttributeMaxDynamicSharedMemorySize, LDS_BYTES) != hipSuccess) { fprintf(stderr, "kernel_launch: hipFuncSetAttribute failed\n"); grid = -1; return; }
        if (hipOccupancyMaxActiveBlocksPerMultiprocessor(&per_cu, (const void*)hymba_fwd, 512, LDS_BYTES) != hipSuccess || per_cu < 1) fprintf(stderr, "kernel_launch: occupancy query says %d\n", per_cu);
        (void)hipGetLastError();
        grid = cus;
    }
    if (grid < 0) return;
    (void)hipMemsetAsync((char*)d_ws + WS_CTL, 0, CTL_BYTES, stream);
    Params p{};
    for (int i = 0; i < 26; ++i) p.in[i] = (const float*)d_in[i];
    p.out = (float*)d_out; p.ws = (unsigned char*)d_ws;
    if (MK_N_LAUNCHES == 1) { p.ph_lo = 0; p.ph_hi = NPHASE; hipLaunchKernelGGL(hymba_fwd, dim3(grid), dim3(512), LDS_BYTES, stream, p); }
    else for (int ph = 0; ph < NPHASE; ++ph) { p.ph_lo = ph; p.ph_hi = ph + 1; hipLaunchKernelGGL(hymba_fwd, dim3(grid), dim3(512), LDS_BYTES, stream, p); }
    const hipError_t le = hipPeekAtLastError();
    if (le != hipSuccess) fprintf(stderr, "kernel_launch: launch failed: %s\n", hipGetErrorName(le));
}
```

```cpp
#include <hip/hip_runtime.h>
#include <cstdio>
#include <cstdint>

#ifndef PROBE_DUP
#define PROBE_DUP -1
#endif
#ifndef PROBE_SEG
#define PROBE_SEG -1
#endif
#ifndef MK_N_LAUNCHES
#define MK_N_LAUNCHES 1
#endif

constexpr int DM = 2048, NBATCH = 4, SEQ = 2048, MP = NBATCH * SEQ;
constexpr int DSEQ = 8, DTOK = 8, MS = DSEQ * DTOK;
constexpr int MVALID = MP + MS, MROWS = 8448;
constexpr int NIN = 6664, NPAD = 6912;
constexpr int MEMT = 256, MMEM = NBATCH * MEMT;
constexpr int NPAGES = 128, PAGE = 128, PAST = NPAGES * PAGE;
constexpr float EPS = 1e-6f;
constexpr float LOG2E = 1.4426950408889634f;
constexpr float QSCALE = 0.08838834764831845f * LOG2E;

constexpr size_t O_YP = 0, O_YS = 16777216, O_PK = 16908288, O_PV = 25296896, O_PSSM = 33685504, O_PCONV = 33947648,
                 O_PMK = 33959936, O_PMV = 34484224, O_SK = 35008512, O_SV = 35074048, O_SSSM = 35139584, O_SCONV = 35663872;

constexpr size_t MiB = 1u << 20;
constexpr size_t WS_CTL = 0, CTL_BYTES = 1 * MiB;
constexpr size_t WS_WIN = 2 * MiB;
constexpr size_t WS_WM = 32 * MiB;
constexpr size_t WS_WOUT = 38 * MiB;
constexpr size_t WS_H = 48 * MiB;
constexpr size_t WS_HM = 84 * MiB;
constexpr size_t WS_PROJ = 90 * MiB;
constexpr int PC_Q = 0, PC_K = 1024, PC_V = 2048, PC_GSB = 3072, PC_Z = 4096, PC_XBC = 4608, PC_MQ = 5632, PC_GM = 6144;
constexpr size_t WS_DT = 210 * MiB;
constexpr size_t WS_MKN = 211 * MiB;
constexpr size_t WS_MVB = 213 * MiB;
constexpr size_t WS_CMK = 215 * MiB;
constexpr size_t WS_CMV = 218 * MiB;
constexpr size_t WS_SSQ = 221 * MiB;
constexpr size_t WS_FPART = 222 * MiB;
constexpr size_t WS_MIX = 224 * MiB;
constexpr size_t WS_YZ = 260 * MiB;
constexpr size_t WS_OPART = 280 * MiB;
constexpr size_t WS_XA = 316 * MiB;
constexpr size_t WS_SLOC = 334 * MiB;
constexpr size_t WS_SUMDT = 354 * MiB;
constexpr size_t WS_END = 355 * MiB;

constexpr int CW_BAR = 4096;
constexpr int CW_QUEUE = 64;

constexpr int LDS_BYTES = 163840;
constexpr int RING_BYTES = 131072;
constexpr int LDS_CTLW = LDS_BYTES - 512;

#define LAS __attribute__((address_space(3)))
typedef unsigned short bf16_t;
typedef short bf16x8 __attribute__((ext_vector_type(8)));
typedef short s16x4 __attribute__((ext_vector_type(4)));
typedef float f32x2 __attribute__((ext_vector_type(2)));
typedef float f32x4 __attribute__((ext_vector_type(4)));
typedef float f32x16 __attribute__((ext_vector_type(16)));
typedef unsigned u32x2 __attribute__((ext_vector_type(2)));
typedef unsigned u32x4 __attribute__((ext_vector_type(4)));

__device__ __forceinline__ unsigned cvtpk(float lo, float hi) { unsigned r; asm volatile("v_cvt_pk_bf16_f32 %0, %1, %2" : "=v"(r) : "v"(lo), "v"(hi)); return r; }
__device__ __forceinline__ float bf_lo(unsigned w) { return __uint_as_float(w << 16); }
__device__ __forceinline__ float bf_hi(unsigned w) { return __uint_as_float(w & 0xffff0000u); }
__device__ __forceinline__ float bf2f(bf16_t b) { return __uint_as_float(((unsigned)b) << 16); }
__device__ __forceinline__ bf16_t f2bf(float f) { return (bf16_t)(cvtpk(f, 0.f) & 0xffffu); }
__device__ __forceinline__ float wave_sum(float v) {
#pragma unroll
    for (int o = 1; o < 64; o <<= 1) v += __shfl_xor(v, o);
    return v;
}
__device__ __forceinline__ float fast_exp2(float x) { return __builtin_amdgcn_exp2f(x); }
__device__ __forceinline__ float fast_rcp(float x) { return __builtin_amdgcn_rcpf(x); }
__device__ __forceinline__ float silu_f(float x) { return x * fast_rcp(1.f + fast_exp2(-x * LOG2E)); }

#define XB_TMO      128
#define XB_XCNT(j)  (256  + 64 * (j))
#define XB_XSUB(j)  (1280 + 64 * (j))
#define XB_XGEN(j)  (2304 + 64 * (j))
#define XB_TOP      3328
#define XB_TOPGEN   3392
#define XCD_BAR_WORDS 3456
#define XB_SPIN_CAP (1u << 18)
#ifndef XB_SLEEP
#define XB_SLEEP 1
#endif

__device__ __forceinline__ unsigned xb_ld(unsigned* p)              { return __hip_atomic_load(p, __ATOMIC_RELAXED, __HIP_MEMORY_SCOPE_AGENT); }
__device__ __forceinline__ unsigned xb_add(unsigned* p, unsigned v) { return __hip_atomic_fetch_add(p, v, __ATOMIC_RELAXED, __HIP_MEMORY_SCOPE_AGENT); }
__device__ __forceinline__ unsigned xb_xcc_id() { return (unsigned)__builtin_amdgcn_s_getreg((3 << 11) | 20) & 0xFu; }
#define XB_SPIN(cond, bar) do { unsigned _sp = 0; while (cond) { __builtin_amdgcn_s_sleep(XB_SLEEP); \
    if ((++_sp & 255u) == 0u) { if (xb_ld(&(bar)[XB_TMO])) break; if (_sp > XB_SPIN_CAP) { atomicAdd(&(bar)[XB_TMO], 1u); break; } } } } while (0)

struct XcdBarrier { unsigned* bar; unsigned x; volatile LAS unsigned* st; };

__device__ __forceinline__ XcdBarrier xcd_barrier_post(unsigned* bar, volatile LAS unsigned* st) {
    XcdBarrier b; b.bar = bar; b.x = xb_xcc_id(); b.st = st;
    if (threadIdx.x == 0) (void)xb_add(&bar[XB_XCNT(b.x)], 1u);
    return b;
}
__device__ __forceinline__ void xcd_barrier_complete(unsigned* bar, unsigned x, unsigned& nloc, unsigned& nx) {
    const unsigned G = gridDim.x * gridDim.y * gridDim.z;
    unsigned sum, cnt, mine, sp = 0u;
    for (;;) {
        sum = 0u; cnt = 0u; mine = 0u;
#pragma unroll
        for (unsigned j = 0; j < 16; ++j) { const unsigned c = xb_ld(&bar[XB_XCNT(j)]); sum += c; cnt += (c > 0u) ? 1u : 0u; mine = (j == x) ? c : mine; }
        if (sum == G) break;
        __builtin_amdgcn_s_sleep(1);
        if ((++sp & 255u) == 0u) { if (xb_ld(&bar[XB_TMO])) break; if (sp > XB_SPIN_CAP) { atomicAdd(&bar[XB_TMO], 1u); break; } }
    }
    nloc = mine > 0u ? mine : 1u; nx = cnt > 0u ? cnt : 1u;
}
__device__ __forceinline__ void xcd_barrier(const XcdBarrier& b) {
    asm volatile("s_waitcnt vmcnt(0)" ::: "memory");
    __syncthreads();
    if (threadIdx.x == 0) {
        unsigned* bar = b.bar;
        __builtin_amdgcn_s_waitcnt(0);
        unsigned nloc = b.st[0], nx = b.st[1];
        if (nloc == 0u) { xcd_barrier_complete(bar, b.x, nloc, nx); b.st[0] = nloc; b.st[1] = nx; }
        const unsigned old = xb_add(&bar[XB_XSUB(b.x)], 1u);
        const unsigned gen = old / nloc;
        if (old + 1u == (gen + 1u) * nloc) {
            __builtin_amdgcn_fence(__ATOMIC_RELEASE, "agent");
            asm volatile("s_waitcnt vmcnt(0)" ::: "memory");
            const unsigned og = xb_add(&bar[XB_TOP], 1u);
            const unsigned tg = og / nx;
            if (og + 1u == (tg + 1u) * nx) xb_add(&bar[XB_TOPGEN], 1u);
            else XB_SPIN(xb_ld(&bar[XB_TOPGEN]) == tg, bar);
            __builtin_amdgcn_fence(__ATOMIC_ACQUIRE, "agent");
            xb_add(&bar[XB_XGEN(b.x)], 1u);
            asm volatile("s_waitcnt vmcnt(0)" ::: "memory");
        } else {
            XB_SPIN(xb_ld(&bar[XB_XGEN(b.x)]) == gen, bar);
            __builtin_amdgcn_fence(__ATOMIC_ACQUIRE, "agent");
            asm volatile("s_waitcnt vmcnt(0)" ::: "memory");
        }
    }
    __syncthreads();
}

#define XB2_BASE     8192
#define XB2_XREP(x, i) (XB2_BASE + 256 * (32 * (x) + (i)))
#define XB2_TOPREP(x)  (XB2_BASE + 256 * (512 + (x)))
struct XcdBarrier2 { unsigned* bar; unsigned x, idx; volatile LAS unsigned* st; };
__device__ __forceinline__ XcdBarrier2 xcd_barrier2_post(unsigned* bar, volatile LAS unsigned* st) {
    XcdBarrier2 b; b.bar = bar; b.x = xb_xcc_id(); b.st = st; b.idx = 0;
    if (threadIdx.x < 64) { unsigned i = 0; if (threadIdx.x == 0) i = xb_add(&bar[XB_XCNT(b.x)], 1u); b.idx = __builtin_amdgcn_readfirstlane(i); }
    return b;
}
__device__ __forceinline__ void xcd_barrier2(const XcdBarrier2& b) {
    asm volatile("s_waitcnt vmcnt(0)" ::: "memory");
    __syncthreads();
    if (threadIdx.x < 64) {
        unsigned* bar = b.bar; const unsigned lane = threadIdx.x;
        unsigned nloc = b.st[0], nx = b.st[1]; const unsigned gen = b.st[2];
        if (nloc == 0u) { if (lane == 0) { xcd_barrier_complete(bar, b.x, nloc, nx); b.st[0] = nloc; b.st[1] = nx; }
            asm volatile("s_waitcnt lgkmcnt(0)" ::: "memory"); nloc = b.st[0]; nx = b.st[1]; }
        nloc = __builtin_amdgcn_readfirstlane(nloc); nx = __builtin_amdgcn_readfirstlane(nx);
        unsigned old = 0; if (lane == 0) old = xb_add(&bar[XB_XSUB(b.x)], 1u);
        old = __builtin_amdgcn_readfirstlane(old);
        if (old + 1u == (gen + 1u) * nloc) {
            if (lane == 0) { __builtin_amdgcn_fence(__ATOMIC_RELEASE, "agent"); asm volatile("s_waitcnt vmcnt(0)" ::: "memory"); }
            unsigned og = 0; if (lane == 0) og = xb_add(&bar[XB_TOP], 1u);
            og = __builtin_amdgcn_readfirstlane(og);
            if (og + 1u == (gen + 1u) * nx) { if (lane < 16) __hip_atomic_store(&bar[XB2_TOPREP(lane)], gen + 1u, __ATOMIC_RELAXED, __HIP_MEMORY_SCOPE_AGENT); }
            else if (lane == 0) XB_SPIN(xb_ld(&bar[XB2_TOPREP(b.x)]) < gen + 1u, bar);
            if (lane == 0) __builtin_amdgcn_fence(__ATOMIC_ACQUIRE, "agent");
            if (lane < nloc && lane < 32) __hip_atomic_store(&bar[XB2_XREP(b.x, lane)], gen + 1u, __ATOMIC_RELAXED, __HIP_MEMORY_SCOPE_AGENT);
            asm volatile("s_waitcnt vmcnt(0)" ::: "memory");
        } else {
            if (lane == 0) { XB_SPIN(xb_ld(&bar[XB2_XREP(b.x, b.idx)]) < gen + 1u, bar);
                __builtin_amdgcn_fence(__ATOMIC_ACQUIRE, "agent"); asm volatile("s_waitcnt vmcnt(0)" ::: "memory"); }
        }
        if (lane == 0) b.st[2] = gen + 1u;
    }
    __syncthreads();
}
template <int FENCES> __device__ __forceinline__ void xcd_barrier_probe(const XcdBarrier& b) {
    asm volatile("s_waitcnt vmcnt(0)" ::: "memory");
    __syncthreads();
    if (threadIdx.x == 0) {
        unsigned* bar = b.bar;
        unsigned nloc = b.st[0], nx = b.st[1];
        if (nloc == 0u) { xcd_barrier_complete(bar, b.x, nloc, nx); b.st[0] = nloc; b.st[1] = nx; }
        const unsigned old = xb_add(&bar[XB_XSUB(b.x)], 1u);
        const unsigned gen = old / nloc;
        if (old + 1u == (gen + 1u) * nloc) {
            if (FENCES & 1) { __builtin_amdgcn_fence(__ATOMIC_RELEASE, "agent"); asm volatile("s_waitcnt vmcnt(0)" ::: "memory"); }
            const unsigned og = xb_add(&bar[XB_TOP], 1u);
            const unsigned tg = og / nx;
            if (og + 1u == (tg + 1u) * nx) xb_add(&bar[XB_TOPGEN], 1u);
            else XB_SPIN(xb_ld(&bar[XB_TOPGEN]) == tg, bar);
            if (FENCES & 2) __builtin_amdgcn_fence(__ATOMIC_ACQUIRE, "agent");
            xb_add(&bar[XB_XGEN(b.x)], 1u);
            asm volatile("s_waitcnt vmcnt(0)" ::: "memory");
        } else {
            XB_SPIN(xb_ld(&bar[XB_XGEN(b.x)]) == gen, bar);
        }
    }
    __syncthreads();
}
__device__ __forceinline__ void flat_barrier(unsigned* bar, volatile LAS unsigned* gen) {
    asm volatile("s_waitcnt vmcnt(0)" ::: "memory");
    __syncthreads();
    if (threadIdx.x == 0) {
        const unsigned g = gen[0] + 1u; gen[0] = g;
        __builtin_amdgcn_fence(__ATOMIC_RELEASE, "agent");
        asm volatile("s_waitcnt vmcnt(0)" ::: "memory");
        xb_add(&bar[XB_TOP], 1u);
        const unsigned target = g * gridDim.x;
        XB_SPIN(xb_ld(&bar[XB_TOP]) < target, bar);
        __builtin_amdgcn_fence(__ATOMIC_ACQUIRE, "agent");
        asm volatile("s_waitcnt vmcnt(0)" ::: "memory");
    }
    __syncthreads();
}
namespace pg8 {
constexpr int BM = 256, BK = 64, HALF = 128, HTB = HALF * BK * 2, STAGE_BYTES = 8 * HTB, NXCD = 8, WGM = 8;
__host__ __device__ __forceinline__ int lds_byte(int r, int c) { const int st = (r >> 4) * 2 + (c >> 5), rr = r & 15, cc = c & 31, ob = rr * 64 + cc * 2; return st * 1024 + (ob ^ (((ob >> 9) & 1) << 5)); }
__host__ __device__ __forceinline__ void stage_rc(int b, int& R, int& C) { const int st = b / 1024, sb = b % 1024, swz = sb ^ (((sb >> 9) & 1) << 5); R = (st >> 1) * 16 + swz / 64; C = (st & 1) * 32 + (swz % 64) / 2; }

struct Unit { int pm, pn, sel; };
struct Gemm { const bf16_t* A0; const bf16_t* B0; const bf16_t* A1; const bf16_t* B1; int K; };

struct Order {
    int nM, nN, nwg, n1M, n1N, G, c;
    __device__ void init(int nM_, int nN_, int n1M_, int n1N_, int G_, int c_) { nM = nM_; nN = nN_; nwg = nM * nN; n1M = n1M_; n1N = n1N_; G = G_; c = c_; }
    __device__ bool next(int i, Unit& u) const {
        const long L = (long)i * G + c;
        if (L >= nwg + n1M * n1N) return false;
        if (L >= nwg) { const int r = (int)L - nwg; u.pm = r / n1N; u.pn = r % n1N; u.sel = 1; return true; }
        int wgid = (int)L; { const int q = nwg / NXCD, r = nwg % NXCD, xcd = wgid % NXCD, off = wgid / NXCD; wgid = (xcd < r ? xcd * (q + 1) : r * (q + 1) + (xcd - r) * q) + off; }
        const int nig = WGM * nN, gid = wgid / nig, fm = gid * WGM, gsz = (nM - fm) < WGM ? (nM - fm) : WGM;
        u.pm = fm + ((wgid % nig) % gsz); u.pn = (wgid % nig) / gsz; u.sel = 0; return true;
    }
};

template <class Epi>
__device__ __forceinline__ void gemm_phase(LAS unsigned char* lds, const Gemm g, const Order& S, const Epi& E) {
    const int tid = threadIdx.x, wid = __builtin_amdgcn_readfirstlane(tid >> 6), lane = tid & 63, wr = wid >> 2, wc = wid & 3, fr = lane & 15, fq = lane >> 4;
    const int K = g.K, nt = K / BK;
    unsigned voffA[2];
#pragma unroll
    for (int i = 0; i < 2; ++i) { int R, C; stage_rc(tid * 16 + i * 8192, R, C); voffA[i] = (unsigned)(R * K + C) * 2u; }
    const size_t kstep = (size_t)(BK * 2);
    const size_t hstep = (size_t)HALF * K * 2;
    const size_t tstep = 2 * hstep;
    const unsigned ldsw = (unsigned)wid * 1024u;
    const int aoff = lds_byte(wr * 64 + fr, fq * 8), boff = lds_byte(wc * 32 + fr, fq * 8);
#define PG8_SA(b, h) (((b) * 2 + (h)) * HTB)
#define PG8_SB(b, h) ((4 + (b) * 2 + (h)) * HTB)
#define PG8_STAGE(bufoff, gbase) do { _Pragma("unroll") for (int _i = 0; _i < 2; ++_i) \
        __builtin_amdgcn_global_load_lds((const unsigned*)((const char*)(gbase) + voffA[_i]), (LAS unsigned*)(lds + (bufoff) + ldsw + _i * 8192), 16, 0, 0); } while (0)
#define PG8_LDA(dst, b, h) do { _Pragma("unroll") for (int m = 0; m < 4; ++m) _Pragma("unroll") for (int k = 0; k < 2; ++k) dst[m][k] = *(const LAS bf16x8*)(lds + PG8_SA(b, h) + aoff + m * 2048 + k * 1024); } while (0)
#define PG8_LDB(dst, b, h) do { _Pragma("unroll") for (int n = 0; n < 2; ++n) _Pragma("unroll") for (int k = 0; k < 2; ++k) dst[n][k] = *(const LAS bf16x8*)(lds + PG8_SB(b, h) + boff + n * 2048 + k * 1024); } while (0)
#define PG8_MMA(ai, bj, At, Bt) do { __builtin_amdgcn_s_setprio(1); _Pragma("unroll") for (int m = 0; m < 4; ++m) _Pragma("unroll") for (int n = 0; n < 2; ++n) _Pragma("unroll") for (int k = 0; k < 2; ++k) \
        acc[ai][bj][m][n] = __builtin_amdgcn_mfma_f32_16x16x32_bf16(Bt[n][k], At[m][k], acc[ai][bj][m][n], 0, 0, 0); __builtin_amdgcn_s_setprio(0); } while (0)
#define PG8_WAIT_V(n) asm volatile("s_waitcnt vmcnt(" #n ")" ::: "memory")
#define PG8_WAIT_L(n) asm volatile("s_waitcnt lgkmcnt(" #n ")" ::: "memory")
#define PG8_BAR __builtin_amdgcn_s_barrier()
#define PG8_SCHED __builtin_amdgcn_sched_barrier(0)
    Unit cur, nxt; int ui = 0;
    if (!S.next(0, cur)) return;
    f32x4 acc[2][2][4][2];
#pragma unroll
    for (int a = 0; a < 2; ++a)
#pragma unroll
        for (int b = 0; b < 2; ++b)
#pragma unroll
            for (int m = 0; m < 4; ++m)
#pragma unroll
                for (int n = 0; n < 2; ++n) acc[a][b][m][n] = (f32x4){0.f, 0.f, 0.f, 0.f};
    bf16x8 At[4][2], B0[2][2], B1[2][2];
    const char* cA = (const char*)(cur.sel ? g.A1 : g.A0) + (size_t)cur.pm * tstep; const char* cB = (const char*)(cur.sel ? g.B1 : g.B0) + (size_t)cur.pn * tstep;
    PG8_STAGE(PG8_SB(0, 0), cB); PG8_STAGE(PG8_SB(0, 1), cB + hstep); PG8_STAGE(PG8_SA(0, 0), cA); PG8_STAGE(PG8_SA(0, 1), cA + hstep);
    if (wr == 1) PG8_BAR;
    PG8_WAIT_V(2); PG8_BAR;
    PG8_STAGE(PG8_SB(1, 0), cB + kstep); PG8_STAGE(PG8_SA(1, 0), cA + kstep); PG8_STAGE(PG8_SB(1, 1), cB + hstep + kstep);
    PG8_WAIT_V(6); PG8_BAR;
    for (;;) {
        const bool has_next = S.next(ui + 1, nxt);
        const char* nA = has_next ? (const char*)(nxt.sel ? g.A1 : g.A0) + (size_t)nxt.pm * tstep : cA; const char* nB = has_next ? (const char*)(nxt.sel ? g.B1 : g.B0) + (size_t)nxt.pn * tstep : cB;
        for (int t = 0; t < nt; t += 2) {
            const bool last = (t == nt - 2);
            const char* a1 = cA + (size_t)(t + 1) * kstep;
            const char* a2 = last ? nA : cA + (size_t)(t + 2) * kstep; const char* b2 = last ? nB : cB + (size_t)(t + 2) * kstep;
            const char* a3 = a2 + kstep; const char* b3 = b2 + kstep;
            if constexpr (Epi::MID > 0) { if (t == Epi::MID) E.mid(acc, cur, wr, fr); }
            PG8_LDB(B0, 0, 0); PG8_LDB(B1, 0, 1); PG8_SCHED; PG8_LDA(At, 0, 0); PG8_STAGE(PG8_SA(1, 1), a1 + hstep);
            PG8_WAIT_V(8); PG8_WAIT_L(0); PG8_BAR; PG8_MMA(0, 0, At, B0); PG8_MMA(0, 1, At, B1); PG8_BAR; PG8_SCHED;
            PG8_LDA(At, 0, 1); PG8_STAGE(PG8_SB(0, 0), b2); PG8_STAGE(PG8_SB(0, 1), b2 + hstep); PG8_STAGE(PG8_SA(0, 0), a2);
            PG8_WAIT_V(8); PG8_WAIT_L(0); PG8_BAR; PG8_MMA(1, 0, At, B0); PG8_MMA(1, 1, At, B1); PG8_BAR; PG8_SCHED;
            PG8_LDB(B0, 1, 0); PG8_LDB(B1, 1, 1); PG8_SCHED; PG8_LDA(At, 1, 0); PG8_STAGE(PG8_SA(0, 1), a2 + hstep);
            PG8_WAIT_V(8); PG8_WAIT_L(0); PG8_BAR; PG8_MMA(0, 0, At, B0); PG8_MMA(0, 1, At, B1); PG8_BAR; PG8_SCHED;
            PG8_LDA(At, 1, 1); PG8_STAGE(PG8_SB(1, 0), b3); PG8_STAGE(PG8_SB(1, 1), b3 + hstep); PG8_STAGE(PG8_SA(1, 0), a3);
            PG8_WAIT_V(8); PG8_WAIT_L(0); PG8_BAR; PG8_MMA(1, 0, At, B0); PG8_MMA(1, 1, At, B1); PG8_BAR; PG8_SCHED;
        }
        if (wr == 0) PG8_BAR;
        E(acc, cur, wr, wc, fr, fq);
        if (!has_next) break;
#pragma unroll
        for (int a = 0; a < 2; ++a)
#pragma unroll
            for (int b = 0; b < 2; ++b)
#pragma unroll
                for (int m = 0; m < 4; ++m)
#pragma unroll
                    for (int n = 0; n < 2; ++n) acc[a][b][m][n] = (f32x4){0.f, 0.f, 0.f, 0.f};
        cur = nxt; cA = nA; cB = nB; ++ui;
        if (wr == 1) PG8_BAR;
    }
    PG8_WAIT_V(0);
    PG8_BAR;
#undef PG8_SA
#undef PG8_SB
#undef PG8_STAGE
#undef PG8_LDA
#undef PG8_LDB
#undef PG8_MMA
#undef PG8_WAIT_V
#undef PG8_WAIT_L
#undef PG8_BAR
#undef PG8_SCHED
}
typedef f32x4 Acc[2][2][4][2];
__device__ __forceinline__ void store_f32(const Acc& acc, float* base, int ld, int rl0, int cl0, int valid) {
#pragma unroll
    for (int ai = 0; ai < 2; ++ai)
#pragma unroll
        for (int m = 0; m < 4; ++m) { const int row = rl0 + ai * HALF + m * 16; if (row < valid) { float* rp = base + (size_t)row * ld + cl0;
#pragma unroll
            for (int bj = 0; bj < 2; ++bj)
#pragma unroll
                for (int n = 0; n < 2; ++n) *(f32x4*)(rp + bj * HALF + n * 16) = acc[ai][bj][m][n]; } }
}
__device__ __forceinline__ void store_bf16(const Acc& acc, bf16_t* base, int ld, int rl0, int cl0) {
#pragma unroll
    for (int ai = 0; ai < 2; ++ai)
#pragma unroll
        for (int m = 0; m < 4; ++m) { const int row = rl0 + ai * HALF + m * 16; bf16_t* rp = base + (size_t)row * ld + cl0;
#pragma unroll
            for (int bj = 0; bj < 2; ++bj)
#pragma unroll
                for (int n = 0; n < 2; ++n) { const f32x4 a = acc[ai][bj][m][n]; u32x2 w; w.x = cvtpk(a[0], a[1]); w.y = cvtpk(a[2], a[3]); *(u32x2*)(rp + bj * HALF + n * 16) = w; } }
}
}

struct Params {
    const float* in[26];
    float* out;
    unsigned char* ws;
    int ph_lo, ph_hi;
};
enum { I_XP = 0, I_XS, I_CK, I_CV, I_SSM, I_SCONV, I_CMK, I_CMV, I_PT, I_MEM, I_NORMW, I_WIN, I_QNORM, I_KNORM, I_SBBIAS, I_CONVW, I_CONVB, I_DTBIAS, I_ALOG, I_DSKIP,
       I_SSDNW, I_MEMNW, I_WMEM, I_MQNORM, I_MKNORM, I_WOUT };

#define PSTAMP0(i) do { if (PROBE_SEG >= 40 && blockIdx.x == 0 && threadIdx.x == 0) ((volatile LAS unsigned long long*)(ctlw + 32))[20 + (i)] = __builtin_amdgcn_s_memrealtime(); } while (0)
struct TrItem { const float* src; bf16_t* dst; bool ok; };
__device__ __forceinline__ TrItem tr_item(const Params& p, int it, int lane) {
    constexpr int I_IN = (DM / 32) * (NPAD / 128), I_M = (DM / 32) * (1024 / 128);
    const float* W; bf16_t* WT; int Nsrc, N, map;
    if (it < I_IN) { W = p.in[I_WIN]; WT = (bf16_t*)(p.ws + WS_WIN); Nsrc = NIN; N = NPAD; map = 1; }
    else if (it < I_IN + I_M) { it -= I_IN; W = p.in[I_WMEM]; WT = (bf16_t*)(p.ws + WS_WM); Nsrc = 1024; N = 1024; map = 0; }
    else { it -= I_IN + I_M; W = p.in[I_WOUT]; WT = (bf16_t*)(p.ws + WS_WOUT); Nsrc = DM; N = DM; map = 2; }
    const int nblk = N / 128, kb = it / nblk, nb = it % nblk, k0 = 32 * kb, n0 = 128 * nb;
    const int ks0 = (map == 2) ? (k0 < 512 ? k0 + 1024 : (k0 < 1536 ? k0 - 512 : k0)) : k0;
    const int nd = n0 + 4 * (lane & 31);
    int ns = nd; bool ok = true;
    if (map == 1) { if (nd < 5632) ns = nd; else if (nd < 6656) ns = nd + 8; else if (nd < 6664) ns = nd - 1024; else { ns = 0; ok = false; } }
    TrItem t; t.src = W + (size_t)(ks0 + (lane >> 5)) * Nsrc + ns; t.dst = WT + (size_t)(n0 + (lane & 15)) * DM + k0 + 8 * (lane >> 4); t.ok = ok;
    return t;
}
__device__ __forceinline__ int tr_nsrc(int it) { constexpr int I_IN = (DM / 32) * (NPAD / 128), I_M = (DM / 32) * (1024 / 128); return it < I_IN ? NIN : (it < I_IN + I_M ? 1024 : DM); }
__device__ __forceinline__ void tr_load(const TrItem& t, int nsrc, f32x4 (&v)[16]) {
#pragma unroll
    for (int i = 0; i < 16; ++i) v[i] = t.ok ? *(const f32x4*)(t.src + (size_t)(2 * i) * nsrc) : f32x4{0.f, 0.f, 0.f, 0.f};
}
__device__ __forceinline__ void tr_finish(const TrItem& t, const f32x4 (&v)[16], LAS float* scr, int lane) {
#pragma unroll
    for (int i = 0; i < 16; ++i) { const int kk = 2 * i + (lane >> 5); *(LAS f32x4*)(scr + kk * 132 + 4 * (lane & 31)) = v[i]; }
    asm volatile("s_waitcnt lgkmcnt(0)" ::: "memory");
    const int nl = lane & 15, c = lane >> 4;
#pragma unroll
    for (int j = 0; j < 8; ++j) { const LAS float* sp = scr + (8 * c) * 132 + nl + 16 * j;
        u32x4 o; o.x = cvtpk(sp[0 * 132], sp[1 * 132]); o.y = cvtpk(sp[2 * 132], sp[3 * 132]); o.z = cvtpk(sp[4 * 132], sp[5 * 132]); o.w = cvtpk(sp[6 * 132], sp[7 * 132]);
        *(u32x4*)(t.dst + (size_t)(16 * j) * DM) = o; }
    asm volatile("s_waitcnt lgkmcnt(0)" ::: "memory");
}
__device__ __forceinline__ const float* p0_row_src(const Params& p, int m) { return m < MP ? p.in[I_XP] + (size_t)m * DM : (m < MVALID ? p.in[I_XS] + (size_t)(m - MP) * DM : p.in[I_MEM] + (size_t)(m - MVALID) * DM); }
__device__ __forceinline__ void p0_row_finish(const Params& p, int m, const f32x4 (&v)[8], int lane) {
    float s = 0.f;
#pragma unroll
    for (int j = 0; j < 8; ++j) s += (v[j].x * v[j].x + v[j].y * v[j].y) + (v[j].z * v[j].z + v[j].w * v[j].w);
    const float rs = 1.f / sqrtf(wave_sum(s) * (1.f / DM) + EPS);
    const f32x4* gr = (const f32x4*)(m < MVALID ? p.in[I_NORMW] : p.in[I_MEMNW]) + lane;
    bf16_t* orow = m < MVALID ? (bf16_t*)(p.ws + WS_H) + (size_t)m * DM : (bf16_t*)(p.ws + WS_HM) + (size_t)(m - MVALID) * DM;
    u32x2* o8 = (u32x2*)orow + lane;
#pragma unroll
    for (int j = 0; j < 8; ++j) { const f32x4 g = gr[64 * j]; u32x2 w; w.x = cvtpk(v[j].x * rs * g.x, v[j].y * rs * g.y); w.y = cvtpk(v[j].z * rs * g.z, v[j].w * rs * g.w); o8[64 * j] = w; }
}
__device__ __forceinline__ void phase0(const Params& p, LAS unsigned char* lds, int vcu, int G, volatile LAS unsigned* ctlw) {
    const int tid = threadIdx.x, lane = tid & 63, wave = __builtin_amdgcn_readfirstlane(tid >> 6);
    LAS float* scr = (LAS float*)(lds + wave * 16896);
    const int gw = vcu * 8 + wave, NGW = G * 8;
    constexpr int NITEMS = (DM / 32) * (NPAD / 128) + (DM / 32) * (1024 / 128) + (DM / 32) * (DM / 128);
    PSTAMP0(0);
    {
        f32x4 va[8], vb[8];
        int m = gw;
        if (m < MVALID + MMEM) { const f32x4* xr = (const f32x4*)p0_row_src(p, m) + lane;
#pragma unroll
            for (int j = 0; j < 8; ++j) va[j] = xr[64 * j]; }
        while (m < MVALID + MMEM) {
            const int mb = m + NGW;
            if (mb < MVALID + MMEM) { const f32x4* xr = (const f32x4*)p0_row_src(p, mb) + lane;
#pragma unroll
                for (int j = 0; j < 8; ++j) vb[j] = xr[64 * j]; }
            p0_row_finish(p, m, va, lane);
            if (mb >= MVALID + MMEM) break;
            const int ma = mb + NGW;
            if (ma < MVALID + MMEM) { const f32x4* xr = (const f32x4*)p0_row_src(p, ma) + lane;
#pragma unroll
                for (int j = 0; j < 8; ++j) va[j] = xr[64 * j]; }
            p0_row_finish(p, mb, vb, lane);
            m = ma;
        }
    }
    PSTAMP0(1);
    {
        f32x4 va[16], vb[16];
        int it = gw;
        TrItem ta{}, tb{};
        if (it < NITEMS) { ta = tr_item(p, it, lane); tr_load(ta, tr_nsrc(it), va); }
        while (it < NITEMS) {
            const int itb = it + NGW;
            if (itb < NITEMS) { tb = tr_item(p, itb, lane); tr_load(tb, tr_nsrc(itb), vb); }
            tr_finish(ta, va, scr, lane);
            if (itb >= NITEMS) break;
            const int ita = itb + NGW;
            if (ita < NITEMS) { ta = tr_item(p, ita, lane); tr_load(ta, tr_nsrc(ita), va); }
            tr_finish(tb, vb, scr, lane);
            it = ita;
        }
    }
    PSTAMP0(2);
    const int gt = vcu * 512 + tid, NGT = G * 512;
    u32x4* cmk = (u32x4*)(p.ws + WS_CMK); u32x4* cmv = (u32x4*)(p.ws + WS_CMV);
    constexpr int N8 = DSEQ * MEMT * 512 / 8;
    for (int i = gt; i < 2 * N8; i += NGT) { const bool isk = i < N8; const int j = isk ? i : i - N8; const f32x4* s = (const f32x4*)(isk ? p.in[I_CMK] : p.in[I_CMV]) + 2 * (size_t)j;
        const f32x4 a = s[0], b = s[1]; u32x4 o; o.x = cvtpk(a.x, a.y); o.y = cvtpk(a.z, a.w); o.z = cvtpk(b.x, b.y); o.w = cvtpk(b.z, b.w); (isk ? cmk : cmv)[j] = o; }
    PSTAMP0(3);
}

struct Epi1 {
    static constexpr int MID = 0;
    bf16_t* PROJ; float* DT; float* out; const float* dtbias; const float* qn; const float* kn; const float* mqn; const float* mkn; bf16_t* MKn; bf16_t* MVb; LAS float* T;
    __device__ __forceinline__ void head_norm(pg8::Acc& acc, const float* gain, float gscale, int wr, int wc, int fr, int fq) const {
        float part[2][4][2];
#pragma unroll
        for (int ai = 0; ai < 2; ++ai)
#pragma unroll
            for (int m = 0; m < 4; ++m)
#pragma unroll
                for (int bj = 0; bj < 2; ++bj) { const f32x4 a = acc[ai][bj][m][0], b = acc[ai][bj][m][1];
                    float s = ((a.x * a.x + a.y * a.y) + (a.z * a.z + a.w * a.w)) + ((b.x * b.x + b.y * b.y) + (b.z * b.z + b.w * b.w));
                    s += __shfl_xor(s, 16); s += __shfl_xor(s, 32); part[ai][m][bj] = s; }
        if (fq == 0) {
#pragma unroll
            for (int ai = 0; ai < 2; ++ai)
#pragma unroll
                for (int m = 0; m < 4; ++m)
#pragma unroll
                    for (int bj = 0; bj < 2; ++bj) T[(((wr * 128 + ai * 64 + m * 16 + fr) * 2 + bj) << 2) + wc] = part[ai][m][bj];
        }
        asm volatile("s_waitcnt lgkmcnt(0)" ::: "memory");
        __builtin_amdgcn_s_barrier();
        asm volatile("" ::: "memory");
        int cg = wc * 32 + 4 * fq; asm volatile("" : "+v"(cg));
        const f32x4 g0 = *(const f32x4*)(gain + cg) * gscale, g1 = *(const f32x4*)(gain + cg + 16) * gscale;
#pragma unroll
        for (int ai = 0; ai < 2; ++ai)
#pragma unroll
            for (int m = 0; m < 4; ++m)
#pragma unroll
                for (int bj = 0; bj < 2; ++bj) { const f32x4 t = *(const LAS f32x4*)(T + (((wr * 128 + ai * 64 + m * 16 + fr) * 2 + bj) << 2));
                    const float rs = 1.f / sqrtf(((t.x + t.y) + (t.z + t.w)) * (1.f / 128.f) + EPS);
                    acc[ai][bj][m][0] = acc[ai][bj][m][0] * rs * g0; acc[ai][bj][m][1] = acc[ai][bj][m][1] * rs * g1;
                    asm volatile("" ::: "memory"); }
    }
    __device__ __forceinline__ void operator()(pg8::Acc& acc, const pg8::Unit& u, int wr, int wc, int fr, int fq) const {
        int rl0 = wr * 64 + fr, cl0 = wc * 32 + 4 * fq;
        asm volatile("" : "+v"(rl0), "+v"(cl0));
        const int pn = u.pn; const size_t r0 = (size_t)u.pm * 256;
        const float* gain = nullptr; float gs = 1.f;
        float* fbase = nullptr; int fld = 1024, valid = 256;
        bf16_t* bbase = PROJ + r0 * NPAD + pn * 256; int bld = NPAD;
        if (u.sel == 1) { if (pn < 2) gain = mkn; fbase = out + (pn < 2 ? O_PMK : O_PMV) + r0 * 512 + (pn & 1) * 256; fld = 512; bbase = (pn < 2 ? MKn : MVb) + r0 * 512 + (pn & 1) * 256; bld = 512; }
        else {
            if (pn < 4) { gain = qn; gs = QSCALE; } else if (pn < 8) gain = kn; else if (pn == 22 || pn == 23) { gain = mqn; gs = QSCALE; }
            if (pn >= 4 && pn < 12) { if (u.pm < 32) fbase = out + (pn < 8 ? O_PK : O_PV) + r0 * 1024 + (pn & 3) * 256; else { fbase = out + (pn < 8 ? O_SK : O_SV) + (pn & 3) * 256; valid = MS; } }
        }
        if (gain) head_norm(acc, gain, gs, wr, wc, fr, fq);
        if (fbase) pg8::store_f32(acc, fbase, fld, rl0, cl0, valid);
        pg8::store_bf16(acc, bbase, bld, rl0, cl0);
        if (u.sel == 1) return;
        if (pn >= 18 && pn < 22) {
#pragma unroll
            for (int ai = 0; ai < 2; ++ai)
#pragma unroll
                for (int m = 0; m < 4; ++m) { const int row = rl0 + ai * 128 + m * 16; float* dst = nullptr;
                    if (u.pm < 32) { if ((u.pm & 7) == 7 && row >= 253) dst = out + O_PCONV + (size_t)((u.pm >> 3) * 3 + row - 253) * 1024; }
                    else if (row < MS && (row & 7) >= 5) dst = out + O_SCONV + (size_t)((row >> 3) * 3 + (row & 7) - 5) * 1024;
                    if (dst) { dst += (pn - 18) * 256 + cl0;
#pragma unroll
                        for (int bj = 0; bj < 2; ++bj)
#pragma unroll
                            for (int n = 0; n < 2; ++n) *(f32x4*)(dst + bj * 128 + n * 16) = acc[ai][bj][m][n]; } }
        }
        if (pn == 26 && wc == 0 && fq < 2) {
            const f32x4 db = *(const f32x4*)(dtbias + 4 * fq);
#pragma unroll
            for (int ai = 0; ai < 2; ++ai)
#pragma unroll
                for (int m = 0; m < 4; ++m) { const int row = rl0 + ai * 128 + m * 16; f32x4 v = acc[ai][0][m][0] + db;
#pragma unroll
                    for (int e = 0; e < 4; ++e) v[e] = (v[e] > 20.f) ? v[e] : log1pf(__expf(v[e]));
                    *(f32x4*)(DT + (r0 + row) * 8 + 4 * fq) = v; }
        }
    }
};

__device__ __forceinline__ float group16_sum(float v) { v += __shfl_xor(v, 1); v += __shfl_xor(v, 2); v += __shfl_xor(v, 4); v += __shfl_xor(v, 8); return v; }

#define KSWZ(row, colB) ((row) * 256 + ((colB) ^ (((row) & 7) << 4)))
#define SBAR() __builtin_amdgcn_sched_barrier(0)
__device__ __forceinline__ int crow(int r, int hi) { return (r & 3) + 8 * (r >> 2) + 4 * hi; }
__device__ __forceinline__ int v_st(int k, int c) { const int kk = (k & ~0xC) | ((k & 4) << 1) | ((k & 8) >> 1); return ((kk >> 3) * 4 + (c >> 5)) * 512 + ((kk & 7) * 32 + (c & 31)) * 2; }
__device__ __forceinline__ int v_rd_base(int lane) { return ((lane & 3) << 3) | (((lane >> 2) & 3) << 6) | (((lane >> 4) & 1) << 5) | (((lane >> 5) & 1) << 8); }
constexpr int v_rd_off(int d0, int ks, int half) { return d0 * 512 + ks * 4096 + half * 2048; }
template <int OFF> __device__ __forceinline__ s16x4 tr_read(int vb) {
    s16x4 r; asm volatile("ds_read_b64_tr_b16 %0, %1 offset:%2" : "=&v"(r) : "v"(vb), "i"(OFF) : "memory"); return r;
}
#define PKV(L, H) (bf16x8){L[0], L[1], L[2], L[3], H[0], H[1], H[2], H[3]}
template <int D0, int KS0> __device__ __forceinline__ void pv_one(f32x16& od, int vb, const bf16x8* pa) {
    const s16x4 l0 = tr_read<v_rd_off(D0, KS0, 0)>(vb), h0 = tr_read<v_rd_off(D0, KS0, 1)>(vb), l1 = tr_read<v_rd_off(D0, KS0 + 1, 0)>(vb), h1 = tr_read<v_rd_off(D0, KS0 + 1, 1)>(vb);
    asm volatile("s_waitcnt lgkmcnt(0)" ::: "memory"); SBAR();
    od = __builtin_amdgcn_mfma_f32_32x32x16_bf16(pa[0], PKV(l0, h0), od, 0, 0, 0);
    od = __builtin_amdgcn_mfma_f32_32x32x16_bf16(pa[1], PKV(l1, h1), od, 0, 0, 0);
}
template <int KS0> __device__ __forceinline__ void pv_blk(f32x16* o, int vb, const bf16x8* pa) {
    pv_one<0, KS0>(o[0], vb, pa); pv_one<1, KS0>(o[1], vb, pa); pv_one<2, KS0>(o[2], vb, pa); pv_one<3, KS0>(o[3], vb, pa);
}
__device__ __forceinline__ void pack_p(const f32x16& P, bf16x8& out0, bf16x8& out1) {
#define PK4(BASE, OUT) do { unsigned a0 = cvtpk(P[BASE + 0], P[BASE + 1]), a1 = cvtpk(P[BASE + 2], P[BASE + 3]);   \
    unsigned b0 = cvtpk(P[BASE + 4], P[BASE + 5]), b1 = cvtpk(P[BASE + 6], P[BASE + 7]);                              \
    auto r0 = __builtin_amdgcn_permlane32_swap(a0, b0, false, false); auto r1 = __builtin_amdgcn_permlane32_swap(a1, b1, false, false); \
    u32x4 w = {r0[0], r1[0], r0[1], r1[1]}; OUT = *reinterpret_cast<bf16x8*>(&w); } while (0)
    PK4(0, out0); PK4(8, out1);
#undef PK4
}
template <int NB, bool MASK> __device__ __forceinline__ void sb_transform(f32x16* P, float& R, int hi, int kpos0, int qpos) {
    float T[NB][4];
#pragma unroll
    for (int b = 0; b < NB; ++b)
#pragma unroll
        for (int g = 0; g < 4; ++g) {
            float be[4], f[4];
#pragma unroll
            for (int i = 0; i < 4; ++i) {
                const float z = fmaxf(P[b][4 * g + i], -100.f);
                const float e = fast_exp2(-z), rc = fast_rcp(1.f + e);
                be[i] = rc; f[i] = e * rc;
                if (MASK) { const bool ok = (kpos0 + 32 * b + 8 * g + 4 * hi + i) < qpos; be[i] = ok ? be[i] : 0.f; f[i] = ok ? f[i] : 1.f; }
            }
            const float e2 = f[3], e1 = f[2] * f[3], e0 = f[1] * e1;
            T[b][g] = f[0] * e0;
            P[b][4 * g + 0] = be[0] * e0; P[b][4 * g + 1] = be[1] * e1; P[b][4 * g + 2] = be[2] * e2; P[b][4 * g + 3] = be[3];
        }
    float E = R;
#pragma unroll
    for (int b = NB - 1; b >= 0; --b)
#pragma unroll
        for (int g = 3; g >= 0; --g) {
            const float To = __shfl_xor(T[b][g], 32);
            const float Eg = hi ? E : E * To;
#pragma unroll
            for (int i = 0; i < 4; ++i) P[b][4 * g + i] *= Eg;
            E = E * T[b][g] * To;
        }
    R = E;
}

struct AttnArgs {
    const bf16_t* Q; int qstride;
    const bf16_t* K; const bf16_t* V; int kvstride;
    int ntiles;
    int qpos0;
    int nvalid;
    float bias2;
    const bf16_t* gate; int gstride;
    bf16_t* out; int ostride;
};
struct GroupBar { volatile LAS unsigned* cnt; unsigned gen; };
__device__ __forceinline__ void group_bar(GroupBar& gb, int lane) {
    asm volatile("s_waitcnt lgkmcnt(0)" ::: "memory");
    gb.gen += 4u;
    if (lane == 0) (void)__hip_atomic_fetch_add((LAS unsigned*)gb.cnt, 1u, __ATOMIC_RELAXED, __HIP_MEMORY_SCOPE_WORKGROUP);
    while (__hip_atomic_load((LAS unsigned*)gb.cnt, __ATOMIC_RELAXED, __HIP_MEMORY_SCOPE_WORKGROUP) < gb.gen) __builtin_amdgcn_s_sleep(0);
    asm volatile("" ::: "memory");
}
template <int MODE>
__device__ __forceinline__ void attn_unit(LAS unsigned char* lds, GroupBar& gb, const bf16_t* aQ, int aqstride, const bf16_t* aK, const bf16_t* aV, int akvstride, int antiles, int aqpos0, int anvalid, float abias2,
                                      const bf16_t* agate, int agstride, bf16_t* aout, int aostride) {
    AttnArgs a; a.Q = aQ; a.qstride = aqstride; a.K = aK; a.V = aV; a.kvstride = akvstride; a.ntiles = antiles; a.qpos0 = aqpos0; a.nvalid = anvalid; a.bias2 = abias2;
    a.gate = agate; a.gstride = agstride; a.out = aout; a.ostride = aostride;
    int tid = threadIdx.x; asm volatile("" : "+v"(tid));
    const int wid = __builtin_amdgcn_readfirstlane(tid >> 6), lane = tid & 63, r32 = lane & 31, hi = lane >> 5;
    constexpr int SHM_V = 16384, SHM_K = 16384;
    LAS unsigned char* V_lds = lds; LAS unsigned char* K_lds = lds + 2 * SHM_V;
    LAS float* wsf = (LAS float*)(lds + 73728) + wid * 64;
    f32x16 o[4];
#pragma unroll
    for (int d = 0; d < 4; ++d) o[d] = f32x16{};
    bf16x8 qr[8];
    { int qrow = wid * 32 + r32; qrow = qrow < a.nvalid ? qrow : a.nvalid - 1;
      const bf16_t* Qw = a.Q + (size_t)qrow * a.qstride + hi * 8;
#pragma unroll
      for (int d0 = 0; d0 < 8; ++d0) qr[d0] = *(const bf16x8*)(Qw + d0 * 16); }
    const int sr = tid >> 4, sc = (tid & 15) * 8;
    const int vb0 = (int)(uintptr_t)V_lds + v_rd_base(lane);
    bf16x8 sv[4], sk[4];
#define SLOAD(k0) do { _Pragma("unroll") for (int j_ = 0; j_ < 4; ++j_) { sv[j_] = *(const bf16x8*)(a.V + (size_t)((k0) + sr + 16 * j_) * a.kvstride + sc); \
        sk[j_] = *(const bf16x8*)(a.K + (size_t)((k0) + sr + 16 * j_) * a.kvstride + sc); } } while (0)
#define SWRITE(b) do { _Pragma("unroll") for (int j_ = 0; j_ < 4; ++j_) { *(LAS bf16x8*)(V_lds + (b) * SHM_V + v_st(sr + 16 * j_, sc)) = sv[j_]; \
        *(LAS bf16x8*)(K_lds + (b) * SHM_K + KSWZ(sr + 16 * j_, sc * 2)) = sk[j_]; } } while (0)
    const int nt = a.ntiles;
    float R = 1.f, lsum = 0.f;
    const int qpos = a.qpos0 + wid * 32 + r32;
    const int qmax_w = a.qpos0 + wid * 32 + 31;
    group_bar(gb, lane);
    { const int t0 = (MODE == 0) ? nt - 1 : 0; SLOAD(t0 * 64); SWRITE(0); }
    group_bar(gb, lane);
    for (int j = 0; j < nt; ++j) {
        const int cur = j & 1, t = (MODE == 0) ? nt - 1 - j : j;
        if (j + 1 < nt) { const int tn = (MODE == 0) ? t - 1 : t + 1; SLOAD(tn * 64); }
        const bool active = (MODE == 1) || (t * 64 < qmax_w);
        if (active) {
            const LAS unsigned char* Ks = K_lds + cur * SHM_K;
            const bool diag = (MODE == 0) && (t * 64 + 63 >= a.qpos0);
#define ATT_BLOCK(B) do { f32x16 pb_[1]; { const float init = (MODE == 0) ? a.bias2 : 0.f; _Pragma("unroll") for (int r = 0; r < 16; ++r) pb_[0][r] = init; } \
            _Pragma("unroll") for (int d0 = 0; d0 < 8; ++d0) { const int cb = (d0 * 16 + hi * 8) * 2; \
                const bf16x8 kf = *(const LAS bf16x8*)(Ks + KSWZ(32 * (B) + r32, cb)); \
                pb_[0] = __builtin_amdgcn_mfma_f32_32x32x16_bf16(kf, qr[d0], pb_[0], 0, 0, 0); } \
            if (MODE == 0) { if (diag) sb_transform<1, true>(pb_, R, hi, t * 64 + 32 * (B), qpos); else sb_transform<1, false>(pb_, R, hi, 0, 0); } \
            else { float ps = 0.f; _Pragma("unroll") for (int r = 0; r < 16; ++r) { pb_[0][r] = fast_exp2(pb_[0][r]); ps += pb_[0][r]; } lsum += ps; } \
            bf16x8 pa_[2]; pack_p(pb_[0], pa_[0], pa_[1]); SBAR(); \
            pv_blk<2 * (B)>(o, vb0 + cur * SHM_V, pa_); } while (0)
            ATT_BLOCK(1);
            ATT_BLOCK(0);
#undef ATT_BLOCK
        }
        if (j + 1 < nt) SWRITE(cur ^ 1);
        group_bar(gb, lane);
    }
#undef SLOAD
#undef SWRITE
    float rl[16];
    if (MODE == 1) {
        lsum += __shfl_xor(lsum, 32);
        if (hi == 0) wsf[r32] = lsum;
        asm volatile("s_waitcnt lgkmcnt(0)" ::: "memory");
#pragma unroll
        for (int r = 0; r < 16; ++r) rl[r] = fast_rcp(wsf[crow(r, hi)]);
    }
    LAS unsigned char* ost = lds + wid * (32 * 272);
#pragma unroll
    for (int r = 0; r < 16; ++r)
#pragma unroll
        for (int d0 = 0; d0 < 4; ++d0) { float v = o[d0][r]; if (MODE == 1) v *= rl[r];
            *(LAS bf16_t*)(ost + crow(r, hi) * 272 + (d0 * 32 + r32) * 2) = f2bf(v); }
    asm volatile("s_waitcnt lgkmcnt(0)" ::: "memory");
    {
        const int row = wid * 32 + (lane >> 1), c0 = (lane & 1) * 64;
        if (row < a.nvalid) {
            const bf16_t* gp = a.gate + (size_t)row * a.gstride + c0; bf16_t* op = a.out + (size_t)row * a.ostride + c0;
            u32x4 gv[8];
#pragma unroll
            for (int j = 0; j < 8; ++j) gv[j] = *(const u32x4*)(gp + 8 * j);
#pragma unroll
            for (int j = 0; j < 8; ++j) { const u32x4 ov = *(const LAS u32x4*)(ost + (lane >> 1) * 272 + (c0 + 8 * j) * 2); u32x4 w;
#pragma unroll
                for (int e = 0; e < 4; ++e) w[e] = cvtpk(bf_lo(ov[e]) * silu_f(bf_lo(gv[j][e])), bf_hi(ov[e]) * silu_f(bf_hi(gv[j][e])));
                *(u32x4*)(op + 8 * j) = w; }
        }
    }
}

__device__ __forceinline__ void sb_transform16(f32x4 (&st)[2], float& R, int lane, int kg) {
    float T[2];
#pragma unroll
    for (int rb = 0; rb < 2; ++rb) {
        float be[4], f[4];
#pragma unroll
        for (int i = 0; i < 4; ++i) { const float z = fmaxf(st[rb][i], -100.f); const float e = fast_exp2(-z), rc = fast_rcp(1.f + e); be[i] = rc; f[i] = e * rc; }
        const float e2 = f[3], e1 = f[2] * f[3], e0 = f[1] * e1;
        T[rb] = f[0] * e0;
        st[rb][0] = be[0] * e0; st[rb][1] = be[1] * e1; st[rb][2] = be[2] * e2; st[rb][3] = be[3];
    }
    float Tg[8];
#pragma unroll
    for (int k2 = 0; k2 < 4; ++k2) { const int src = ((lane & 15) + 16 * k2) * 4;
        Tg[k2] = __builtin_bit_cast(float, __builtin_amdgcn_ds_bpermute(src, __builtin_bit_cast(int, T[0])));
        Tg[4 + k2] = __builtin_bit_cast(float, __builtin_amdgcn_ds_bpermute(src, __builtin_bit_cast(int, T[1]))); }
    float S[8]; S[7] = R;
#pragma unroll
    for (int G = 6; G >= 0; --G) S[G] = S[G + 1] * Tg[G + 1];
    const float E0 = kg == 0 ? S[0] : kg == 1 ? S[1] : kg == 2 ? S[2] : S[3];
    const float E1 = kg == 0 ? S[4] : kg == 1 ? S[5] : kg == 2 ? S[6] : S[7];
    st[0] = st[0] * E0; st[1] = st[1] * E1;
    R = S[0] * Tg[0];
}

constexpr int L0_FIRST = 96, L0_PAGES = NPAGES - L0_FIRST;
constexpr float SKIP_THR = 1.4551915e-11f;
constexpr int CW_L0CNT = 8192;
constexpr int N_DEC_L0 = DSEQ * 8 * L0_PAGES, N_DEC_ITEMS = N_DEC_L0 + DSEQ * 8 * (L0_FIRST / 2);
template <bool SC1>
__device__ __forceinline__ bool decode_skip_old_pages(const float* FPARTp, int seq, int head, int lane) {
    const float* Fp = FPARTp + ((size_t)((seq * 8 + head) * NPAGES + L0_FIRST)) * DTOK;
    const int q = lane & 7, grp = lane >> 3;
    float f[4];
#pragma unroll
    for (int k = 0; k < 4; ++k) { const float* a = Fp + (grp * 4 + k) * DTOK + q;
        f[k] = SC1 ? __builtin_bit_cast(float, __hip_atomic_load((const unsigned*)a, __ATOMIC_RELAXED, __HIP_MEMORY_SCOPE_AGENT)) : *a; }
    float pr = (f[0] * f[1]) * (f[2] * f[3]);
    pr *= __shfl_xor(pr, 8); pr *= __shfl_xor(pr, 16); pr *= __shfl_xor(pr, 32);
    float m = pr; m = fmaxf(m, __shfl_xor(m, 1)); m = fmaxf(m, __shfl_xor(m, 2)); m = fmaxf(m, __shfl_xor(m, 4));
    return m < SKIP_THR;
}

__device__ __forceinline__ void decode_page(const int* ptab, const float* ck, const float* cv, const float* sbbias, unsigned char* ws, LAS unsigned char* wlds, int seq, int page, int head, int lane) {
    const int j16 = lane & 15, kg = lane >> 4;
    constexpr int VLD = 272;
    LAS unsigned char* K_lds = wlds; LAS unsigned char* V_lds = wlds + 8192; LAS unsigned char* Q_lds = wlds + 8192 + 8704;
    const bf16_t* PROJ = (const bf16_t*)(ws + WS_PROJ);
    const int phys = __builtin_amdgcn_readfirstlane(ptab[seq * NPAGES + page]);
    const float bias2 = sbbias[head] * LOG2E;
    f32x4 o[8];
#pragma unroll
    for (int d = 0; d < 8; ++d) o[d] = f32x4{0.f, 0.f, 0.f, 0.f};
    float R = 1.f;
    const int srow = lane >> 4, scol = (lane & 15) * 8;
    const int vtr = (int)(uintptr_t)V_lds + (4 * kg + (j16 >> 2)) * VLD + 8 * (j16 & 3);
#pragma unroll
    for (int i = 0; i < 2; ++i) { const int c = lane + 64 * i, qrw = c >> 4, qc = (c & 15) * 8;
        *(LAS bf16x8*)(Q_lds + KSWZ(qrw, qc * 2)) = *(const bf16x8*)(PROJ + (size_t)(MP + seq * DTOK + qrw) * NPAD + PC_Q + head * 128 + qc); }
    f32x4 sk[16], sv[16];
    const __amdgpu_buffer_rsrc_t rK = __builtin_amdgcn_make_buffer_rsrc((void*)(ck + (size_t)phys * (PAGE * 1024)), 0, PAGE * 1024 * 4, 0x00020000);
    const __amdgpu_buffer_rsrc_t rV = __builtin_amdgcn_make_buffer_rsrc((void*)(cv + (size_t)phys * (PAGE * 1024)), 0, PAGE * 1024 * 4, 0x00020000);
    const int voff = (srow * 1024 + head * 128 + scol) * 4;
#define DLOAD(dst, rs, kb) do { _Pragma("unroll") for (int i = 0; i < 8; ++i) { const int so_ = ((kb) * 32 + 4 * i) * 4096; \
        dst[2 * i] = __builtin_bit_cast(f32x4, __builtin_amdgcn_raw_buffer_load_b128(rs, voff, so_, 2)); dst[2 * i + 1] = __builtin_bit_cast(f32x4, __builtin_amdgcn_raw_buffer_load_b128(rs, voff + 16, so_, 2)); } } while (0)
    DLOAD(sk, rK, 3); DLOAD(sv, rV, 3);
#pragma unroll 1
    for (int kb = 3; kb >= 0; --kb) {
#pragma unroll
        for (int i = 0; i < 8; ++i) { u32x4 w; w.x = cvtpk(sk[2 * i].x, sk[2 * i].y); w.y = cvtpk(sk[2 * i].z, sk[2 * i].w); w.z = cvtpk(sk[2 * i + 1].x, sk[2 * i + 1].y); w.w = cvtpk(sk[2 * i + 1].z, sk[2 * i + 1].w);
            *(LAS u32x4*)(K_lds + KSWZ(srow + 4 * i, scol * 2)) = w; }
        if (kb > 0) DLOAD(sk, rK, kb - 1);
        f32x4 st[2];
        st[0] = f32x4{bias2, bias2, bias2, bias2}; st[1] = st[0];
#pragma unroll
        for (int ks = 0; ks < 4; ++ks) { const int cb = (32 * ks + 8 * kg) * 2;
            const bf16x8 qf = *(const LAS bf16x8*)(Q_lds + KSWZ(j16 & 7, cb));
            const bf16x8 k0 = *(const LAS bf16x8*)(K_lds + KSWZ(j16, cb)), k1 = *(const LAS bf16x8*)(K_lds + KSWZ(16 + j16, cb));
            st[0] = __builtin_amdgcn_mfma_f32_16x16x32_bf16(k0, qf, st[0], 0, 0, 0);
            st[1] = __builtin_amdgcn_mfma_f32_16x16x32_bf16(k1, qf, st[1], 0, 0, 0); }
        sb_transform16(st, R, lane, kg);
        u32x4 af; af.x = cvtpk(st[0][0], st[0][1]); af.y = cvtpk(st[0][2], st[0][3]); af.z = cvtpk(st[1][0], st[1][1]); af.w = cvtpk(st[1][2], st[1][3]);
        const bf16x8 pfrag = __builtin_bit_cast(bf16x8, af);
#pragma unroll
        for (int i = 0; i < 8; ++i) { u32x4 w; w.x = cvtpk(sv[2 * i].x, sv[2 * i].y); w.y = cvtpk(sv[2 * i].z, sv[2 * i].w); w.z = cvtpk(sv[2 * i + 1].x, sv[2 * i + 1].y); w.w = cvtpk(sv[2 * i + 1].z, sv[2 * i + 1].w);
            *(LAS u32x4*)(V_lds + (srow + 4 * i) * VLD + scol * 2) = w; }
        if (kb > 0) DLOAD(sv, rV, kb - 1);
        SBAR();
#define DPV4(D0) do { const s16x4 l0_ = tr_read<(D0) * 32>(vtr), h0_ = tr_read<(D0) * 32 + 16 * VLD>(vtr), l1_ = tr_read<(D0 + 1) * 32>(vtr), h1_ = tr_read<(D0 + 1) * 32 + 16 * VLD>(vtr); \
        const s16x4 l2_ = tr_read<(D0 + 2) * 32>(vtr), h2_ = tr_read<(D0 + 2) * 32 + 16 * VLD>(vtr), l3_ = tr_read<(D0 + 3) * 32>(vtr), h3_ = tr_read<(D0 + 3) * 32 + 16 * VLD>(vtr); \
        asm volatile("s_waitcnt lgkmcnt(0)" ::: "memory"); SBAR(); \
        o[D0] = __builtin_amdgcn_mfma_f32_16x16x32_bf16(pfrag, PKV(l0_, h0_), o[D0], 0, 0, 0); o[D0 + 1] = __builtin_amdgcn_mfma_f32_16x16x32_bf16(pfrag, PKV(l1_, h1_), o[D0 + 1], 0, 0, 0); \
        o[D0 + 2] = __builtin_amdgcn_mfma_f32_16x16x32_bf16(pfrag, PKV(l2_, h2_), o[D0 + 2], 0, 0, 0); o[D0 + 3] = __builtin_amdgcn_mfma_f32_16x16x32_bf16(pfrag, PKV(l3_, h3_), o[D0 + 3], 0, 0, 0); } while (0)
        DPV4(0); DPV4(4);
#undef DPV4
    }
#undef DLOAD
    if (kg < 2) {
        float* Op = (float*)(ws + WS_OPART) + ((size_t)((seq * 8 + head) * NPAGES + page)) * (DTOK * 128);
#pragma unroll
        for (int db = 0; db < 8; ++db)
#pragma unroll
            for (int r = 0; r < 4; ++r) Op[(4 * kg + r) * 128 + 16 * db + j16] = o[db][r];
    }
    if (lane < 8) __hip_atomic_store((unsigned*)(ws + WS_FPART) + ((size_t)((seq * 8 + head) * NPAGES + page)) * DTOK + lane, __builtin_bit_cast(unsigned, R), __ATOMIC_RELAXED, __HIP_MEMORY_SCOPE_AGENT);
}
__device__ __forceinline__ void decode_wave_loop(const int* ptab, const float* ck, const float* cv, const float* sbbias, unsigned char* ws, LAS unsigned char* wlds, unsigned* qhead, int lane) {
    int ckey = -1; bool cskip = false;
    unsigned* l0cnt = (unsigned*)(ws + WS_CTL) + CW_L0CNT;
    for (;;) {
        unsigned it = 0; if (lane == 0) it = __hip_atomic_fetch_add(qhead, 1u, __ATOMIC_RELAXED, __HIP_MEMORY_SCOPE_AGENT);
        it = __builtin_amdgcn_readfirstlane(it);
        if (it >= (unsigned)N_DEC_ITEMS) break;
        int seq, head, page0, npages;
        if (it < (unsigned)N_DEC_L0) { head = it & 7; page0 = L0_FIRST + ((it >> 3) & 31); seq = it >> 8; npages = 1; }
        else {
            const int j = (int)it - N_DEC_L0, rem = j % (DSEQ * (L0_FIRST / 2));
            head = 7 - j / (DSEQ * (L0_FIRST / 2)); seq = rem / (L0_FIRST / 2); page0 = 2 * (rem % (L0_FIRST / 2)); npages = 2;
            const int key = seq * 8 + head;
            if (key != ckey) {
                unsigned ok = 1u, sp = 0u;
                while (__builtin_amdgcn_readfirstlane(__hip_atomic_load(l0cnt + 64 * key, __ATOMIC_RELAXED, __HIP_MEMORY_SCOPE_AGENT)) < (unsigned)L0_PAGES) { __builtin_amdgcn_s_sleep(8); if (++sp > (1u << 20)) { ok = 0u; break; } }
                cskip = ok ? decode_skip_old_pages<true>((const float*)(ws + WS_FPART), seq, head, lane) : false; ckey = key;
            }
            if (cskip) continue;
        }
#pragma unroll 1
        for (int pg = 0; pg < npages; ++pg) decode_page(ptab, ck, cv, sbbias, ws, wlds, seq, page0 + pg, head, lane);
        if (npages == 1) {
            asm volatile("s_waitcnt vmcnt(0)" ::: "memory");
            if (lane == 0) __hip_atomic_fetch_add(l0cnt + 64 * (seq * 8 + head), 1u, __ATOMIC_RELAXED, __HIP_MEMORY_SCOPE_AGENT);
        }
    }
}

constexpr int SS_LD = 272;
__device__ __forceinline__ void scan128(float& v0, float& v1, int lane) {
#pragma unroll
    for (int o = 1; o < 64; o <<= 1) { const float t0 = __shfl_up(v0, o), t1 = __shfl_up(v1, o); if (lane >= o) { v0 += t0; v1 += t1; } }
    v1 += __shfl(v0, 63);
}
__device__ __forceinline__ void tr4x8(const u32x4 (&w)[4], u32x2 (&o)[8]) {
#pragma unroll
    for (int k = 0; k < 8; ++k) { const int d = k >> 1;
        if (k & 1) { o[k].x = (w[0][d] >> 16) | (w[1][d] & 0xffff0000u); o[k].y = (w[2][d] >> 16) | (w[3][d] & 0xffff0000u); }
        else       { o[k].x = (w[0][d] & 0xffffu) | (w[1][d] << 16);     o[k].y = (w[2][d] & 0xffffu) | (w[3][d] << 16); } }
}
template <bool SAMPLE>
__device__ __forceinline__ void conv_load(const bf16_t* PROJ, const float* sconv0, int rowbase, int bs, bool first_chunk, int l0, int ch0, u32x4 (&rw)[7]) {
#pragma unroll
    for (int r = 0; r < 7; ++r) { const int l = l0 - 3 + r;
        if (l >= 0 || !first_chunk) rw[r] = *(const u32x4*)(PROJ + (size_t)(rowbase + l) * NPAD + PC_XBC + ch0);
        else if (SAMPLE) { const f32x4* sp = (const f32x4*)(sconv0 + ((size_t)bs * 3 + (3 + l)) * 1024 + ch0); const f32x4 u0 = sp[0], u1 = sp[1];
            rw[r].x = cvtpk(u0.x, u0.y); rw[r].y = cvtpk(u0.z, u0.w); rw[r].z = cvtpk(u1.x, u1.y); rw[r].w = cvtpk(u1.z, u1.w); }
        else rw[r] = u32x4{0u, 0u, 0u, 0u}; }
}
__device__ __forceinline__ void conv_apply(const float* convw, const float* convb, int ch0, const u32x4 (&rw)[7], float (&ov)[4][8]) {
    float cw[4][8], cbv[8];
#pragma unroll
    for (int jj = 0; jj < 4; ++jj) { const f32x4* sp = (const f32x4*)(convw + jj * 1024 + ch0); const f32x4 u0 = sp[0], u1 = sp[1];
        cw[jj][0] = u0.x; cw[jj][1] = u0.y; cw[jj][2] = u0.z; cw[jj][3] = u0.w; cw[jj][4] = u1.x; cw[jj][5] = u1.y; cw[jj][6] = u1.z; cw[jj][7] = u1.w; }
    { const f32x4* sp = (const f32x4*)(convb + ch0); const f32x4 u0 = sp[0], u1 = sp[1];
        cbv[0] = u0.x; cbv[1] = u0.y; cbv[2] = u0.z; cbv[3] = u0.w; cbv[4] = u1.x; cbv[5] = u1.y; cbv[6] = u1.z; cbv[7] = u1.w; }
#pragma unroll
    for (int r = 0; r < 4; ++r)
#pragma unroll
        for (int k = 0; k < 8; ++k) { float t = cbv[k];
#pragma unroll
            for (int jj = 0; jj < 4; ++jj) { const unsigned w = rw[r + jj][k >> 1]; t = fmaf((k & 1) ? bf_hi(w) : bf_lo(w), cw[jj][k], t); }
            ov[r][k] = silu_f(t); }
}
constexpr int ST_BT = 0, ST_XTW = 34816, ST_F = 104448;
template <bool SAMPLE>
__device__ __forceinline__ void ssd_state_unit(unsigned char* ws, const float* alog, const float* sconv0, const float* convw, const float* convb, LAS unsigned char* lds, int bs, int c, int g) {
    int tid = threadIdx.x; asm volatile("" : "+v"(tid));
    const int wid = __builtin_amdgcn_readfirstlane(tid >> 6), lane = tid & 63, j16 = lane & 15, ig = lane >> 4;
    const int rowbase = SAMPLE ? MP + bs * DTOK : bs * SEQ + c * 128;
    constexpr int NTOK = SAMPLE ? DTOK : 128;
    const bf16_t* PROJ = (const bf16_t*)(ws + WS_PROJ);
    const bool first_chunk = SAMPLE || c == 0;
    const float* DTS = (const float*)(ws + WS_DT);
    LAS float* xwf = (LAS float*)(lds + ST_F);
    const int sidx0 = SAMPLE ? 512 + bs * 8 + 4 * g : (bs * 8 + 4 * g) * 16 + c;
    __syncthreads();
    if (wid < 4) {
        const int h = 4 * g + wid; const float a_h = -__expf(alog[h]);
        float d0 = (lane < NTOK) ? DTS[(size_t)(rowbase + lane) * 8 + h] : 0.f, d1 = (lane + 64 < NTOK) ? DTS[(size_t)(rowbase + lane + 64) * 8 + h] : 0.f;
        float c0 = d0 * a_h, c1 = d1 * a_h;
        scan128(c0, c1, lane);
        const float cs_end = __shfl(c1, 63);
        xwf[wid * 128 + lane] = d0 * __expf(cs_end - c0); xwf[wid * 128 + 64 + lane] = d1 * __expf(cs_end - c1);
        if (lane == 0) ((float*)(ws + WS_SUMDT))[sidx0 + (SAMPLE ? wid : 16 * wid)] = cs_end;
    }
    __syncthreads();
    {
        const int ccb = tid & 15, lb = 4 * (tid >> 4);
        const int hx0 = tid >> 8, cx0 = tid & 7, lx0 = 4 * ((tid & 255) >> 3);
        bf16_t* XA = (bf16_t*)(ws + WS_XA);
        u32x4 rb[7], rc[7], rx0[7], rx1[7];
        conv_load<SAMPLE>(PROJ, sconv0, rowbase, bs, first_chunk, lb, 512 + g * 128 + 8 * ccb, rb);
        conv_load<SAMPLE>(PROJ, sconv0, rowbase, bs, first_chunk, lb, 768 + g * 128 + 8 * ccb, rc);
        conv_load<SAMPLE>(PROJ, sconv0, rowbase, bs, first_chunk, lx0, (4 * g + hx0) * 64 + 8 * cx0, rx0);
        conv_load<SAMPLE>(PROJ, sconv0, rowbase, bs, first_chunk, lx0, (4 * g + hx0 + 2) * 64 + 8 * cx0, rx1);
        float ov[4][8];
        conv_apply(convw, convb, 512 + g * 128 + 8 * ccb, rb, ov);
#pragma unroll
        for (int k = 0; k < 8; ++k) { u32x2 o; o.x = cvtpk(ov[0][k], ov[1][k]); o.y = cvtpk(ov[2][k], ov[3][k]);
            *(LAS u32x2*)(lds + ST_BT + (8 * ccb + k) * SS_LD + lb * 2) = o; }
#pragma unroll
        for (int r = 0; r < 4; ++r) { u32x4 w; w.x = cvtpk(ov[r][0], ov[r][1]); w.y = cvtpk(ov[r][2], ov[r][3]); w.z = cvtpk(ov[r][4], ov[r][5]); w.w = cvtpk(ov[r][6], ov[r][7]);
            if (!SAMPLE || lb + r < NTOK) *(u32x4*)(XA + (size_t)(rowbase + lb + r) * 1024 + 512 + g * 128 + 8 * ccb) = w; }
        conv_apply(convw, convb, 768 + g * 128 + 8 * ccb, rc, ov);
#pragma unroll
        for (int r = 0; r < 4; ++r) { u32x4 w; w.x = cvtpk(ov[r][0], ov[r][1]); w.y = cvtpk(ov[r][2], ov[r][3]); w.z = cvtpk(ov[r][4], ov[r][5]); w.w = cvtpk(ov[r][6], ov[r][7]);
            if (!SAMPLE || lb + r < NTOK) *(u32x4*)(XA + (size_t)(rowbase + lb + r) * 1024 + 768 + g * 128 + 8 * ccb) = w; }
#pragma unroll
        for (int i = 0; i < 2; ++i) { const int hh = hx0 + 2 * i;
            float xw[4];
#pragma unroll
            for (int r = 0; r < 4; ++r) xw[r] = xwf[hh * 128 + lx0 + r];
            conv_apply(convw, convb, (4 * g + hh) * 64 + 8 * cx0, i ? rx1 : rx0, ov);
#pragma unroll
            for (int r = 0; r < 4; ++r) { u32x4 w; w.x = cvtpk(ov[r][0], ov[r][1]); w.y = cvtpk(ov[r][2], ov[r][3]); w.z = cvtpk(ov[r][4], ov[r][5]); w.w = cvtpk(ov[r][6], ov[r][7]);
                if (!SAMPLE || lx0 + r < NTOK) *(u32x4*)(XA + (size_t)(rowbase + lx0 + r) * 1024 + (4 * g + hh) * 64 + 8 * cx0) = w; }
#pragma unroll
            for (int k = 0; k < 8; ++k) { u32x2 o; o.x = cvtpk(ov[0][k] * xw[0], ov[1][k] * xw[1]); o.y = cvtpk(ov[2][k] * xw[2], ov[3][k] * xw[3]);
                *(LAS u32x2*)(lds + ST_XTW + (hh * 64 + 8 * cx0 + k) * SS_LD + lx0 * 2) = o; } }
    }
    __syncthreads();
    f32x4 acc[16];
#pragma unroll
    for (int q = 0; q < 16; ++q) acc[q] = f32x4{0.f, 0.f, 0.f, 0.f};
#pragma unroll
    for (int ks = 0; ks < 4; ++ks) {
        const bf16x8 bf = *(const LAS bf16x8*)(lds + ST_BT + (16 * wid + j16) * SS_LD + (32 * ks + 8 * ig) * 2);
#pragma unroll
        for (int q = 0; q < 16; ++q) { const bf16x8 af = *(const LAS bf16x8*)(lds + ST_XTW + (16 * q + j16) * SS_LD + (32 * ks + 8 * ig) * 2);
            acc[q] = __builtin_amdgcn_mfma_f32_16x16x32_bf16(bf, af, acc[q], 0, 0, 0); } }
    float* SL = (float*)(ws + WS_SLOC);
#pragma unroll
    for (int q = 0; q < 16; ++q) { const int hh = q >> 2; const size_t sidx = (size_t)sidx0 + (SAMPLE ? hh : 16 * hh);
        *(f32x4*)(SL + (sidx * 64 + (16 * (q & 3) + j16)) * 128 + 16 * wid + 4 * ig) = acc[q]; }
}

constexpr int SO_CM = 0, SO_BM = 34816, SO_XT = 69632, SO_HB = 87040, SO_XS = 104448, SO_XS_LD = 144, SO_F = 122880;
template <bool SAMPLE>
__device__ __forceinline__ void ssd_out_unit(unsigned char* ws, float* outp, const float* alog, const float* dskip, const float* ssdnw, const float* ssm0, const float* sconv0, const float* convw, const float* convb,
                                         LAS unsigned char* lds, int bs, int c, int h) {
    int tid = threadIdx.x; asm volatile("" : "+v"(tid));
    const int wid = __builtin_amdgcn_readfirstlane(tid >> 6), lane = tid & 63, j16 = lane & 15, ig = lane >> 4;
    const int g = h >> 2;
    const int rowbase = SAMPLE ? MP + bs * DTOK : bs * SEQ + c * 128;
    constexpr int NTOK = SAMPLE ? DTOK : 128;
    const float a_h = -__expf(alog[h]), D_h = dskip[h];
    const bf16_t* PROJ = (const bf16_t*)(ws + WS_PROJ);
    const bool first_chunk = SAMPLE || c == 0;
    const float* DTS = (const float*)(ws + WS_DT); const float* SL = (const float*)(ws + WS_SLOC); const float* SUMDT = (const float*)(ws + WS_SUMDT);
    LAS float* csf = (LAS float*)(lds + SO_F); LAS float* dtf = csf + 128; LAS float* facf = csf + 256;
    const int sidx = SAMPLE ? 512 + bs * 8 + h : (bs * 8 + h) * 16 + c;
    __syncthreads();
    if (wid == 0) {
        float d0 = (lane < NTOK) ? DTS[(size_t)(rowbase + lane) * 8 + h] : 0.f, d1 = (lane + 64 < NTOK) ? DTS[(size_t)(rowbase + lane + 64) * 8 + h] : 0.f;
        float c0 = d0 * a_h, c1 = d1 * a_h;
        scan128(c0, c1, lane);
        csf[lane] = c0; csf[lane + 64] = c1; dtf[lane] = d0; dtf[lane + 64] = d1;
    } else if (wid == 1 && !SAMPLE) {
        if (lane < 16) { float sacc = 0.f; for (int q = lane + 1; q < c; ++q) sacc += SUMDT[(bs * 8 + h) * 16 + q]; facf[lane] = __expf(sacc); }
    }
    __syncthreads();
    const float cs_end = csf[127];
    {
        f32x4 hp[4];
#pragma unroll
        for (int pb = 0; pb < 4; ++pb) hp[pb] = f32x4{0.f, 0.f, 0.f, 0.f};
        if (SAMPLE) {
#pragma unroll
            for (int pb = 0; pb < 4; ++pb) hp[pb] = *(const f32x4*)(ssm0 + ((size_t)(bs * 8 + h) * 64 + 16 * pb + j16) * 128 + 16 * wid + 4 * ig);
        } else {
            const float* sp0 = SL + ((size_t)(sidx - c) * 64 + j16) * 128 + 16 * wid + 4 * ig;
#pragma unroll
            for (int q = 0; q < SEQ / 128 - 1; ++q) if (q < c) { const float f = facf[q];
#pragma unroll
                for (int pb = 0; pb < 4; ++pb) hp[pb] = hp[pb] + f * *(const f32x4*)(sp0 + ((size_t)q * 64 + 16 * pb) * 128); }
        }
#pragma unroll
        for (int pb = 0; pb < 4; ++pb) { u32x2 w; w.x = cvtpk(hp[pb].x, hp[pb].y); w.y = cvtpk(hp[pb].z, hp[pb].w);
            *(LAS u32x2*)(lds + SO_HB + (16 * pb + j16) * SS_LD + (16 * wid + 4 * ig) * 2) = w; }
        if (SAMPLE || c == SEQ / 128 - 1) {
            const float dec = __expf(cs_end); const float* sp = SL + ((size_t)sidx * 64 + j16) * 128 + 16 * wid + 4 * ig;
            float* So = outp + (SAMPLE ? O_SSSM : O_PSSM) + ((size_t)(bs * 8 + h) * 64 + j16) * 128 + 16 * wid + 4 * ig;
#pragma unroll
            for (int pb = 0; pb < 4; ++pb) *(f32x4*)(So + (16 * pb) * 128) = hp[pb] * dec + *(const f32x4*)(sp + (16 * pb) * 128);
        }
    }
    {
        const bf16_t* XA = (const bf16_t*)(ws + WS_XA);
        const int cc = tid & 15, l0 = 4 * (tid >> 4), cx = tid & 7, lx = 4 * ((tid & 255) >> 3);
        u32x4 wc[4], wb[4], wx[4];
#pragma unroll
        for (int r = 0; r < 4; ++r) { const bool lv = !SAMPLE || (l0 + r) < NTOK;
            wc[r] = lv ? *(const u32x4*)(XA + (size_t)(rowbase + l0 + r) * 1024 + 768 + g * 128 + 8 * cc) : u32x4{0u, 0u, 0u, 0u};
            wb[r] = lv ? *(const u32x4*)(XA + (size_t)(rowbase + l0 + r) * 1024 + 512 + g * 128 + 8 * cc) : u32x4{0u, 0u, 0u, 0u}; }
        if (tid < 256) {
#pragma unroll
            for (int r = 0; r < 4; ++r) wx[r] = (!SAMPLE || (lx + r) < NTOK) ? *(const u32x4*)(XA + (size_t)(rowbase + lx + r) * 1024 + h * 64 + 8 * cx) : u32x4{0u, 0u, 0u, 0u}; }
#pragma unroll
        for (int r = 0; r < 4; ++r) { *(LAS u32x4*)(lds + SO_CM + (l0 + r) * SS_LD + cc * 16) = wc[r]; *(LAS u32x4*)(lds + SO_BM + (l0 + r) * SS_LD + cc * 16) = wb[r]; }
        if (tid < 256) {
            float dl[4];
#pragma unroll
            for (int r = 0; r < 4; ++r) { dl[r] = dtf[lx + r]; *(LAS u32x4*)(lds + SO_XS + (lx + r) * SO_XS_LD + cx * 16) = wx[r]; }
#pragma unroll
            for (int k = 0; k < 8; ++k) { const int d = k >> 1; float v[4];
#pragma unroll
                for (int r = 0; r < 4; ++r) v[r] = ((k & 1) ? bf_hi(wx[r][d]) : bf_lo(wx[r][d])) * dl[r];
                u32x2 o; o.x = cvtpk(v[0], v[1]); o.y = cvtpk(v[2], v[3]);
                *(LAS u32x2*)(lds + SO_XT + (8 * cx + k) * SS_LD + lx * 2) = o; }
        }
    }
    __syncthreads();
    f32x4 cb[8];
#pragma unroll
    for (int sb = 0; sb < 8; ++sb) cb[sb] = f32x4{0.f, 0.f, 0.f, 0.f};
#pragma unroll
    for (int ks = 0; ks < 4; ++ks) {
        const bf16x8 af = *(const LAS bf16x8*)(lds + SO_CM + (16 * wid + j16) * SS_LD + (32 * ks + 8 * ig) * 2);
#pragma unroll
        for (int sb = 0; sb < 8; ++sb) { const bf16x8 bf = *(const LAS bf16x8*)(lds + SO_BM + (16 * sb + j16) * SS_LD + (32 * ks + 8 * ig) * 2);
            cb[sb] = __builtin_amdgcn_mfma_f32_16x16x32_bf16(af, bf, cb[sb], 0, 0, 0); } }
    __syncthreads();
    {
        float csl[4];
#pragma unroll
        for (int r = 0; r < 4; ++r) csl[r] = csf[16 * wid + 4 * ig + r];
#pragma unroll
        for (int sb = 0; sb < 8; ++sb) { const int sx = 16 * sb + j16; const float css = csf[sx];
#pragma unroll
            for (int r = 0; r < 4; ++r) { const int l = 16 * wid + 4 * ig + r; const float gv = (sx <= l) ? cb[sb][r] * __expf(csl[r] - css) : 0.f;
                *(LAS bf16_t*)(lds + SO_BM + l * SS_LD + sx * 2) = f2bf(gv); } }
    }
    f32x4 yd[4], yo[4];
#pragma unroll
    for (int pb = 0; pb < 4; ++pb) { yd[pb] = f32x4{0.f, 0.f, 0.f, 0.f}; yo[pb] = f32x4{0.f, 0.f, 0.f, 0.f}; }
#pragma unroll
    for (int ks = 0; ks < 4; ++ks) {
        const bf16x8 ag = *(const LAS bf16x8*)(lds + SO_BM + (16 * wid + j16) * SS_LD + (32 * ks + 8 * ig) * 2);
        const bf16x8 ac = *(const LAS bf16x8*)(lds + SO_CM + (16 * wid + j16) * SS_LD + (32 * ks + 8 * ig) * 2);
#pragma unroll
        for (int pb = 0; pb < 4; ++pb) {
            const bf16x8 bx = *(const LAS bf16x8*)(lds + SO_XT + (16 * pb + j16) * SS_LD + (32 * ks + 8 * ig) * 2);
            const bf16x8 bh = *(const LAS bf16x8*)(lds + SO_HB + (16 * pb + j16) * SS_LD + (32 * ks + 8 * ig) * 2);
            yd[pb] = __builtin_amdgcn_mfma_f32_16x16x32_bf16(ag, bx, yd[pb], 0, 0, 0);
            yo[pb] = __builtin_amdgcn_mfma_f32_16x16x32_bf16(ac, bh, yo[pb], 0, 0, 0); } }
    {
        bf16_t* MIX = (bf16_t*)(ws + WS_MIX); float* SSQ = (float*)(ws + WS_SSQ);
        float gw[4];
#pragma unroll
        for (int pb = 0; pb < 4; ++pb) gw[pb] = ssdnw[h * 64 + 16 * pb + j16];
#pragma unroll
        for (int r = 0; r < 4; ++r) { const int l = 16 * wid + 4 * ig + r; const float el = __expf(csf[l]); float sq = 0.f;
            const bool live = l < NTOK; const size_t grow = (size_t)(rowbase + l);
#pragma unroll
            for (int pb = 0; pb < 4; ++pb) { const int pp = 16 * pb + j16;
                const float xv = bf2f(*(const LAS bf16_t*)(lds + SO_XS + l * SO_XS_LD + pp * 2));
                float y = yd[pb][r] + el * yo[pb][r] + D_h * xv;
                if (live) { const float zv = bf2f(PROJ[grow * NPAD + PC_Z + h * 64 + pp]); y *= silu_f(zv); MIX[grow * 2048 + h * 64 + pp] = f2bf(y * gw[pb]); sq += y * y; } }
            sq = group16_sum(sq);
            if (live && j16 == 0) SSQ[grow * 8 + h] = sq; }
    }
}

constexpr int U_SSDP = NBATCH * 16 * 2, U_SSDSS = DSEQ * 2, U_SB = NBATCH * 8 * 16, U_MEMP = NBATCH * 16 * 4, U_MEMS = DSEQ * 4;
#ifndef PROBE_BLK
#define PROBE_BLK 0
#endif
#define PSTAMP(i) do { if (PROBE_SEG >= 20 && blockIdx.x == PROBE_BLK && threadIdx.x == 0) ((volatile LAS unsigned long long*)(ctlw + 32))[8 + (i)] = __builtin_amdgcn_s_memrealtime(); } while (0)
#define QUEUE_LOOP(qi, total, ...) for (;;) { __syncthreads(); if (threadIdx.x == 0) ctlw[16] = __hip_atomic_fetch_add(qbase + 64 * (qi), 1u, __ATOMIC_RELAXED, __HIP_MEMORY_SCOPE_AGENT); \
        __syncthreads(); const int u = (int)ctlw[16]; if (u >= (total)) break; __VA_ARGS__ }
#define GROUP_LOOP(qi, total, ...) for (int gi_ = 0;; ++gi_) { if (threadIdx.x == 0) ctlw[22 + (gi_ & 1)] = __hip_atomic_fetch_add(qbase + 64 * (qi), 1u, __ATOMIC_RELAXED, __HIP_MEMORY_SCOPE_AGENT); \
        group_bar(gb, lane); const int u = (int)ctlw[22 + (gi_ & 1)]; if (u >= (total)) break; __VA_ARGS__ }
template <int MASK> __device__ __forceinline__ void phase3(const Params& p, LAS unsigned char* lds, volatile LAS unsigned* ctlw, int qset) {
    unsigned* qbase = (unsigned*)(p.ws + WS_CTL) + CW_QUEUE + 1024 * qset;
    const bf16_t* PROJ = (const bf16_t*)(p.ws + WS_PROJ);
    bf16_t* MIX = (bf16_t*)(p.ws + WS_MIX);
    PSTAMP(4);
    QUEUE_LOOP(0, U_SSDP, { ssd_state_unit<false>(p.ws, p.in[I_ALOG], p.in[I_SCONV], p.in[I_CONVW], p.in[I_CONVB], lds, u >> 5, (u >> 1) & 15, u & 1); })
    QUEUE_LOOP(4, U_SSDSS, { ssd_state_unit<true>(p.ws, p.in[I_ALOG], p.in[I_SCONV], p.in[I_CONVW], p.in[I_CONVB], lds, u >> 1, 0, u & 1); })
    PSTAMP(5);
    const unsigned gb0 = __builtin_amdgcn_readfirstlane(ctlw[20]);
    __syncthreads();
    {
        int tid = threadIdx.x; asm volatile("" : "+v"(tid));
        const int wid = __builtin_amdgcn_readfirstlane(tid >> 6), lane = tid & 63;
        if (wid < 4) {
            GroupBar gb; gb.cnt = ctlw + 20; gb.gen = gb0;
            __builtin_amdgcn_s_setprio(1);
            GROUP_LOOP(2, U_SB, {
                const int i = 15 - (u >> 5), bh = u & 31, b = bh >> 3, h = bh & 7;
                attn_unit<0>(lds, gb, PROJ + (size_t)(b * SEQ + i * 128) * NPAD + PC_Q + h * 128, NPAD,
                             PROJ + (size_t)(b * SEQ) * NPAD + PC_K + h * 128, PROJ + (size_t)(b * SEQ) * NPAD + PC_V + h * 128, NPAD,
                             2 * (i + 1), i * 128, 128, p.in[I_SBBIAS][h] * LOG2E,
                             PROJ + (size_t)(b * SEQ + i * 128) * NPAD + PC_GSB + h * 128, NPAD, MIX + (size_t)(b * SEQ + i * 128) * 2048 + 512 + h * 128, 2048); })
            PSTAMP(6);
            GROUP_LOOP(3, U_MEMP + U_MEMS, {
                if (u < U_MEMP) { const int hm = u & 3, qb = (u >> 2) & 15, b = u >> 6; const size_t r0 = (size_t)(b * SEQ + qb * 128);
                    attn_unit<1>(lds, gb, PROJ + r0 * NPAD + PC_MQ + hm * 128, NPAD, (const bf16_t*)(p.ws + WS_MKN) + (size_t)(b * MEMT) * 512 + hm * 128, (const bf16_t*)(p.ws + WS_MVB) + (size_t)(b * MEMT) * 512 + hm * 128, 512,
                                 4, 0, 128, 0.f, PROJ + r0 * NPAD + PC_GM + hm * 128, NPAD, MIX + r0 * 2048 + 1536 + hm * 128, 2048); }
                else { const int v = u - U_MEMP, hm = v & 3, sq = v >> 2; const size_t r0 = (size_t)(MP + sq * DTOK);
                    attn_unit<1>(lds, gb, PROJ + r0 * NPAD + PC_MQ + hm * 128, NPAD, (const bf16_t*)(p.ws + WS_CMK) + (size_t)(sq * MEMT) * 512 + hm * 128, (const bf16_t*)(p.ws + WS_CMV) + (size_t)(sq * MEMT) * 512 + hm * 128, 512,
                                 4, 0, DTOK, 0.f, PROJ + r0 * NPAD + PC_GM + hm * 128, NPAD, MIX + r0 * 2048 + 1536 + hm * 128, 2048); } })
            group_bar(gb, lane);
            __builtin_amdgcn_s_setprio(0);
            PSTAMP(7);
        }
        LAS unsigned char* wlds = lds + (wid < 4 ? wid * 19456 : 77824 + (wid - 4) * 19456);
        decode_wave_loop((const int*)p.in[I_PT], p.in[I_CK], p.in[I_CV], p.in[I_SBBIAS], p.ws, wlds, qbase + 64 * 1, lane);
    }
    __syncthreads();
    PSTAMP(8);
}

__device__ __forceinline__ void phase4(const Params& p, LAS unsigned char* lds, volatile LAS unsigned* ctlw, int vcu, int G, int qset) {
    const int tid = threadIdx.x, lane = tid & 63, wave = __builtin_amdgcn_readfirstlane(tid >> 6);
    bf16_t* MIX = (bf16_t*)(p.ws + WS_MIX);
    const bf16_t* PROJ = (const bf16_t*)(p.ws + WS_PROJ);
    unsigned* qbase = (unsigned*)(p.ws + WS_CTL) + CW_QUEUE + 1024 * qset;
    PSTAMP(2);
    for (int u = G - 1 - (int)blockIdx.x; u < DSEQ * 8; u += G) {
        const int seq = u >> 3, head = u & 7, i = wave;
        const int row = MP + seq * DTOK + i;
        const float bias2 = p.in[I_SBBIAS][head] * LOG2E;
        const unsigned qw = *(const unsigned*)(PROJ + (size_t)row * NPAD + PC_Q + head * 128 + 2 * lane);
        const float q0 = bf_lo(qw), q1 = bf_hi(qw);
        float acc0 = 0.f, acc1 = 0.f, R = 1.f;
        for (int j = DTOK - 1; j >= 0; --j) {
            const f32x2 kv = *(const f32x2*)(p.out + O_SK + (size_t)(seq * DTOK + j) * 1024 + head * 128 + 2 * lane);
            const float kb0 = bf2f(f2bf(kv.x)), kb1 = bf2f(f2bf(kv.y));
            const float z = fmaxf(wave_sum(q0 * kb0 + q1 * kb1) + bias2, -100.f);
            if (j < i) {
                const float e = fast_exp2(-z), rc = fast_rcp(1.f + e);
                const f32x2 vv = *(const f32x2*)(p.out + O_SV + (size_t)(seq * DTOK + j) * 1024 + head * 128 + 2 * lane);
                const float w = rc * R; acc0 += w * vv.x; acc1 += w * vv.y; R *= e * rc;
            }
        }
        const float* Op = (const float*)(p.ws + WS_OPART) + (size_t)((seq * 8 + head) * NPAGES) * (DTOK * 128) + i * 128 + 2 * lane;
        const float* Fp = (const float*)(p.ws + WS_FPART) + (size_t)((seq * 8 + head) * NPAGES) * DTOK + i;
        const int pg_lo = decode_skip_old_pages<false>((const float*)(p.ws + WS_FPART), seq, head, lane) ? L0_FIRST : 0;
        for (int pg0 = NPAGES - 16; pg0 >= pg_lo; pg0 -= 16) {
            f32x2 ov[16]; float fv[16];
#pragma unroll
            for (int q = 0; q < 16; ++q) { ov[q] = *(const f32x2*)(Op + (size_t)(pg0 + q) * (DTOK * 128)); fv[q] = Fp[(size_t)(pg0 + q) * DTOK]; }
#pragma unroll
            for (int q = 15; q >= 0; --q) { acc0 += R * ov[q].x; acc1 += R * ov[q].y; R *= fv[q]; }
        }
        const unsigned gwd = *(const unsigned*)(PROJ + (size_t)row * NPAD + PC_GSB + head * 128 + 2 * lane);
        *(unsigned*)(MIX + (size_t)row * 2048 + 512 + head * 128 + 2 * lane) = cvtpk(acc0 * silu_f(bf_lo(gwd)), acc1 * silu_f(bf_hi(gwd)));
    }
    PSTAMP(3);
    PSTAMP(0);
    QUEUE_LOOP(5, NBATCH * 16 * 8, { const int v = NBATCH * 16 * 8 - 1 - u;
        ssd_out_unit<false>(p.ws, p.out, p.in[I_ALOG], p.in[I_DSKIP], p.in[I_SSDNW], p.in[I_SSM], p.in[I_SCONV], p.in[I_CONVW], p.in[I_CONVB], lds, (v >> 3) & 3, v >> 5, v & 7); })
    PSTAMP(1);
    QUEUE_LOOP(6, DSEQ * 8, { ssd_out_unit<true>(p.ws, p.out, p.in[I_ALOG], p.in[I_DSKIP], p.in[I_SSDNW], p.in[I_SSM], p.in[I_SCONV], p.in[I_CONVW], p.in[I_CONVB], lds, u >> 3, 0, u & 7); })
}

struct Epi5 {
    static constexpr int MID = 8;
    const float* xp; float* out; const float* SSQ;
    __device__ __forceinline__ void mid(pg8::Acc& acc, const pg8::Unit& u, int wr, int fr) const {
        int rl0 = wr * 64 + fr; asm volatile("" : "+v"(rl0));
#pragma unroll
        for (int ai = 0; ai < 2; ++ai)
#pragma unroll
            for (int m = 0; m < 4; ++m) { const size_t row = (size_t)u.pm * 256 + rl0 + ai * 128 + m * 16;
                const f32x4 s0 = *(const f32x4*)(SSQ + row * 8), s1 = *(const f32x4*)(SSQ + row * 8 + 4);
                const float rs = 1.f / sqrtf((((s0.x + s0.y) + (s0.z + s0.w)) + ((s1.x + s1.y) + (s1.z + s1.w))) * (1.f / 512.f) + EPS);
#pragma unroll
                for (int bj = 0; bj < 2; ++bj)
#pragma unroll
                    for (int n = 0; n < 2; ++n) acc[ai][bj][m][n] = acc[ai][bj][m][n] * rs; }
    }
    __device__ __forceinline__ void operator()(pg8::Acc& acc, const pg8::Unit& u, int wr, int wc, int fr, int fq) const {
        int rl0 = wr * 64 + fr, cl0 = u.pn * 256 + wc * 32 + 4 * fq;
        asm volatile("" : "+v"(rl0), "+v"(cl0));
        const float* xb = xp + (size_t)u.pm * 256 * DM; float* ob = out + O_YP + (size_t)u.pm * 256 * DM;
#pragma unroll
        for (int ai = 0; ai < 2; ++ai)
#pragma unroll
            for (int m = 0; m < 4; ++m) { const int row = rl0 + ai * 128 + m * 16; const float* xr = xb + (size_t)row * DM + cl0; float* orow = ob + (size_t)row * DM + cl0;
#pragma unroll
                for (int bj = 0; bj < 2; ++bj)
#pragma unroll
                    for (int n = 0; n < 2; ++n) *(f32x4*)(orow + bj * 128 + n * 16) = *(const f32x4*)(xr + bj * 128 + n * 16) + acc[ai][bj][m][n]; }
    }
};
__device__ __forceinline__ void sample_outproj(const Params& p, LAS unsigned char* lds, int c) {
    int tid = threadIdx.x; asm volatile("" : "+v"(tid));
    const int wid = __builtin_amdgcn_readfirstlane(tid >> 6), lane = tid & 63, j16 = lane & 15, ig = lane >> 4;
    const bf16_t* MIX = (const bf16_t*)(p.ws + WS_MIX) + (size_t)MP * 2048; const bf16_t* WT = (const bf16_t*)(p.ws + WS_WOUT) + (size_t)(16 * c) * 2048;
    const float* SSQ = (const float*)(p.ws + WS_SSQ) + (size_t)MP * 8;
    f32x4 acc[4];
#pragma unroll
    for (int rb = 0; rb < 4; ++rb) acc[rb] = f32x4{0.f, 0.f, 0.f, 0.f};
#pragma unroll
    for (int ks = 0; ks < 8; ++ks) { const int k = 256 * wid + 32 * ks + 8 * ig;
        const bf16x8 bf = *(const bf16x8*)(WT + (size_t)j16 * 2048 + k);
#pragma unroll
        for (int rb = 0; rb < 4; ++rb) { const bf16x8 af = *(const bf16x8*)(MIX + (size_t)(16 * rb + j16) * 2048 + k);
            acc[rb] = __builtin_amdgcn_mfma_f32_16x16x32_bf16(af, bf, acc[rb], 0, 0, 0); } }
    if (wid < 2) {
#pragma unroll
        for (int rb = 0; rb < 4; ++rb)
#pragma unroll
            for (int r = 0; r < 4; ++r) { const int row = 16 * rb + 4 * ig + r; const f32x4 s0 = *(const f32x4*)(SSQ + row * 8), s1 = *(const f32x4*)(SSQ + row * 8 + 4);
                acc[rb][r] *= 1.f / sqrtf((((s0.x + s0.y) + (s0.z + s0.w)) + ((s1.x + s1.y) + (s1.z + s1.w))) * (1.f / 512.f) + EPS); }
    }
    __syncthreads();
    LAS float* red = (LAS float*)lds;
#pragma unroll
    for (int rb = 0; rb < 4; ++rb)
#pragma unroll
        for (int r = 0; r < 4; ++r) red[(wid * 64 + 16 * rb + 4 * ig + r) * 16 + j16] = acc[rb][r];
    __syncthreads();
#pragma unroll
    for (int i = 0; i < 2; ++i) { const int e = tid + 512 * i, row = e >> 4, col = e & 15; float v = 0.f;
#pragma unroll
        for (int w = 0; w < 8; ++w) v += red[(w * 64 + row) * 16 + col];
        p.out[O_YS + (size_t)row * DM + 16 * c + col] = p.in[I_XS][(size_t)row * DM + 16 * c + col] + v; }
}

__device__ __forceinline__ void probe_flush(const Params& p, int vcu, int G) {
    const f32x4* src = (const f32x4*)p.in[I_CK]; const size_t n16 = (size_t)40 * 1024 * 1024; f32x4 a = f32x4{0.f, 0.f, 0.f, 0.f};
    for (size_t i = (size_t)vcu * 512 + threadIdx.x; i < n16; i += (size_t)G * 512) a = a + __builtin_nontemporal_load(src + i);
    if (a.x + a.y + a.z + a.w == 1.2345e-30f) ((float*)(p.ws + WS_CTL))[2048] = a.x;
}
constexpr int NPHASE = 6;
__global__ void __launch_bounds__(512, 2) hymba_fwd(Params p) {
    extern __shared__ __attribute__((aligned(16))) unsigned char lds_raw[];
    LAS unsigned char* lds = (LAS unsigned char*)lds_raw;
    const int tid = threadIdx.x;
    const int G = gridDim.x; const int bx = blockIdx.x; const int vcu = (G % 8 == 0) ? (bx % 8) * (G / 8) + bx / 8 : bx;
    volatile LAS unsigned* ctlw = (volatile LAS unsigned*)(lds + LDS_CTLW);
    if (tid < 128) ctlw[tid] = 0u;
    __syncthreads();
    unsigned* ctl = (unsigned*)(p.ws + WS_CTL);
    const int lo = p.ph_lo, hi = p.ph_hi;
    XcdBarrier bar; bar.bar = ctl + CW_BAR; bar.x = 0; bar.st = nullptr;
    if (hi - lo > 1) bar = xcd_barrier_post(ctl + CW_BAR, ctlw + 8);
    volatile LAS unsigned long long* tst = (volatile LAS unsigned long long*)(ctlw + 32); volatile LAS unsigned long long* tarr = tst + 32; int nst = 0, nbar = 0;
#define STAMP() do { if (PROBE_SEG >= 0 && bx == 0 && tid == 0) { tst[nst] = __builtin_amdgcn_s_memrealtime(); } ++nst; } while (0)
#define GBAR() do { if (PROBE_SEG >= 0) { if (tid == 0) __hip_atomic_fetch_max((unsigned long long*)(ctl + 200000) + 8 * nbar, (unsigned long long)__builtin_amdgcn_s_memrealtime(), __ATOMIC_RELAXED, __HIP_MEMORY_SCOPE_AGENT); } \
        xcd_barrier(bar); if (PROBE_SEG >= 0 && bx == 0 && tid == 0) tarr[nbar] = __hip_atomic_load((unsigned long long*)(ctl + 200000) + 8 * nbar, __ATOMIC_RELAXED, __HIP_MEMORY_SCOPE_AGENT); ++nbar; } while (0)
    STAMP();
#define IN(k) (lo <= (k) && (k) < hi)
#define BOTH(k) (IN(k) && IN((k) + 1))
    if (IN(0)) { phase0(p, lds, vcu, G, ctlw); if (BOTH(0)) GBAR(); STAMP(); }
    if (PROBE_DUP == 0) { phase0(p, lds, vcu, G, ctlw); xcd_barrier(bar); }
    if (PROBE_DUP == 100) { probe_flush(p, vcu, G); xcd_barrier(bar); }
    if (PROBE_DUP == 101) { probe_flush(p, vcu, G); xcd_barrier(bar); phase0(p, lds, vcu, G, ctlw); xcd_barrier(bar); }
    if (PROBE_DUP == 99) { for (int q = 0; q < 8; ++q) xcd_barrier(bar); }
    if (PROBE_DUP == 97) { for (int q = 0; q < 8; ++q) { __syncthreads(); if (threadIdx.x == 0) { const unsigned g = ctlw[12] + 1u; ctlw[12] = g; xb_add(&(ctl + CW_BAR + 4096)[XB_TOP], 1u); const unsigned target = g * gridDim.x; XB_SPIN(xb_ld(&(ctl + CW_BAR + 4096)[XB_TOP]) < target, (ctl + CW_BAR + 4096)); } __syncthreads(); } }
    if (PROBE_DUP == 96) { for (int q = 0; q < 8; ++q) { __syncthreads(); if (threadIdx.x == 0) { __builtin_amdgcn_fence(__ATOMIC_RELEASE, "agent"); asm volatile("s_waitcnt vmcnt(0)" ::: "memory"); __builtin_amdgcn_fence(__ATOMIC_ACQUIRE, "agent"); asm volatile("s_waitcnt vmcnt(0)" ::: "memory"); } __syncthreads(); } }
    if (PROBE_DUP == 95) { unsigned acc_ = 0; for (int q = 0; q < 64; ++q) { __syncthreads(); if (threadIdx.x == 0) acc_ += xb_add(&(ctl + 65536)[64 * blockIdx.x], 1u); __syncthreads(); } if (acc_ == 0xdeadbeefu) ctl[3] = acc_; }
    if (PROBE_DUP == 94) { unsigned acc_ = 0; for (int q = 0; q < 64; ++q) { __syncthreads(); if (threadIdx.x == 0) acc_ += xb_add(&(ctl + 65536)[0], 1u); __syncthreads(); } if (acc_ == 0xdeadbeefu) ctl[3] = acc_; }
    if (PROBE_DUP == 93) { unsigned acc_ = 0; for (int q = 0; q < 64; ++q) { __syncthreads(); if (threadIdx.x == 0) acc_ += xb_ld(&(ctl + 65536)[0]); __syncthreads(); } if (acc_ == 0xdeadbeefu) ctl[3] = acc_; }
    if (PROBE_DUP == 92) { for (int q = 0; q < 16; ++q) { __syncthreads(); if (threadIdx.x == 0) { __builtin_amdgcn_fence(__ATOMIC_ACQUIRE, "agent"); asm volatile("s_waitcnt vmcnt(0)" ::: "memory"); } __syncthreads(); } }
    if (PROBE_DUP == 91) { for (int q = 0; q < 16; ++q) { __syncthreads(); if (threadIdx.x == 0) { __builtin_amdgcn_fence(__ATOMIC_RELEASE, "agent"); asm volatile("s_waitcnt vmcnt(0)" ::: "memory"); } __syncthreads(); } }
    if (PROBE_DUP == 90) { for (int q = 0; q < 8; ++q) xcd_barrier_probe<0>(bar); }
    if (PROBE_DUP == 89) { for (int q = 0; q < 8; ++q) xcd_barrier_probe<1>(bar); }
    if (PROBE_DUP == 88) { XcdBarrier2 b2 = xcd_barrier2_post(ctl + 131072, ctlw + 20); for (int q = 0; q < 8; ++q) xcd_barrier2(b2); }
    if (PROBE_DUP == 98) { for (int q = 0; q < 8; ++q) flat_barrier(ctl + CW_BAR + 4096, ctlw + 12); }
    if (IN(1)) {
        pg8::Gemm g{(const bf16_t*)(p.ws + WS_H), (const bf16_t*)(p.ws + WS_WIN), (const bf16_t*)(p.ws + WS_HM), (const bf16_t*)(p.ws + WS_WM), DM};
        pg8::Order S; S.init(MROWS / 256, NPAD / 256, MMEM / 256, 1024 / 256, G, bx);
        Epi1 E{(bf16_t*)(p.ws + WS_PROJ), (float*)(p.ws + WS_DT), p.out, p.in[I_DTBIAS], p.in[I_QNORM], p.in[I_KNORM], p.in[I_MQNORM], p.in[I_MKNORM], (bf16_t*)(p.ws + WS_MKN), (bf16_t*)(p.ws + WS_MVB), (LAS float*)(lds + RING_BYTES)};
        pg8::gemm_phase<Epi1>(lds, g, S, E);
        if (BOTH(1)) GBAR(); STAMP();
        if (PROBE_DUP == 1) { pg8::gemm_phase<Epi1>(lds, g, S, E); xcd_barrier(bar); }
    }
    if (IN(3)) { phase3<31>(p, lds, ctlw, 0); if (BOTH(3)) GBAR(); STAMP(); }
    if (PROBE_DUP >= 30) { phase3<31>(p, lds, ctlw, 1); xcd_barrier(bar); }
    if (IN(4)) { phase4(p, lds, ctlw, vcu, G, 0); if (BOTH(4)) GBAR(); STAMP(); }
    if (PROBE_DUP == 4) { phase4(p, lds, ctlw, vcu, G, 1); xcd_barrier(bar); }
    if (IN(5)) {
        pg8::Gemm g{(const bf16_t*)(p.ws + WS_MIX), (const bf16_t*)(p.ws + WS_WOUT), nullptr, nullptr, DM};
        pg8::Order S; S.init(MP / 256, DM / 256, 0, 1, G, bx);
        Epi5 E{p.in[I_XP], p.out, (const float*)(p.ws + WS_SSQ)};
        PSTAMP0(4);
        pg8::gemm_phase<Epi5>(lds, g, S, E);
        PSTAMP0(5);
        if (bx < 128) sample_outproj(p, lds, bx);
        PSTAMP0(6);
        STAMP();
        if (PROBE_DUP == 5) { xcd_barrier(bar); pg8::gemm_phase<Epi5>(lds, g, S, E); if (bx < 128) sample_outproj(p, lds, bx); }
    }
    if (PROBE_SEG >= 0 && bx == ((PROBE_SEG >= 20 && PROBE_SEG < 30) ? PROBE_BLK : 0) && tid == 0) {
        unsigned long long iv = 0;
        if (PROBE_SEG == 29) iv = tst[8 + 9] - tst[8 + 5];
        else if (PROBE_SEG == 28) iv = tst[8 + 6] - tst[8 + 9];
        else if (PROBE_SEG >= 40) iv = tst[20 + PROBE_SEG - 40 + 1] - tst[20 + PROBE_SEG - 40];
        else if (PROBE_SEG == 30) iv = tst[9] - tst[8];
        else if (PROBE_SEG >= 20) iv = tst[8 + PROBE_SEG - 20 + 1] - tst[8 + PROBE_SEG - 20];
        else if (PROBE_SEG < 10) iv = tst[PROBE_SEG + 1] - tst[PROBE_SEG];
        else iv = tst[PROBE_SEG - 10 + 1] - tarr[PROBE_SEG - 10];
        const unsigned long long t0 = __builtin_amdgcn_s_memrealtime();
        while (__builtin_amdgcn_s_memrealtime() - t0 < 8ull * iv) __builtin_amdgcn_s_sleep(8);
    }
    if (PROBE_DUP == 200) {
        xcd_barrier(bar);
        phase0(p, lds, vcu, G, ctlw); xcd_barrier(bar);
        { pg8::Gemm g{(const bf16_t*)(p.ws + WS_H), (const bf16_t*)(p.ws + WS_WIN), (const bf16_t*)(p.ws + WS_HM), (const bf16_t*)(p.ws + WS_WM), DM};
          pg8::Order S; S.init(MROWS / 256, NPAD / 256, MMEM / 256, 1024 / 256, G, bx);
          Epi1 E{(bf16_t*)(p.ws + WS_PROJ), (float*)(p.ws + WS_DT), p.out, p.in[I_DTBIAS], p.in[I_QNORM], p.in[I_KNORM], p.in[I_MQNORM], p.in[I_MKNORM], (bf16_t*)(p.ws + WS_MKN), (bf16_t*)(p.ws + WS_MVB), (LAS float*)(lds + RING_BYTES)};
          pg8::gemm_phase<Epi1>(lds, g, S, E); xcd_barrier(bar); }
        phase3<31>(p, lds, ctlw, 1); xcd_barrier(bar);
        phase4(p, lds, ctlw, vcu, G, 1); xcd_barrier(bar);
        { pg8::Gemm g{(const bf16_t*)(p.ws + WS_MIX), (const bf16_t*)(p.ws + WS_WOUT), nullptr, nullptr, DM};
          pg8::Order S; S.init(MP / 256, DM / 256, 0, 1, G, bx);
          Epi5 E{p.in[I_XP], p.out, (const float*)(p.ws + WS_SSQ)};
          pg8::gemm_phase<Epi5>(lds, g, S, E);
          if (bx < 128) sample_outproj(p, lds, bx); }
    }
#undef IN
#undef BOTH
}

extern "C" void kernel_launch(void* const* d_in, const int* in_sizes, int n_in, void* d_out, int out_size, void* d_ws, size_t ws_size, hipStream_t stream) {
    static int grid = 0;
    if (grid == 0) {
        if (n_in != 26 || ws_size < WS_END) { fprintf(stderr, "kernel_launch: unexpected n_in %d / ws %zu\n", n_in, ws_size); grid = -1; return; }
        int dev = 0, cus = 0, per_cu = 0;
        if (hipGetDevice(&dev) != hipSuccess || hipDeviceGetAttribute(&cus, hipDeviceAttributeMultiprocessorCount, dev) != hipSuccess) { grid = -1; return; }
        if (hipFuncSetAttribute((const void*)hymba_fwd, hipFuncAttributeMaxDynamicSharedMemorySize, LDS_BYTES) != hipSuccess) { fprintf(stderr, "kernel_launch: hipFuncSetAttribute failed\n"); grid = -1; return; }
        if (hipOccupancyMaxActiveBlocksPerMultiprocessor(&per_cu, (const void*)hymba_fwd, 512, LDS_BYTES) != hipSuccess || per_cu < 1) fprintf(stderr, "kernel_launch: occupancy query says %d\n", per_cu);
        (void)hipGetLastError();
        grid = cus;
    }
    if (grid < 0) return;
    (void)hipMemsetAsync((char*)d_ws + WS_CTL, 0, CTL_BYTES, stream);
    Params p{};
    for (int i = 0; i < 26; ++i) p.in[i] = (const float*)d_in[i];
    p.out = (float*)d_out; p.ws = (unsigned char*)d_ws;
    if (MK_N_LAUNCHES == 1) { p.ph_lo = 0; p.ph_hi = NPHASE; hipLaunchKernelGGL(hymba_fwd, dim3(grid), dim3(512), LDS_BYTES, stream, p); }
    else for (int ph = 0; ph < NPHASE; ++ph) { p.ph_lo = ph; p.ph_hi = ph + 1; hipLaunchKernelGGL(hymba_fwd, dim3(grid), dim3(512), LDS_BYTES, stream, p); }
    const hipError_t le = hipPeekAtLastError();
    if (le != hipSuccess) fprintf(stderr, "kernel_launch: launch failed: %s\n", hipGetErrorName(le));
}
```

```cpp
#include <hip/hip_runtime.h>
#include <cstdio>
#include <cstdint>

#ifndef PROBE_DUP
#define PROBE_DUP -1
#endif
#ifndef PROBE_SEG
#define PROBE_SEG -1
#endif
#ifndef MK_N_LAUNCHES
#define MK_N_LAUNCHES 1
#endif

constexpr int DM = 2048, NBATCH = 4, SEQ = 2048, MP = NBATCH * SEQ;
constexpr int DSEQ = 8, DTOK = 8, MS = DSEQ * DTOK;
constexpr int MVALID = MP + MS, MROWS = 8448;
constexpr int NIN = 6664, NPAD = 6912;
constexpr int MEMT = 256, MMEM = NBATCH * MEMT;
constexpr int NPAGES = 128, PAGE = 128, PAST = NPAGES * PAGE;
constexpr float EPS = 1e-6f;
constexpr float LOG2E = 1.4426950408889634f;
constexpr float QSCALE = 0.08838834764831845f * LOG2E;

constexpr size_t O_YP = 0, O_YS = 16777216, O_PK = 16908288, O_PV = 25296896, O_PSSM = 33685504, O_PCONV = 33947648,
                 O_PMK = 33959936, O_PMV = 34484224, O_SK = 35008512, O_SV = 35074048, O_SSSM = 35139584, O_SCONV = 35663872;

constexpr size_t MiB = 1u << 20;
constexpr size_t WS_CTL = 0, CTL_BYTES = 1 * MiB;
constexpr size_t WS_WIN = 2 * MiB;
constexpr size_t WS_WM = 32 * MiB;
constexpr size_t WS_WOUT = 38 * MiB;
constexpr size_t WS_H = 48 * MiB;
constexpr size_t WS_HM = 84 * MiB;
constexpr size_t WS_PROJ = 90 * MiB;
constexpr int PC_Q = 0, PC_K = 1024, PC_V = 2048, PC_GSB = 3072, PC_Z = 4096, PC_XBC = 4608, PC_MQ = 5632, PC_GM = 6144;
constexpr size_t WS_DT = 210 * MiB;
constexpr size_t WS_MKN = 211 * MiB;
constexpr size_t WS_MVB = 213 * MiB;
constexpr size_t WS_CMK = 215 * MiB;
constexpr size_t WS_CMV = 218 * MiB;
constexpr size_t WS_SSQ = 221 * MiB;
constexpr size_t WS_FPART = 222 * MiB;
constexpr size_t WS_MIX = 224 * MiB;
constexpr size_t WS_YZ = 260 * MiB;
constexpr size_t WS_OPART = 280 * MiB;
constexpr size_t WS_XA = 316 * MiB;
constexpr size_t WS_SLOC = 334 * MiB;
constexpr size_t WS_SUMDT = 354 * MiB;
constexpr size_t WS_END = 355 * MiB;

constexpr int CW_BAR = 4096;
constexpr int CW_QUEUE = 64;

constexpr int LDS_BYTES = 163840;
constexpr int RING_BYTES = 131072;
constexpr int LDS_CTLW = LDS_BYTES - 512;

#define LAS __attribute__((address_space(3)))
typedef unsigned short bf16_t;
typedef short bf16x8 __attribute__((ext_vector_type(8)));
typedef short s16x4 __attribute__((ext_vector_type(4)));
typedef float f32x2 __attribute__((ext_vector_type(2)));
typedef float f32x4 __attribute__((ext_vector_type(4)));
typedef float f32x16 __attribute__((ext_vector_type(16)));
typedef unsigned u32x2 __attribute__((ext_vector_type(2)));
typedef unsigned u32x4 __attribute__((ext_vector_type(4)));

__device__ __forceinline__ unsigned cvtpk(float lo, float hi) { unsigned r; asm volatile("v_cvt_pk_bf16_f32 %0, %1, %2" : "=v"(r) : "v"(lo), "v"(hi)); return r; }
__device__ __forceinline__ float bf_lo(unsigned w) { return __uint_as_float(w << 16); }
__device__ __forceinline__ float bf_hi(unsigned w) { return __uint_as_float(w & 0xffff0000u); }
__device__ __forceinline__ float bf2f(bf16_t b) { return __uint_as_float(((unsigned)b) << 16); }
__device__ __forceinline__ bf16_t f2bf(float f) { return (bf16_t)(cvtpk(f, 0.f) & 0xffffu); }
__device__ __forceinline__ float wave_sum(float v) {
#pragma unroll
    for (int o = 1; o < 64; o <<= 1) v += __shfl_xor(v, o);
    return v;
}
__device__ __forceinline__ float fast_exp2(float x) { return __builtin_amdgcn_exp2f(x); }
__device__ __forceinline__ float fast_rcp(float x) { return __builtin_amdgcn_rcpf(x); }
__device__ __forceinline__ float silu_f(float x) { return x * fast_rcp(1.f + fast_exp2(-x * LOG2E)); }

#define XB_TMO      128
#define XB_XCNT(j)  (256  + 64 * (j))
#define XB_XSUB(j)  (1280 + 64 * (j))
#define XB_XGEN(j)  (2304 + 64 * (j))
#define XB_TOP      3328
#define XB_TOPGEN   3392
#define XCD_BAR_WORDS 3456
#define XB_SPIN_CAP (1u << 18)
#ifndef XB_SLEEP
#define XB_SLEEP 1
#endif

__device__ __forceinline__ unsigned xb_ld(unsigned* p)              { return __hip_atomic_load(p, __ATOMIC_RELAXED, __HIP_MEMORY_SCOPE_AGENT); }
__device__ __forceinline__ unsigned xb_add(unsigned* p, unsigned v) { return __hip_atomic_fetch_add(p, v, __ATOMIC_RELAXED, __HIP_MEMORY_SCOPE_AGENT); }
__device__ __forceinline__ unsigned xb_xcc_id() { return (unsigned)__builtin_amdgcn_s_getreg((3 << 11) | 20) & 0xFu; }
#define XB_SPIN(cond, bar) do { unsigned _sp = 0; while (cond) { __builtin_amdgcn_s_sleep(XB_SLEEP); \
    if ((++_sp & 255u) == 0u) { if (xb_ld(&(bar)[XB_TMO])) break; if (_sp > XB_SPIN_CAP) { atomicAdd(&(bar)[XB_TMO], 1u); break; } } } } while (0)

struct XcdBarrier { unsigned* bar; unsigned x; volatile LAS unsigned* st; };

__device__ __forceinline__ XcdBarrier xcd_barrier_post(unsigned* bar, volatile LAS unsigned* st) {
    XcdBarrier b; b.bar = bar; b.x = xb_xcc_id(); b.st = st;
    if (threadIdx.x == 0) (void)xb_add(&bar[XB_XCNT(b.x)], 1u);
    return b;
}
__device__ __forceinline__ void xcd_barrier_complete(unsigned* bar, unsigned x, unsigned& nloc, unsigned& nx) {
    const unsigned G = gridDim.x * gridDim.y * gridDim.z;
    unsigned sum, cnt, mine, sp = 0u;
    for (;;) {
        sum = 0u; cnt = 0u; mine = 0u;
#pragma unroll
        for (unsigned j = 0; j < 16; ++j) { const unsigned c = xb_ld(&bar[XB_XCNT(j)]); sum += c; cnt += (c > 0u) ? 1u : 0u; mine = (j == x) ? c : mine; }
        if (sum == G) break;
        __builtin_amdgcn_s_sleep(1);
        if ((++sp & 255u) == 0u) { if (xb_ld(&bar[XB_TMO])) break; if (sp > XB_SPIN_CAP) { atomicAdd(&bar[XB_TMO], 1u); break; } }
    }
    nloc = mine > 0u ? mine : 1u; nx = cnt > 0u ? cnt : 1u;
}
__device__ __forceinline__ void xcd_barrier(const XcdBarrier& b) {
    asm volatile("s_waitcnt vmcnt(0)" ::: "memory");
    __syncthreads();
    if (threadIdx.x == 0) {
        unsigned* bar = b.bar;
        __builtin_amdgcn_s_waitcnt(0);
        unsigned nloc = b.st[0], nx = b.st[1];
        if (nloc == 0u) { xcd_barrier_complete(bar, b.x, nloc, nx); b.st[0] = nloc; b.st[1] = nx; }
        const unsigned old = xb_add(&bar[XB_XSUB(b.x)], 1u);
        const unsigned gen = old / nloc;
        if (old + 1u == (gen + 1u) * nloc) {
            __builtin_amdgcn_fence(__ATOMIC_RELEASE, "agent");
            asm volatile("s_waitcnt vmcnt(0)" ::: "memory");
            const unsigned og = xb_add(&bar[XB_TOP], 1u);
            const unsigned tg = og / nx;
            if (og + 1u == (tg + 1u) * nx) xb_add(&bar[XB_TOPGEN], 1u);
            else XB_SPIN(xb_ld(&bar[XB_TOPGEN]) == tg, bar);
            __builtin_amdgcn_fence(__ATOMIC_ACQUIRE, "agent");
            xb_add(&bar[XB_XGEN(b.x)], 1u);
            asm volatile("s_waitcnt vmcnt(0)" ::: "memory");
        } else {
            XB_SPIN(xb_ld(&bar[XB_XGEN(b.x)]) == gen, bar);
            __builtin_amdgcn_fence(__ATOMIC_ACQUIRE, "agent");
            asm volatile("s_waitcnt vmcnt(0)" ::: "memory");
        }
    }
    __syncthreads();
}

#define XB2_BASE     8192
#define XB2_XREP(x, i) (XB2_BASE + 256 * (32 * (x) + (i)))
#define XB2_TOPREP(x)  (XB2_BASE + 256 * (512 + (x)))
struct XcdBarrier2 { unsigned* bar; unsigned x, idx; volatile LAS unsigned* st; };
__device__ __forceinline__ XcdBarrier2 xcd_barrier2_post(unsigned* bar, volatile LAS unsigned* st) {
    XcdBarrier2 b; b.bar = bar; b.x = xb_xcc_id(); b.st = st; b.idx = 0;
    if (threadIdx.x < 64) { unsigned i = 0; if (threadIdx.x == 0) i = xb_add(&bar[XB_XCNT(b.x)], 1u); b.idx = __builtin_amdgcn_readfirstlane(i); }
    return b;
}
__device__ __forceinline__ void xcd_barrier2(const XcdBarrier2& b) {
    asm volatile("s_waitcnt vmcnt(0)" ::: "memory");
    __syncthreads();
    if (threadIdx.x < 64) {
        unsigned* bar = b.bar; const unsigned lane = threadIdx.x;
        unsigned nloc = b.st[0], nx = b.st[1]; const unsigned gen = b.st[2];
        if (nloc == 0u) { if (lane == 0) { xcd_barrier_complete(bar, b.x, nloc, nx); b.st[0] = nloc; b.st[1] = nx; }
            asm volatile("s_waitcnt lgkmcnt(0)" ::: "memory"); nloc = b.st[0]; nx = b.st[1]; }
        nloc = __builtin_amdgcn_readfirstlane(nloc); nx = __builtin_amdgcn_readfirstlane(nx);
        unsigned old = 0; if (lane == 0) old = xb_add(&bar[XB_XSUB(b.x)], 1u);
        old = __builtin_amdgcn_readfirstlane(old);
        if (old + 1u == (gen + 1u) * nloc) {
            if (lane == 0) { __builtin_amdgcn_fence(__ATOMIC_RELEASE, "agent"); asm volatile("s_waitcnt vmcnt(0)" ::: "memory"); }
            unsigned og = 0; if (lane == 0) og = xb_add(&bar[XB_TOP], 1u);
            og = __builtin_amdgcn_readfirstlane(og);
            if (og + 1u == (gen + 1u) * nx) { if (lane < 16) __hip_atomic_store(&bar[XB2_TOPREP(lane)], gen + 1u, __ATOMIC_RELAXED, __HIP_MEMORY_SCOPE_AGENT); }
            else if (lane == 0) XB_SPIN(xb_ld(&bar[XB2_TOPREP(b.x)]) < gen + 1u, bar);
            if (lane == 0) __builtin_amdgcn_fence(__ATOMIC_ACQUIRE, "agent");
            if (lane < nloc && lane < 32) __hip_atomic_store(&bar[XB2_XREP(b.x, lane)], gen + 1u, __ATOMIC_RELAXED, __HIP_MEMORY_SCOPE_AGENT);
            asm volatile("s_waitcnt vmcnt(0)" ::: "memory");
        } else {
            if (lane == 0) { XB_SPIN(xb_ld(&bar[XB2_XREP(b.x, b.idx)]) < gen + 1u, bar);
                __builtin_amdgcn_fence(__ATOMIC_ACQUIRE, "agent"); asm volatile("s_waitcnt vmcnt(0)" ::: "memory"); }
        }
        if (lane == 0) b.st[2] = gen + 1u;
    }
    __syncthreads();
}
template <int FENCES> __device__ __forceinline__ void xcd_barrier_probe(const XcdBarrier& b) {
    asm volatile("s_waitcnt vmcnt(0)" ::: "memory");
    __syncthreads();
    if (threadIdx.x == 0) {
        unsigned* bar = b.bar;
        unsigned nloc = b.st[0], nx = b.st[1];
        if (nloc == 0u) { xcd_barrier_complete(bar, b.x, nloc, nx); b.st[0] = nloc; b.st[1] = nx; }
        const unsigned old = xb_add(&bar[XB_XSUB(b.x)], 1u);
        const unsigned gen = old / nloc;
        if (old + 1u == (gen + 1u) * nloc) {
            if (FENCES & 1) { __builtin_amdgcn_fence(__ATOMIC_RELEASE, "agent"); asm volatile("s_waitcnt vmcnt(0)" ::: "memory"); }
            const unsigned og = xb_add(&bar[XB_TOP], 1u);
            const unsigned tg = og / nx;
            if (og + 1u == (tg + 1u) * nx) xb_add(&bar[XB_TOPGEN], 1u);
            else XB_SPIN(xb_ld(&bar[XB_TOPGEN]) == tg, bar);
            if (FENCES & 2) __builtin_amdgcn_fence(__ATOMIC_ACQUIRE, "agent");
            xb_add(&bar[XB_XGEN(b.x)], 1u);
            asm volatile("s_waitcnt vmcnt(0)" ::: "memory");
        } else {
            XB_SPIN(xb_ld(&bar[XB_XGEN(b.x)]) == gen, bar);
        }
    }
    __syncthreads();
}
__device__ __forceinline__ void flat_barrier(unsigned* bar, volatile LAS unsigned* gen) {
    asm volatile("s_waitcnt vmcnt(0)" ::: "memory");
    __syncthreads();
    if (threadIdx.x == 0) {
        const unsigned g = gen[0] + 1u; gen[0] = g;
        __builtin_amdgcn_fence(__ATOMIC_RELEASE, "agent");
        asm volatile("s_waitcnt vmcnt(0)" ::: "memory");
        xb_add(&bar[XB_TOP], 1u);
        const unsigned target = g * gridDim.x;
        XB_SPIN(xb_ld(&bar[XB_TOP]) < target, bar);
        __builtin_amdgcn_fence(__ATOMIC_ACQUIRE, "agent");
        asm volatile("s_waitcnt vmcnt(0)" ::: "memory");
    }
    __syncthreads();
}
namespace pg8 {
constexpr int BM = 256, BK = 64, HALF = 128, HTB = HALF * BK * 2, STAGE_BYTES = 8 * HTB, NXCD = 8, WGM = 8;
__host__ __device__ __forceinline__ int lds_byte(int r, int c) { const int st = (r >> 4) * 2 + (c >> 5), rr = r & 15, cc = c & 31, ob = rr * 64 + cc * 2; return st * 1024 + (ob ^ (((ob >> 9) & 1) << 5)); }
__host__ __device__ __forceinline__ void stage_rc(int b, int& R, int& C) { const int st = b / 1024, sb = b % 1024, swz = sb ^ (((sb >> 9) & 1) << 5); R = (st >> 1) * 16 + swz / 64; C = (st & 1) * 32 + (swz % 64) / 2; }

struct Unit { int pm, pn, sel; };
struct Gemm { const bf16_t* A0; const bf16_t* B0; const bf16_t* A1; const bf16_t* B1; int K; };

struct Order {
    int nM, nN, nwg, n1M, n1N, G, c;
    __device__ void init(int nM_, int nN_, int n1M_, int n1N_, int G_, int c_) { nM = nM_; nN = nN_; nwg = nM * nN; n1M = n1M_; n1N = n1N_; G = G_; c = c_; }
    __device__ bool next(int i, Unit& u) const {
        const long L = (long)i * G + c;
        if (L >= nwg + n1M * n1N) return false;
        if (L >= nwg) { const int r = (int)L - nwg; u.pm = r / n1N; u.pn = r % n1N; u.sel = 1; return true; }
        int wgid = (int)L; { const int q = nwg / NXCD, r = nwg % NXCD, xcd = wgid % NXCD, off = wgid / NXCD; wgid = (xcd < r ? xcd * (q + 1) : r * (q + 1) + (xcd - r) * q) + off; }
        const int nig = WGM * nN, gid = wgid / nig, fm = gid * WGM, gsz = (nM - fm) < WGM ? (nM - fm) : WGM;
        u.pm = fm + ((wgid % nig) % gsz); u.pn = (wgid % nig) / gsz; u.sel = 0; return true;
    }
};

template <class Epi>
__device__ __forceinline__ void gemm_phase(LAS unsigned char* lds, const Gemm g, const Order& S, const Epi& E) {
    const int tid = threadIdx.x, wid = __builtin_amdgcn_readfirstlane(tid >> 6), lane = tid & 63, wr = wid >> 2, wc = wid & 3, fr = lane & 15, fq = lane >> 4;
    const int K = g.K, nt = K / BK;
    unsigned voffA[2];
#pragma unroll
    for (int i = 0; i < 2; ++i) { int R, C; stage_rc(tid * 16 + i * 8192, R, C); voffA[i] = (unsigned)(R * K + C) * 2u; }
    const size_t kstep = (size_t)(BK * 2);
    const size_t hstep = (size_t)HALF * K * 2;
    const size_t tstep = 2 * hstep;
    const unsigned ldsw = (unsigned)wid * 1024u;
    const int aoff = lds_byte(wr * 64 + fr, fq * 8), boff = lds_byte(wc * 32 + fr, fq * 8);
#define PG8_SA(b, h) (((b) * 2 + (h)) * HTB)
#define PG8_SB(b, h) ((4 + (b) * 2 + (h)) * HTB)
#define PG8_STAGE(bufoff, gbase) do { _Pragma("unroll") for (int _i = 0; _i < 2; ++_i) \
        __builtin_amdgcn_global_load_lds((const unsigned*)((const char*)(gbase) + voffA[_i]), (LAS unsigned*)(lds + (bufoff) + ldsw + _i * 8192), 16, 0, 0); } while (0)
#define PG8_LDA(dst, b, h) do { _Pragma("unroll") for (int m = 0; m < 4; ++m) _Pragma("unroll") for (int k = 0; k < 2; ++k) dst[m][k] = *(const LAS bf16x8*)(lds + PG8_SA(b, h) + aoff + m * 2048 + k * 1024); } while (0)
#define PG8_LDB(dst, b, h) do { _Pragma("unroll") for (int n = 0; n < 2; ++n) _Pragma("unroll") for (int k = 0; k < 2; ++k) dst[n][k] = *(const LAS bf16x8*)(lds + PG8_SB(b, h) + boff + n * 2048 + k * 1024); } while (0)
#define PG8_MMA(ai, bj, At, Bt) do { __builtin_amdgcn_s_setprio(1); _Pragma("unroll") for (int m = 0; m < 4; ++m) _Pragma("unroll") for (int n = 0; n < 2; ++n) _Pragma("unroll") for (int k = 0; k < 2; ++k) \
        acc[ai][bj][m][n] = __builtin_amdgcn_mfma_f32_16x16x32_bf16(Bt[n][k], At[m][k], acc[ai][bj][m][n], 0, 0, 0); __builtin_amdgcn_s_setprio(0); } while (0)
#define PG8_WAIT_V(n) asm volatile("s_waitcnt vmcnt(" #n ")" ::: "memory")
#define PG8_WAIT_L(n) asm volatile("s_waitcnt lgkmcnt(" #n ")" ::: "memory")
#define PG8_BAR __builtin_amdgcn_s_barrier()
#define PG8_SCHED __builtin_amdgcn_sched_barrier(0)
    Unit cur, nxt; int ui = 0;
    if (!S.next(0, cur)) return;
    f32x4 acc[2][2][4][2];
#pragma unroll
    for (int a = 0; a < 2; ++a)
#pragma unroll
        for (int b = 0; b < 2; ++b)
#pragma unroll
            for (int m = 0; m < 4; ++m)
#pragma unroll
                for (int n = 0; n < 2; ++n) acc[a][b][m][n] = (f32x4){0.f, 0.f, 0.f, 0.f};
    bf16x8 At[4][2], B0[2][2], B1[2][2];
    const char* cA = (const char*)(cur.sel ? g.A1 : g.A0) + (size_t)cur.pm * tstep; const char* cB = (const char*)(cur.sel ? g.B1 : g.B0) + (size_t)cur.pn * tstep;
    PG8_STAGE(PG8_SB(0, 0), cB); PG8_STAGE(PG8_SB(0, 1), cB + hstep); PG8_STAGE(PG8_SA(0, 0), cA); PG8_STAGE(PG8_SA(0, 1), cA + hstep);
    if (wr == 1) PG8_BAR;
    PG8_WAIT_V(2); PG8_BAR;
    PG8_STAGE(PG8_SB(1, 0), cB + kstep); PG8_STAGE(PG8_SA(1, 0), cA + kstep); PG8_STAGE(PG8_SB(1, 1), cB + hstep + kstep);
    PG8_WAIT_V(6); PG8_BAR;
    for (;;) {
        const bool has_next = S.next(ui + 1, nxt);
        const char* nA = has_next ? (const char*)(nxt.sel ? g.A1 : g.A0) + (size_t)nxt.pm * tstep : cA; const char* nB = has_next ? (const char*)(nxt.sel ? g.B1 : g.B0) + (size_t)nxt.pn * tstep : cB;
        for (int t = 0; t < nt; t += 2) {
            const bool last = (t == nt - 2);
            const char* a1 = cA + (size_t)(t + 1) * kstep;
            const char* a2 = last ? nA : cA + (size_t)(t + 2) * kstep; const char* b2 = last ? nB : cB + (size_t)(t + 2) * kstep;
            const char* a3 = a2 + kstep; const char* b3 = b2 + kstep;
            if constexpr (Epi::MID > 0) { if (t == Epi::MID) E.mid(acc, cur, wr, fr); }
            PG8_LDB(B0, 0, 0); PG8_LDB(B1, 0, 1); PG8_SCHED; PG8_LDA(At, 0, 0); PG8_STAGE(PG8_SA(1, 1), a1 + hstep);
            PG8_WAIT_V(8); PG8_WAIT_L(0); PG8_BAR; PG8_MMA(0, 0, At, B0); PG8_MMA(0, 1, At, B1); PG8_BAR; PG8_SCHED;
            PG8_LDA(At, 0, 1); PG8_STAGE(PG8_SB(0, 0), b2); PG8_STAGE(PG8_SB(0, 1), b2 + hstep); PG8_STAGE(PG8_SA(0, 0), a2);
            PG8_WAIT_V(8); PG8_WAIT_L(0); PG8_BAR; PG8_MMA(1, 0, At, B0); PG8_MMA(1, 1, At, B1); PG8_BAR; PG8_SCHED;
            PG8_LDB(B0, 1, 0); PG8_LDB(B1, 1, 1); PG8_SCHED; PG8_LDA(At, 1, 0); PG8_STAGE(PG8_SA(0, 1), a2 + hstep);
            PG8_WAIT_V(8); PG8_WAIT_L(0); PG8_BAR; PG8_MMA(0, 0, At, B0); PG8_MMA(0, 1, At, B1); PG8_BAR; PG8_SCHED;
            PG8_LDA(At, 1, 1); PG8_STAGE(PG8_SB(1, 0), b3); PG8_STAGE(PG8_SB(1, 1), b3 + hstep); PG8_STAGE(PG8_SA(1, 0), a3);
            PG8_WAIT_V(8); PG8_WAIT_L(0); PG8_BAR; PG8_MMA(1, 0, At, B0); PG8_MMA(1, 1, At, B1); PG8_BAR; PG8_SCHED;
        }
        if (wr == 0) PG8_BAR;
        E(acc, cur, wr, wc, fr, fq);
        if (!has_next) break;
#pragma unroll
        for (int a = 0; a < 2; ++a)
#pragma unroll
            for (int b = 0; b < 2; ++b)
#pragma unroll
                for (int m = 0; m < 4; ++m)
#pragma unroll
                    for (int n = 0; n < 2; ++n) acc[a][b][m][n] = (f32x4){0.f, 0.f, 0.f, 0.f};
        cur = nxt; cA = nA; cB = nB; ++ui;
        if (wr == 1) PG8_BAR;
    }
    PG8_WAIT_V(0);
    PG8_BAR;
#undef PG8_SA
#undef PG8_SB
#undef PG8_STAGE
#undef PG8_LDA
#undef PG8_LDB
#undef PG8_MMA
#undef PG8_WAIT_V
#undef PG8_WAIT_L
#undef PG8_BAR
#undef PG8_SCHED
}
typedef f32x4 Acc[2][2][4][2];
__device__ __forceinline__ void store_f32(const Acc& acc, float* base, int ld, int rl0, int cl0, int valid) {
#pragma unroll
    for (int ai = 0; ai < 2; ++ai)
#pragma unroll
        for (int m = 0; m < 4; ++m) { const int row = rl0 + ai * HALF + m * 16; if (row < valid) { float* rp = base + (size_t)row * ld + cl0;
#pragma unroll
            for (int bj = 0; bj < 2; ++bj)
#pragma unroll
                for (int n = 0; n < 2; ++n) *(f32x4*)(rp + bj * HALF + n * 16) = acc[ai][bj][m][n]; } }
}
__device__ __forceinline__ void store_bf16(const Acc& acc, bf16_t* base, int ld, int rl0, int cl0) {
#pragma unroll
    for (int ai = 0; ai < 2; ++ai)
#pragma unroll
        for (int m = 0; m < 4; ++m) { const int row = rl0 + ai * HALF + m * 16; bf16_t* rp = base + (size_t)row * ld + cl0;
#pragma unroll
            for (int bj = 0; bj < 2; ++bj)
#pragma unroll
                for (int n = 0; n < 2; ++n) { const f32x4 a = acc[ai][bj][m][n]; u32x2 w; w.x = cvtpk(a[0], a[1]); w.y = cvtpk(a[2], a[3]); *(u32x2*)(rp + bj * HALF + n * 16) = w; } }
}
}

struct Params {
    const float* in[26];
    float* out;
    unsigned char* ws;
    int ph_lo, ph_hi;
};
enum { I_XP = 0, I_XS, I_CK, I_CV, I_SSM, I_SCONV, I_CMK, I_CMV, I_PT, I_MEM, I_NORMW, I_WIN, I_QNORM, I_KNORM, I_SBBIAS, I_CONVW, I_CONVB, I_DTBIAS, I_ALOG, I_DSKIP,
       I_SSDNW, I_MEMNW, I_WMEM, I_MQNORM, I_MKNORM, I_WOUT };

#define PSTAMP0(i) do { if (PROBE_SEG >= 40 && blockIdx.x == 0 && threadIdx.x == 0) ((volatile LAS unsigned long long*)(ctlw + 32))[20 + (i)] = __builtin_amdgcn_s_memrealtime(); } while (0)
struct TrItem { const float* src; bf16_t* dst; bool ok; };
__device__ __forceinline__ TrItem tr_item(const Params& p, int it, int lane) {
    constexpr int I_IN = (DM / 32) * (NPAD / 128), I_M = (DM / 32) * (1024 / 128);
    const float* W; bf16_t* WT; int Nsrc, N, map;
    if (it < I_IN) { W = p.in[I_WIN]; WT = (bf16_t*)(p.ws + WS_WIN); Nsrc = NIN; N = NPAD; map = 1; }
    else if (it < I_IN + I_M) { it -= I_IN; W = p.in[I_WMEM]; WT = (bf16_t*)(p.ws + WS_WM); Nsrc = 1024; N = 1024; map = 0; }
    else { it -= I_IN + I_M; W = p.in[I_WOUT]; WT = (bf16_t*)(p.ws + WS_WOUT); Nsrc = DM; N = DM; map = 2; }
    const int nblk = N / 128, kb = it / nblk, nb = it % nblk, k0 = 32 * kb, n0 = 128 * nb;
    const int ks0 = (map == 2) ? (k0 < 512 ? k0 + 1024 : (k0 < 1536 ? k0 - 512 : k0)) : k0;
    const int nd = n0 + 4 * (lane & 31);
    int ns = nd; bool ok = true;
    if (map == 1) { if (nd < 5632) ns = nd; else if (nd < 6656) ns = nd + 8; else if (nd < 6664) ns = nd - 1024; else { ns = 0; ok = false; } }
    TrItem t; t.src = W + (size_t)(ks0 + (lane >> 5)) * Nsrc + ns; t.dst = WT + (size_t)(n0 + (lane & 15)) * DM + k0 + 8 * (lane >> 4); t.ok = ok;
    return t;
}
__device__ __forceinline__ int tr_nsrc(int it) { constexpr int I_IN = (DM / 32) * (NPAD / 128), I_M = (DM / 32) * (1024 / 128); return it < I_IN ? NIN : (it < I_IN + I_M ? 1024 : DM); }
__device__ __forceinline__ void tr_load(const TrItem& t, int nsrc, f32x4 (&v)[16]) {
#pragma unroll
    for (int i = 0; i < 16; ++i) v[i] = t.ok ? *(const f32x4*)(t.src + (size_t)(2 * i) * nsrc) : f32x4{0.f, 0.f, 0.f, 0.f};
}
__device__ __forceinline__ void tr_finish(const TrItem& t, const f32x4 (&v)[16], LAS float* scr, int lane) {
#pragma unroll
    for (int i = 0; i < 16; ++i) { const int kk = 2 * i + (lane >> 5); *(LAS f32x4*)(scr + kk * 132 + 4 * (lane & 31)) = v[i]; }
    asm volatile("s_waitcnt lgkmcnt(0)" ::: "memory");
    const int nl = lane & 15, c = lane >> 4;
#pragma unroll
    for (int j = 0; j < 8; ++j) { const LAS float* sp = scr + (8 * c) * 132 + nl + 16 * j;
        u32x4 o; o.x = cvtpk(sp[0 * 132], sp[1 * 132]); o.y = cvtpk(sp[2 * 132], sp[3 * 132]); o.z = cvtpk(sp[4 * 132], sp[5 * 132]); o.w = cvtpk(sp[6 * 132], sp[7 * 132]);
        *(u32x4*)(t.dst + (size_t)(16 * j) * DM) = o; }
    asm volatile("s_waitcnt lgkmcnt(0)" ::: "memory");
}
__device__ __forceinline__ void tr_pipeline(const Params& p, LAS float* scr, int lane, int gw, int NGW, int first, int end) {
    f32x4 va[16], vb[16];
    int it = first + gw;
    TrItem ta{}, tb{};
    if (it < end) { ta = tr_item(p, it, lane); tr_load(ta, tr_nsrc(it), va); }
    while (it < end) {
        const int itb = it + NGW;
        if (itb < end) { tb = tr_item(p, itb, lane); tr_load(tb, tr_nsrc(itb), vb); }
        tr_finish(ta, va, scr, lane);
        if (itb >= end) break;
        const int ita = itb + NGW;
        if (ita < end) { ta = tr_item(p, ita, lane); tr_load(ta, tr_nsrc(ita), va); }
        tr_finish(tb, vb, scr, lane);
        it = ita;
    }
}
constexpr int NITEMS_P0 = (DM / 32) * (NPAD / 128) + (DM / 32) * (1024 / 128), NITEMS_ALL = NITEMS_P0 + (DM / 32) * (DM / 128);
__device__ __forceinline__ void cache_mem_convert(const Params& p, int gt, int NGT) {
    u32x4* cmk = (u32x4*)(p.ws + WS_CMK); u32x4* cmv = (u32x4*)(p.ws + WS_CMV);
    constexpr int N8 = DSEQ * MEMT * 512 / 8;
    for (int i = gt; i < 2 * N8; i += NGT) { const bool isk = i < N8; const int j = isk ? i : i - N8; const f32x4* s = (const f32x4*)(isk ? p.in[I_CMK] : p.in[I_CMV]) + 2 * (size_t)j;
        const f32x4 a = s[0], b = s[1]; u32x4 o; o.x = cvtpk(a.x, a.y); o.y = cvtpk(a.z, a.w); o.z = cvtpk(b.x, b.y); o.w = cvtpk(b.z, b.w); (isk ? cmk : cmv)[j] = o; }
}
__device__ __forceinline__ const float* p0_row_src(const Params& p, int m) { return m < MP ? p.in[I_XP] + (size_t)m * DM : (m < MVALID ? p.in[I_XS] + (size_t)(m - MP) * DM : p.in[I_MEM] + (size_t)(m - MVALID) * DM); }
__device__ __forceinline__ void p0_row_finish(const Params& p, int m, const f32x4 (&v)[8], int lane) {
    float s = 0.f;
#pragma unroll
    for (int j = 0; j < 8; ++j) s += (v[j].x * v[j].x + v[j].y * v[j].y) + (v[j].z * v[j].z + v[j].w * v[j].w);
    const float rs = 1.f / sqrtf(wave_sum(s) * (1.f / DM) + EPS);
    const f32x4* gr = (const f32x4*)(m < MVALID ? p.in[I_NORMW] : p.in[I_MEMNW]) + lane;
    bf16_t* orow = m < MVALID ? (bf16_t*)(p.ws + WS_H) + (size_t)m * DM : (bf16_t*)(p.ws + WS_HM) + (size_t)(m - MVALID) * DM;
    u32x2* o8 = (u32x2*)orow + lane;
#pragma unroll
    for (int j = 0; j < 8; ++j) { const f32x4 g = gr[64 * j]; u32x2 w; w.x = cvtpk(v[j].x * rs * g.x, v[j].y * rs * g.y); w.y = cvtpk(v[j].z * rs * g.z, v[j].w * rs * g.w); o8[64 * j] = w; }
}
__device__ __forceinline__ void phase0(const Params& p, LAS unsigned char* lds, int vcu, int G, volatile LAS unsigned* ctlw) {
    const int tid = threadIdx.x, lane = tid & 63, wave = __builtin_amdgcn_readfirstlane(tid >> 6);
    LAS float* scr = (LAS float*)(lds + wave * 16896);
    const int gw = vcu * 8 + wave, NGW = G * 8;
    PSTAMP0(0);
    {
        f32x4 va[8], vb[8];
        int m = gw;
        if (m < MVALID + MMEM) { const f32x4* xr = (const f32x4*)p0_row_src(p, m) + lane;
#pragma unroll
            for (int j = 0; j < 8; ++j) va[j] = xr[64 * j]; }
        while (m < MVALID + MMEM) {
            const int mb = m + NGW;
            if (mb < MVALID + MMEM) { const f32x4* xr = (const f32x4*)p0_row_src(p, mb) + lane;
#pragma unroll
                for (int j = 0; j < 8; ++j) vb[j] = xr[64 * j]; }
            p0_row_finish(p, m, va, lane);
            if (mb >= MVALID + MMEM) break;
            const int ma = mb + NGW;
            if (ma < MVALID + MMEM) { const f32x4* xr = (const f32x4*)p0_row_src(p, ma) + lane;
#pragma unroll
                for (int j = 0; j < 8; ++j) va[j] = xr[64 * j]; }
            p0_row_finish(p, mb, vb, lane);
            m = ma;
        }
    }
    PSTAMP0(1);
    tr_pipeline(p, scr, lane, gw, NGW, 0, NITEMS_P0);
    PSTAMP0(2);
    PSTAMP0(3);
}

struct Epi1 {
    static constexpr int MID = 0;
    bf16_t* PROJ; float* DT; float* out; const float* dtbias; const float* qn; const float* kn; const float* mqn; const float* mkn; bf16_t* MKn; bf16_t* MVb; LAS float* T;
    __device__ __forceinline__ void head_norm(pg8::Acc& acc, const float* gain, float gscale, int wr, int wc, int fr, int fq) const {
        float part[2][4][2];
#pragma unroll
        for (int ai = 0; ai < 2; ++ai)
#pragma unroll
            for (int m = 0; m < 4; ++m)
#pragma unroll
                for (int bj = 0; bj < 2; ++bj) { const f32x4 a = acc[ai][bj][m][0], b = acc[ai][bj][m][1];
                    float s = ((a.x * a.x + a.y * a.y) + (a.z * a.z + a.w * a.w)) + ((b.x * b.x + b.y * b.y) + (b.z * b.z + b.w * b.w));
                    s += __shfl_xor(s, 16); s += __shfl_xor(s, 32); part[ai][m][bj] = s; }
        if (fq == 0) {
#pragma unroll
            for (int ai = 0; ai < 2; ++ai)
#pragma unroll
                for (int m = 0; m < 4; ++m)
#pragma unroll
                    for (int bj = 0; bj < 2; ++bj) T[(((wr * 128 + ai * 64 + m * 16 + fr) * 2 + bj) << 2) + wc] = part[ai][m][bj];
        }
        asm volatile("s_waitcnt lgkmcnt(0)" ::: "memory");
        __builtin_amdgcn_s_barrier();
        asm volatile("" ::: "memory");
        int cg = wc * 32 + 4 * fq; asm volatile("" : "+v"(cg));
        const f32x4 g0 = *(const f32x4*)(gain + cg) * gscale, g1 = *(const f32x4*)(gain + cg + 16) * gscale;
#pragma unroll
        for (int ai = 0; ai < 2; ++ai)
#pragma unroll
            for (int m = 0; m < 4; ++m)
#pragma unroll
                for (int bj = 0; bj < 2; ++bj) { const f32x4 t = *(const LAS f32x4*)(T + (((wr * 128 + ai * 64 + m * 16 + fr) * 2 + bj) << 2));
                    const float rs = 1.f / sqrtf(((t.x + t.y) + (t.z + t.w)) * (1.f / 128.f) + EPS);
                    acc[ai][bj][m][0] = acc[ai][bj][m][0] * rs * g0; acc[ai][bj][m][1] = acc[ai][bj][m][1] * rs * g1;
                    asm volatile("" ::: "memory"); }
    }
    __device__ __forceinline__ void operator()(pg8::Acc& acc, const pg8::Unit& u, int wr, int wc, int fr, int fq) const {
        int rl0 = wr * 64 + fr, cl0 = wc * 32 + 4 * fq;
        asm volatile("" : "+v"(rl0), "+v"(cl0));
        const int pn = u.pn; const size_t r0 = (size_t)u.pm * 256;
        const float* gain = nullptr; float gs = 1.f;
        float* fbase = nullptr; int fld = 1024, valid = 256;
        bf16_t* bbase = PROJ + r0 * NPAD + pn * 256; int bld = NPAD;
        if (u.sel == 1) { if (pn < 2) gain = mkn; fbase = out + (pn < 2 ? O_PMK : O_PMV) + r0 * 512 + (pn & 1) * 256; fld = 512; bbase = (pn < 2 ? MKn : MVb) + r0 * 512 + (pn & 1) * 256; bld = 512; }
        else {
            if (pn < 4) { gain = qn; gs = QSCALE; } else if (pn < 8) gain = kn; else if (pn == 22 || pn == 23) { gain = mqn; gs = QSCALE; }
            if (pn >= 4 && pn < 12) { if (u.pm < 32) fbase = out + (pn < 8 ? O_PK : O_PV) + r0 * 1024 + (pn & 3) * 256; else { fbase = out + (pn < 8 ? O_SK : O_SV) + (pn & 3) * 256; valid = MS; } }
        }
        if (gain) head_norm(acc, gain, gs, wr, wc, fr, fq);
        if (fbase) pg8::store_f32(acc, fbase, fld, rl0, cl0, valid);
        pg8::store_bf16(acc, bbase, bld, rl0, cl0);
        if (u.sel == 1) return;
        if (pn >= 18 && pn < 22) {
#pragma unroll
            for (int ai = 0; ai < 2; ++ai)
#pragma unroll
                for (int m = 0; m < 4; ++m) { const int row = rl0 + ai * 128 + m * 16; float* dst = nullptr;
                    if (u.pm < 32) { if ((u.pm & 7) == 7 && row >= 253) dst = out + O_PCONV + (size_t)((u.pm >> 3) * 3 + row - 253) * 1024; }
                    else if (row < MS && (row & 7) >= 5) dst = out + O_SCONV + (size_t)((row >> 3) * 3 + (row & 7) - 5) * 1024;
                    if (dst) { dst += (pn - 18) * 256 + cl0;
#pragma unroll
                        for (int bj = 0; bj < 2; ++bj)
#pragma unroll
                            for (int n = 0; n < 2; ++n) *(f32x4*)(dst + bj * 128 + n * 16) = acc[ai][bj][m][n]; } }
        }
        if (pn == 26 && wc == 0 && fq < 2) {
            const f32x4 db = *(const f32x4*)(dtbias + 4 * fq);
#pragma unroll
            for (int ai = 0; ai < 2; ++ai)
#pragma unroll
                for (int m = 0; m < 4; ++m) { const int row = rl0 + ai * 128 + m * 16; f32x4 v = acc[ai][0][m][0] + db;
#pragma unroll
                    for (int e = 0; e < 4; ++e) v[e] = (v[e] > 20.f) ? v[e] : log1pf(__expf(v[e]));
                    *(f32x4*)(DT + (r0 + row) * 8 + 4 * fq) = v; }
        }
    }
};

__device__ __forceinline__ float group16_sum(float v) { v += __shfl_xor(v, 1); v += __shfl_xor(v, 2); v += __shfl_xor(v, 4); v += __shfl_xor(v, 8); return v; }

#define KSWZ(row, colB) ((row) * 256 + ((colB) ^ (((row) & 7) << 4)))
#define SBAR() __builtin_amdgcn_sched_barrier(0)
__device__ __forceinline__ int crow(int r, int hi) { return (r & 3) + 8 * (r >> 2) + 4 * hi; }
__device__ __forceinline__ int v_st(int k, int c) { const int kk = (k & ~0xC) | ((k & 4) << 1) | ((k & 8) >> 1); return ((kk >> 3) * 4 + (c >> 5)) * 512 + ((kk & 7) * 32 + (c & 31)) * 2; }
__device__ __forceinline__ int v_rd_base(int lane) { return ((lane & 3) << 3) | (((lane >> 2) & 3) << 6) | (((lane >> 4) & 1) << 5) | (((lane >> 5) & 1) << 8); }
constexpr int v_rd_off(int d0, int ks, int half) { return d0 * 512 + ks * 4096 + half * 2048; }
template <int OFF> __device__ __forceinline__ s16x4 tr_read(int vb) {
    s16x4 r; asm volatile("ds_read_b64_tr_b16 %0, %1 offset:%2" : "=&v"(r) : "v"(vb), "i"(OFF) : "memory"); return r;
}
#define PKV(L, H) (bf16x8){L[0], L[1], L[2], L[3], H[0], H[1], H[2], H[3]}
template <int D0, int KS0> __device__ __forceinline__ void pv_one(f32x16& od, int vb, const bf16x8* pa) {
    const s16x4 l0 = tr_read<v_rd_off(D0, KS0, 0)>(vb), h0 = tr_read<v_rd_off(D0, KS0, 1)>(vb), l1 = tr_read<v_rd_off(D0, KS0 + 1, 0)>(vb), h1 = tr_read<v_rd_off(D0, KS0 + 1, 1)>(vb);
    asm volatile("s_waitcnt lgkmcnt(0)" ::: "memory"); SBAR();
    od = __builtin_amdgcn_mfma_f32_32x32x16_bf16(pa[0], PKV(l0, h0), od, 0, 0, 0);
    od = __builtin_amdgcn_mfma_f32_32x32x16_bf16(pa[1], PKV(l1, h1), od, 0, 0, 0);
}
template <int KS0> __device__ __forceinline__ void pv_blk(f32x16* o, int vb, const bf16x8* pa) {
    pv_one<0, KS0>(o[0], vb, pa); pv_one<1, KS0>(o[1], vb, pa); pv_one<2, KS0>(o[2], vb, pa); pv_one<3, KS0>(o[3], vb, pa);
}
__device__ __forceinline__ void pack_p(const f32x16& P, bf16x8& out0, bf16x8& out1) {
#define PK4(BASE, OUT) do { unsigned a0 = cvtpk(P[BASE + 0], P[BASE + 1]), a1 = cvtpk(P[BASE + 2], P[BASE + 3]);   \
    unsigned b0 = cvtpk(P[BASE + 4], P[BASE + 5]), b1 = cvtpk(P[BASE + 6], P[BASE + 7]);                              \
    auto r0 = __builtin_amdgcn_permlane32_swap(a0, b0, false, false); auto r1 = __builtin_amdgcn_permlane32_swap(a1, b1, false, false); \
    u32x4 w = {r0[0], r1[0], r0[1], r1[1]}; OUT = *reinterpret_cast<bf16x8*>(&w); } while (0)
    PK4(0, out0); PK4(8, out1);
#undef PK4
}
template <int NB, bool MASK> __device__ __forceinline__ void sb_transform(f32x16* P, float& R, int hi, int kpos0, int qpos) {
    float T[NB][4];
#pragma unroll
    for (int b = 0; b < NB; ++b)
#pragma unroll
        for (int g = 0; g < 4; ++g) {
            float be[4], f[4];
#pragma unroll
            for (int i = 0; i < 4; ++i) {
                const float z = fmaxf(P[b][4 * g + i], -100.f);
                const float e = fast_exp2(-z), rc = fast_rcp(1.f + e);
                be[i] = rc; f[i] = e * rc;
                if (MASK) { const bool ok = (kpos0 + 32 * b + 8 * g + 4 * hi + i) < qpos; be[i] = ok ? be[i] : 0.f; f[i] = ok ? f[i] : 1.f; }
            }
            const float e2 = f[3], e1 = f[2] * f[3], e0 = f[1] * e1;
            T[b][g] = f[0] * e0;
            P[b][4 * g + 0] = be[0] * e0; P[b][4 * g + 1] = be[1] * e1; P[b][4 * g + 2] = be[2] * e2; P[b][4 * g + 3] = be[3];
        }
    float E = R;
#pragma unroll
    for (int b = NB - 1; b >= 0; --b)
#pragma unroll
        for (int g = 3; g >= 0; --g) {
            const float To = __shfl_xor(T[b][g], 32);
            const float Eg = hi ? E : E * To;
#pragma unroll
            for (int i = 0; i < 4; ++i) P[b][4 * g + i] *= Eg;
            E = E * T[b][g] * To;
        }
    R = E;
}

struct AttnArgs {
    const bf16_t* Q; int qstride;
    const bf16_t* K; const bf16_t* V; int kvstride;
    int ntiles;
    int qpos0;
    int nvalid;
    float bias2;
    const bf16_t* gate; int gstride;
    bf16_t* out; int ostride;
};
struct GroupBar { volatile LAS unsigned* cnt; unsigned gen; };
__device__ __forceinline__ void group_bar(GroupBar& gb, int lane) {
    asm volatile("s_waitcnt lgkmcnt(0)" ::: "memory");
    gb.gen += 4u;
    if (lane == 0) (void)__hip_atomic_fetch_add((LAS unsigned*)gb.cnt, 1u, __ATOMIC_RELAXED, __HIP_MEMORY_SCOPE_WORKGROUP);
    while (__hip_atomic_load((LAS unsigned*)gb.cnt, __ATOMIC_RELAXED, __HIP_MEMORY_SCOPE_WORKGROUP) < gb.gen) __builtin_amdgcn_s_sleep(0);
    asm volatile("" ::: "memory");
}
template <int MODE>
__device__ __forceinline__ void attn_unit(LAS unsigned char* lds, GroupBar& gb, const bf16_t* aQ, int aqstride, const bf16_t* aK, const bf16_t* aV, int akvstride, int antiles, int aqpos0, int anvalid, float abias2,
                                      const bf16_t* agate, int agstride, bf16_t* aout, int aostride) {
    AttnArgs a; a.Q = aQ; a.qstride = aqstride; a.K = aK; a.V = aV; a.kvstride = akvstride; a.ntiles = antiles; a.qpos0 = aqpos0; a.nvalid = anvalid; a.bias2 = abias2;
    a.gate = agate; a.gstride = agstride; a.out = aout; a.ostride = aostride;
    int tid = threadIdx.x; asm volatile("" : "+v"(tid));
    const int wid = __builtin_amdgcn_readfirstlane(tid >> 6), lane = tid & 63, r32 = lane & 31, hi = lane >> 5;
    constexpr int SHM_V = 16384, SHM_K = 16384;
    LAS unsigned char* V_lds = lds; LAS unsigned char* K_lds = lds + 2 * SHM_V;
    LAS float* wsf = (LAS float*)(lds + 73728) + wid * 64;
    f32x16 o[4];
#pragma unroll
    for (int d = 0; d < 4; ++d) o[d] = f32x16{};
    bf16x8 qr[8];
    { int qrow = wid * 32 + r32; qrow = qrow < a.nvalid ? qrow : a.nvalid - 1;
      const bf16_t* Qw = a.Q + (size_t)qrow * a.qstride + hi * 8;
#pragma unroll
      for (int d0 = 0; d0 < 8; ++d0) qr[d0] = *(const bf16x8*)(Qw + d0 * 16); }
    const int sr = tid >> 4, sc = (tid & 15) * 8;
    const int vb0 = (int)(uintptr_t)V_lds + v_rd_base(lane);
    bf16x8 sv[4], sk[4];
#define SLOAD(k0) do { _Pragma("unroll") for (int j_ = 0; j_ < 4; ++j_) { sv[j_] = *(const bf16x8*)(a.V + (size_t)((k0) + sr + 16 * j_) * a.kvstride + sc); \
        sk[j_] = *(const bf16x8*)(a.K + (size_t)((k0) + sr + 16 * j_) * a.kvstride + sc); } } while (0)
#define SWRITE(b) do { _Pragma("unroll") for (int j_ = 0; j_ < 4; ++j_) { *(LAS bf16x8*)(V_lds + (b) * SHM_V + v_st(sr + 16 * j_, sc)) = sv[j_]; \
        *(LAS bf16x8*)(K_lds + (b) * SHM_K + KSWZ(sr + 16 * j_, sc * 2)) = sk[j_]; } } while (0)
    const int nt = a.ntiles;
    float R = 1.f, lsum = 0.f;
    const int qpos = a.qpos0 + wid * 32 + r32;
    const int qmax_w = a.qpos0 + wid * 32 + 31;
    group_bar(gb, lane);
    { const int t0 = (MODE == 0) ? nt - 1 : 0; SLOAD(t0 * 64); SWRITE(0); }
    group_bar(gb, lane);
    for (int j = 0; j < nt; ++j) {
        const int cur = j & 1, t = (MODE == 0) ? nt - 1 - j : j;
        if (j + 1 < nt) { const int tn = (MODE == 0) ? t - 1 : t + 1; SLOAD(tn * 64); }
        const bool active = (MODE == 1) || (t * 64 < qmax_w);
        if (active) {
            const LAS unsigned char* Ks = K_lds + cur * SHM_K;
            const bool diag = (MODE == 0) && (t * 64 + 63 >= a.qpos0);
#define ATT_BLOCK(B) do { f32x16 pb_[1]; { const float init = (MODE == 0) ? a.bias2 : 0.f; _Pragma("unroll") for (int r = 0; r < 16; ++r) pb_[0][r] = init; } \
            _Pragma("unroll") for (int d0 = 0; d0 < 8; ++d0) { const int cb = (d0 * 16 + hi * 8) * 2; \
                const bf16x8 kf = *(const LAS bf16x8*)(Ks + KSWZ(32 * (B) + r32, cb)); \
                pb_[0] = __builtin_amdgcn_mfma_f32_32x32x16_bf16(kf, qr[d0], pb_[0], 0, 0, 0); } \
            if (MODE == 0) { if (diag) sb_transform<1, true>(pb_, R, hi, t * 64 + 32 * (B), qpos); else sb_transform<1, false>(pb_, R, hi, 0, 0); } \
            else { float ps = 0.f; _Pragma("unroll") for (int r = 0; r < 16; ++r) { pb_[0][r] = fast_exp2(pb_[0][r]); ps += pb_[0][r]; } lsum += ps; } \
            bf16x8 pa_[2]; pack_p(pb_[0], pa_[0], pa_[1]); SBAR(); \
            pv_blk<2 * (B)>(o, vb0 + cur * SHM_V, pa_); } while (0)
            ATT_BLOCK(1);
            ATT_BLOCK(0);
#undef ATT_BLOCK
        }
        if (j + 1 < nt) SWRITE(cur ^ 1);
        group_bar(gb, lane);
    }
#undef SLOAD
#undef SWRITE
    float rl[16];
    if (MODE == 1) {
        lsum += __shfl_xor(lsum, 32);
        if (hi == 0) wsf[r32] = lsum;
        asm volatile("s_waitcnt lgkmcnt(0)" ::: "memory");
#pragma unroll
        for (int r = 0; r < 16; ++r) rl[r] = fast_rcp(wsf[crow(r, hi)]);
    }
    LAS unsigned char* ost = lds + wid * (32 * 272);
#pragma unroll
    for (int r = 0; r < 16; ++r)
#pragma unroll
        for (int d0 = 0; d0 < 4; ++d0) { float v = o[d0][r]; if (MODE == 1) v *= rl[r];
            *(LAS bf16_t*)(ost + crow(r, hi) * 272 + (d0 * 32 + r32) * 2) = f2bf(v); }
    asm volatile("s_waitcnt lgkmcnt(0)" ::: "memory");
    {
        const int row = wid * 32 + (lane >> 1), c0 = (lane & 1) * 64;
        if (row < a.nvalid) {
            const bf16_t* gp = a.gate + (size_t)row * a.gstride + c0; bf16_t* op = a.out + (size_t)row * a.ostride + c0;
            u32x4 gv[8];
#pragma unroll
            for (int j = 0; j < 8; ++j) gv[j] = *(const u32x4*)(gp + 8 * j);
#pragma unroll
            for (int j = 0; j < 8; ++j) { const u32x4 ov = *(const LAS u32x4*)(ost + (lane >> 1) * 272 + (c0 + 8 * j) * 2); u32x4 w;
#pragma unroll
                for (int e = 0; e < 4; ++e) w[e] = cvtpk(bf_lo(ov[e]) * silu_f(bf_lo(gv[j][e])), bf_hi(ov[e]) * silu_f(bf_hi(gv[j][e])));
                *(u32x4*)(op + 8 * j) = w; }
        }
    }
}

__device__ __forceinline__ void sb_transform16(f32x4 (&st)[2], float& R, int lane, int kg) {
    float T[2];
#pragma unroll
    for (int rb = 0; rb < 2; ++rb) {
        float be[4], f[4];
#pragma unroll
        for (int i = 0; i < 4; ++i) { const float z = fmaxf(st[rb][i], -100.f); const float e = fast_exp2(-z), rc = fast_rcp(1.f + e); be[i] = rc; f[i] = e * rc; }
        const float e2 = f[3], e1 = f[2] * f[3], e0 = f[1] * e1;
        T[rb] = f[0] * e0;
        st[rb][0] = be[0] * e0; st[rb][1] = be[1] * e1; st[rb][2] = be[2] * e2; st[rb][3] = be[3];
    }
    float Tg[8];
#pragma unroll
    for (int k2 = 0; k2 < 4; ++k2) { const int src = ((lane & 15) + 16 * k2) * 4;
        Tg[k2] = __builtin_bit_cast(float, __builtin_amdgcn_ds_bpermute(src, __builtin_bit_cast(int, T[0])));
        Tg[4 + k2] = __builtin_bit_cast(float, __builtin_amdgcn_ds_bpermute(src, __builtin_bit_cast(int, T[1]))); }
    float S[8]; S[7] = R;
#pragma unroll
    for (int G = 6; G >= 0; --G) S[G] = S[G + 1] * Tg[G + 1];
    const float E0 = kg == 0 ? S[0] : kg == 1 ? S[1] : kg == 2 ? S[2] : S[3];
    const float E1 = kg == 0 ? S[4] : kg == 1 ? S[5] : kg == 2 ? S[6] : S[7];
    st[0] = st[0] * E0; st[1] = st[1] * E1;
    R = S[0] * Tg[0];
}

constexpr int L0_FIRST = 96, L0_PAGES = NPAGES - L0_FIRST;
constexpr float SKIP_THR = 1.4551915e-11f;
constexpr int CW_L0CNT = 8192;
constexpr int N_DEC_L0 = DSEQ * 8 * L0_PAGES, N_DEC_ITEMS = N_DEC_L0 + DSEQ * 8 * (L0_FIRST / 2);
template <bool SC1>
__device__ __forceinline__ bool decode_skip_old_pages(const float* FPARTp, int seq, int head, int lane) {
    const float* Fp = FPARTp + ((size_t)((seq * 8 + head) * NPAGES + L0_FIRST)) * DTOK;
    const int q = lane & 7, grp = lane >> 3;
    float f[4];
#pragma unroll
    for (int k = 0; k < 4; ++k) { const float* a = Fp + (grp * 4 + k) * DTOK + q;
        f[k] = SC1 ? __builtin_bit_cast(float, __hip_atomic_load((const unsigned*)a, __ATOMIC_RELAXED, __HIP_MEMORY_SCOPE_AGENT)) : *a; }
    float pr = (f[0] * f[1]) * (f[2] * f[3]);
    pr *= __shfl_xor(pr, 8); pr *= __shfl_xor(pr, 16); pr *= __shfl_xor(pr, 32);
    float m = pr; m = fmaxf(m, __shfl_xor(m, 1)); m = fmaxf(m, __shfl_xor(m, 2)); m = fmaxf(m, __shfl_xor(m, 4));
    return m < SKIP_THR;
}

__device__ __forceinline__ void decode_page(const int* ptab, const float* ck, const float* cv, const float* sbbias, unsigned char* ws, LAS unsigned char* wlds, int seq, int page, int head, int lane) {
    const int j16 = lane & 15, kg = lane >> 4;
    constexpr int VLD = 272;
    LAS unsigned char* K_lds = wlds; LAS unsigned char* V_lds = wlds + 8192; LAS unsigned char* Q_lds = wlds + 8192 + 8704;
    const bf16_t* PROJ = (const bf16_t*)(ws + WS_PROJ);
    const int phys = __builtin_amdgcn_readfirstlane(ptab[seq * NPAGES + page]);
    const float bias2 = sbbias[head] * LOG2E;
    f32x4 o[8];
#pragma unroll
    for (int d = 0; d < 8; ++d) o[d] = f32x4{0.f, 0.f, 0.f, 0.f};
    float R = 1.f;
    const int srow = lane >> 4, scol = (lane & 15) * 8;
    const int vtr = (int)(uintptr_t)V_lds + (4 * kg + (j16 >> 2)) * VLD + 8 * (j16 & 3);
#pragma unroll
    for (int i = 0; i < 2; ++i) { const int c = lane + 64 * i, qrw = c >> 4, qc = (c & 15) * 8;
        *(LAS bf16x8*)(Q_lds + KSWZ(qrw, qc * 2)) = *(const bf16x8*)(PROJ + (size_t)(MP + seq * DTOK + qrw) * NPAD + PC_Q + head * 128 + qc); }
    f32x4 sk[16], sv[16];
    const __amdgpu_buffer_rsrc_t rK = __builtin_amdgcn_make_buffer_rsrc((void*)(ck + (size_t)phys * (PAGE * 1024)), 0, PAGE * 1024 * 4, 0x00020000);
    const __amdgpu_buffer_rsrc_t rV = __builtin_amdgcn_make_buffer_rsrc((void*)(cv + (size_t)phys * (PAGE * 1024)), 0, PAGE * 1024 * 4, 0x00020000);
    const int voff = (srow * 1024 + head * 128 + scol) * 4;
#define DLOAD(dst, rs, kb) do { _Pragma("unroll") for (int i = 0; i < 8; ++i) { const int so_ = ((kb) * 32 + 4 * i) * 4096; \
        dst[2 * i] = __builtin_bit_cast(f32x4, __builtin_amdgcn_raw_buffer_load_b128(rs, voff, so_, 2)); dst[2 * i + 1] = __builtin_bit_cast(f32x4, __builtin_amdgcn_raw_buffer_load_b128(rs, voff + 16, so_, 2)); } } while (0)
    DLOAD(sk, rK, 3); DLOAD(sv, rV, 3);
#pragma unroll 1
    for (int kb = 3; kb >= 0; --kb) {
#pragma unroll
        for (int i = 0; i < 8; ++i) { u32x4 w; w.x = cvtpk(sk[2 * i].x, sk[2 * i].y); w.y = cvtpk(sk[2 * i].z, sk[2 * i].w); w.z = cvtpk(sk[2 * i + 1].x, sk[2 * i + 1].y); w.w = cvtpk(sk[2 * i + 1].z, sk[2 * i + 1].w);
            *(LAS u32x4*)(K_lds + KSWZ(srow + 4 * i, scol * 2)) = w; }
        if (kb > 0) DLOAD(sk, rK, kb - 1);
        f32x4 st[2];
        st[0] = f32x4{bias2, bias2, bias2, bias2}; st[1] = st[0];
#pragma unroll
        for (int ks = 0; ks < 4; ++ks) { const int cb = (32 * ks + 8 * kg) * 2;
            const bf16x8 qf = *(const LAS bf16x8*)(Q_lds + KSWZ(j16 & 7, cb));
            const bf16x8 k0 = *(const LAS bf16x8*)(K_lds + KSWZ(j16, cb)), k1 = *(const LAS bf16x8*)(K_lds + KSWZ(16 + j16, cb));
            st[0] = __builtin_amdgcn_mfma_f32_16x16x32_bf16(k0, qf, st[0], 0, 0, 0);
            st[1] = __builtin_amdgcn_mfma_f32_16x16x32_bf16(k1, qf, st[1], 0, 0, 0); }
        sb_transform16(st, R, lane, kg);
        u32x4 af; af.x = cvtpk(st[0][0], st[0][1]); af.y = cvtpk(st[0][2], st[0][3]); af.z = cvtpk(st[1][0], st[1][1]); af.w = cvtpk(st[1][2], st[1][3]);
        const bf16x8 pfrag = __builtin_bit_cast(bf16x8, af);
#pragma unroll
        for (int i = 0; i < 8; ++i) { u32x4 w; w.x = cvtpk(sv[2 * i].x, sv[2 * i].y); w.y = cvtpk(sv[2 * i].z, sv[2 * i].w); w.z = cvtpk(sv[2 * i + 1].x, sv[2 * i + 1].y); w.w = cvtpk(sv[2 * i + 1].z, sv[2 * i + 1].w);
            *(LAS u32x4*)(V_lds + (srow + 4 * i) * VLD + scol * 2) = w; }
        if (kb > 0) DLOAD(sv, rV, kb - 1);
        SBAR();
#define DPV4(D0) do { const s16x4 l0_ = tr_read<(D0) * 32>(vtr), h0_ = tr_read<(D0) * 32 + 16 * VLD>(vtr), l1_ = tr_read<(D0 + 1) * 32>(vtr), h1_ = tr_read<(D0 + 1) * 32 + 16 * VLD>(vtr); \
        const s16x4 l2_ = tr_read<(D0 + 2) * 32>(vtr), h2_ = tr_read<(D0 + 2) * 32 + 16 * VLD>(vtr), l3_ = tr_read<(D0 + 3) * 32>(vtr), h3_ = tr_read<(D0 + 3) * 32 + 16 * VLD>(vtr); \
        asm volatile("s_waitcnt lgkmcnt(0)" ::: "memory"); SBAR(); \
        o[D0] = __builtin_amdgcn_mfma_f32_16x16x32_bf16(pfrag, PKV(l0_, h0_), o[D0], 0, 0, 0); o[D0 + 1] = __builtin_amdgcn_mfma_f32_16x16x32_bf16(pfrag, PKV(l1_, h1_), o[D0 + 1], 0, 0, 0); \
        o[D0 + 2] = __builtin_amdgcn_mfma_f32_16x16x32_bf16(pfrag, PKV(l2_, h2_), o[D0 + 2], 0, 0, 0); o[D0 + 3] = __builtin_amdgcn_mfma_f32_16x16x32_bf16(pfrag, PKV(l3_, h3_), o[D0 + 3], 0, 0, 0); } while (0)
        DPV4(0); DPV4(4);
#undef DPV4
    }
#undef DLOAD
    if (kg < 2) {
        float* Op = (float*)(ws + WS_OPART) + ((size_t)((seq * 8 + head) * NPAGES + page)) * (DTOK * 128);
#pragma unroll
        for (int db = 0; db < 8; ++db)
#pragma unroll
            for (int r = 0; r < 4; ++r) Op[(4 * kg + r) * 128 + 16 * db + j16] = o[db][r];
    }
    if (lane < 8) __hip_atomic_store((unsigned*)(ws + WS_FPART) + ((size_t)((seq * 8 + head) * NPAGES + page)) * DTOK + lane, __builtin_bit_cast(unsigned, R), __ATOMIC_RELAXED, __HIP_MEMORY_SCOPE_AGENT);
}
__device__ __forceinline__ void decode_wave_loop(const int* ptab, const float* ck, const float* cv, const float* sbbias, unsigned char* ws, LAS unsigned char* wlds, unsigned* qhead, int lane) {
    int ckey = -1; bool cskip = false;
    unsigned* l0cnt = (unsigned*)(ws + WS_CTL) + CW_L0CNT;
    for (;;) {
        unsigned it = 0; if (lane == 0) it = __hip_atomic_fetch_add(qhead, 1u, __ATOMIC_RELAXED, __HIP_MEMORY_SCOPE_AGENT);
        it = __builtin_amdgcn_readfirstlane(it);
        if (it >= (unsigned)N_DEC_ITEMS) break;
        int seq, head, page0, npages;
        if (it < (unsigned)N_DEC_L0) { head = it & 7; page0 = L0_FIRST + ((it >> 3) & 31); seq = it >> 8; npages = 1; }
        else {
            const int j = (int)it - N_DEC_L0, rem = j % (DSEQ * (L0_FIRST / 2));
            head = 7 - j / (DSEQ * (L0_FIRST / 2)); seq = rem / (L0_FIRST / 2); page0 = 2 * (rem % (L0_FIRST / 2)); npages = 2;
            const int key = seq * 8 + head;
            if (key != ckey) {
                unsigned ok = 1u, sp = 0u;
                while (__builtin_amdgcn_readfirstlane(__hip_atomic_load(l0cnt + 64 * key, __ATOMIC_RELAXED, __HIP_MEMORY_SCOPE_AGENT)) < (unsigned)L0_PAGES) { __builtin_amdgcn_s_sleep(8); if (++sp > (1u << 20)) { ok = 0u; break; } }
                cskip = ok ? decode_skip_old_pages<true>((const float*)(ws + WS_FPART), seq, head, lane) : false; ckey = key;
            }
            if (cskip) continue;
        }
#pragma unroll 1
        for (int pg = 0; pg < npages; ++pg) decode_page(ptab, ck, cv, sbbias, ws, wlds, seq, page0 + pg, head, lane);
        if (npages == 1) {
            asm volatile("s_waitcnt vmcnt(0)" ::: "memory");
            if (lane == 0) __hip_atomic_fetch_add(l0cnt + 64 * (seq * 8 + head), 1u, __ATOMIC_RELAXED, __HIP_MEMORY_SCOPE_AGENT);
        }
    }
}

constexpr int SS_LD = 272;
__device__ __forceinline__ void scan128(float& v0, float& v1, int lane) {
#pragma unroll
    for (int o = 1; o < 64; o <<= 1) { const float t0 = __shfl_up(v0, o), t1 = __shfl_up(v1, o); if (lane >= o) { v0 += t0; v1 += t1; } }
    v1 += __shfl(v0, 63);
}
__device__ __forceinline__ void tr4x8(const u32x4 (&w)[4], u32x2 (&o)[8]) {
#pragma unroll
    for (int k = 0; k < 8; ++k) { const int d = k >> 1;
        if (k & 1) { o[k].x = (w[0][d] >> 16) | (w[1][d] & 0xffff0000u); o[k].y = (w[2][d] >> 16) | (w[3][d] & 0xffff0000u); }
        else       { o[k].x = (w[0][d] & 0xffffu) | (w[1][d] << 16);     o[k].y = (w[2][d] & 0xffffu) | (w[3][d] << 16); } }
}
template <bool SAMPLE>
__device__ __forceinline__ void conv_load(const bf16_t* PROJ, const float* sconv0, int rowbase, int bs, bool first_chunk, int l0, int ch0, u32x4 (&rw)[7]) {
#pragma unroll
    for (int r = 0; r < 7; ++r) { const int l = l0 - 3 + r;
        if (l >= 0 || !first_chunk) rw[r] = *(const u32x4*)(PROJ + (size_t)(rowbase + l) * NPAD + PC_XBC + ch0);
        else if (SAMPLE) { const f32x4* sp = (const f32x4*)(sconv0 + ((size_t)bs * 3 + (3 + l)) * 1024 + ch0); const f32x4 u0 = sp[0], u1 = sp[1];
            rw[r].x = cvtpk(u0.x, u0.y); rw[r].y = cvtpk(u0.z, u0.w); rw[r].z = cvtpk(u1.x, u1.y); rw[r].w = cvtpk(u1.z, u1.w); }
        else rw[r] = u32x4{0u, 0u, 0u, 0u}; }
}
__device__ __forceinline__ void conv_apply(const float* convw, const float* convb, int ch0, const u32x4 (&rw)[7], float (&ov)[4][8]) {
    float cw[4][8], cbv[8];
#pragma unroll
    for (int jj = 0; jj < 4; ++jj) { const f32x4* sp = (const f32x4*)(convw + jj * 1024 + ch0); const f32x4 u0 = sp[0], u1 = sp[1];
        cw[jj][0] = u0.x; cw[jj][1] = u0.y; cw[jj][2] = u0.z; cw[jj][3] = u0.w; cw[jj][4] = u1.x; cw[jj][5] = u1.y; cw[jj][6] = u1.z; cw[jj][7] = u1.w; }
    { const f32x4* sp = (const f32x4*)(convb + ch0); const f32x4 u0 = sp[0], u1 = sp[1];
        cbv[0] = u0.x; cbv[1] = u0.y; cbv[2] = u0.z; cbv[3] = u0.w; cbv[4] = u1.x; cbv[5] = u1.y; cbv[6] = u1.z; cbv[7] = u1.w; }
#pragma unroll
    for (int r = 0; r < 4; ++r)
#pragma unroll
        for (int k = 0; k < 8; ++k) { float t = cbv[k];
#pragma unroll
            for (int jj = 0; jj < 4; ++jj) { const unsigned w = rw[r + jj][k >> 1]; t = fmaf((k & 1) ? bf_hi(w) : bf_lo(w), cw[jj][k], t); }
            ov[r][k] = silu_f(t); }
}
constexpr int ST_BT = 0, ST_XTW = 34816, ST_F = 104448;
template <bool SAMPLE>
__device__ __forceinline__ void ssd_state_unit(unsigned char* ws, const float* alog, const float* sconv0, const float* convw, const float* convb, LAS unsigned char* lds, int bs, int c, int g) {
    int tid = threadIdx.x; asm volatile("" : "+v"(tid));
    const int wid = __builtin_amdgcn_readfirstlane(tid >> 6), lane = tid & 63, j16 = lane & 15, ig = lane >> 4;
    const int rowbase = SAMPLE ? MP + bs * DTOK : bs * SEQ + c * 128;
    constexpr int NTOK = SAMPLE ? DTOK : 128;
    const bf16_t* PROJ = (const bf16_t*)(ws + WS_PROJ);
    const bool first_chunk = SAMPLE || c == 0;
    const float* DTS = (const float*)(ws + WS_DT);
    LAS float* xwf = (LAS float*)(lds + ST_F);
    const int sidx0 = SAMPLE ? 512 + bs * 8 + 4 * g : (bs * 8 + 4 * g) * 16 + c;
    __syncthreads();
    if (wid < 4) {
        const int h = 4 * g + wid; const float a_h = -__expf(alog[h]);
        float d0 = (lane < NTOK) ? DTS[(size_t)(rowbase + lane) * 8 + h] : 0.f, d1 = (lane + 64 < NTOK) ? DTS[(size_t)(rowbase + lane + 64) * 8 + h] : 0.f;
        float c0 = d0 * a_h, c1 = d1 * a_h;
        scan128(c0, c1, lane);
        const float cs_end = __shfl(c1, 63);
        xwf[wid * 128 + lane] = d0 * __expf(cs_end - c0); xwf[wid * 128 + 64 + lane] = d1 * __expf(cs_end - c1);
        if (lane == 0) ((float*)(ws + WS_SUMDT))[sidx0 + (SAMPLE ? wid : 16 * wid)] = cs_end;
    }
    __syncthreads();
    {
        const int ccb = tid & 15, lb = 4 * (tid >> 4);
        const int hx0 = tid >> 8, cx0 = tid & 7, lx0 = 4 * ((tid & 255) >> 3);
        bf16_t* XA = (bf16_t*)(ws + WS_XA);
        u32x4 rb[7], rc[7], rx0[7], rx1[7];
        conv_load<SAMPLE>(PROJ, sconv0, rowbase, bs, first_chunk, lb, 512 + g * 128 + 8 * ccb, rb);
        conv_load<SAMPLE>(PROJ, sconv0, rowbase, bs, first_chunk, lb, 768 + g * 128 + 8 * ccb, rc);
        conv_load<SAMPLE>(PROJ, sconv0, rowbase, bs, first_chunk, lx0, (4 * g + hx0) * 64 + 8 * cx0, rx0);
        conv_load<SAMPLE>(PROJ, sconv0, rowbase, bs, first_chunk, lx0, (4 * g + hx0 + 2) * 64 + 8 * cx0, rx1);
        float ov[4][8];
        conv_apply(convw, convb, 512 + g * 128 + 8 * ccb, rb, ov);
#pragma unroll
        for (int k = 0; k < 8; ++k) { u32x2 o; o.x = cvtpk(ov[0][k], ov[1][k]); o.y = cvtpk(ov[2][k], ov[3][k]);
            *(LAS u32x2*)(lds + ST_BT + (8 * ccb + k) * SS_LD + lb * 2) = o; }
#pragma unroll
        for (int r = 0; r < 4; ++r) { u32x4 w; w.x = cvtpk(ov[r][0], ov[r][1]); w.y = cvtpk(ov[r][2], ov[r][3]); w.z = cvtpk(ov[r][4], ov[r][5]); w.w = cvtpk(ov[r][6], ov[r][7]);
            if (!SAMPLE || lb + r < NTOK) *(u32x4*)(XA + (size_t)(rowbase + lb + r) * 1024 + 512 + g * 128 + 8 * ccb) = w; }
        conv_apply(convw, convb, 768 + g * 128 + 8 * ccb, rc, ov);
#pragma unroll
        for (int r = 0; r < 4; ++r) { u32x4 w; w.x = cvtpk(ov[r][0], ov[r][1]); w.y = cvtpk(ov[r][2], ov[r][3]); w.z = cvtpk(ov[r][4], ov[r][5]); w.w = cvtpk(ov[r][6], ov[r][7]);
            if (!SAMPLE || lb + r < NTOK) *(u32x4*)(XA + (size_t)(rowbase + lb + r) * 1024 + 768 + g * 128 + 8 * ccb) = w; }
#pragma unroll
        for (int i = 0; i < 2; ++i) { const int hh = hx0 + 2 * i;
            float xw[4];
#pragma unroll
            for (int r = 0; r < 4; ++r) xw[r] = xwf[hh * 128 + lx0 + r];
            conv_apply(convw, convb, (4 * g + hh) * 64 + 8 * cx0, i ? rx1 : rx0, ov);
#pragma unroll
            for (int r = 0; r < 4; ++r) { u32x4 w; w.x = cvtpk(ov[r][0], ov[r][1]); w.y = cvtpk(ov[r][2], ov[r][3]); w.z = cvtpk(ov[r][4], ov[r][5]); w.w = cvtpk(ov[r][6], ov[r][7]);
                if (!SAMPLE || lx0 + r < NTOK) *(u32x4*)(XA + (size_t)(rowbase + lx0 + r) * 1024 + (4 * g + hh) * 64 + 8 * cx0) = w; }
#pragma unroll
            for (int k = 0; k < 8; ++k) { u32x2 o; o.x = cvtpk(ov[0][k] * xw[0], ov[1][k] * xw[1]); o.y = cvtpk(ov[2][k] * xw[2], ov[3][k] * xw[3]);
                *(LAS u32x2*)(lds + ST_XTW + (hh * 64 + 8 * cx0 + k) * SS_LD + lx0 * 2) = o; } }
    }
    __syncthreads();
    f32x4 acc[16];
#pragma unroll
    for (int q = 0; q < 16; ++q) acc[q] = f32x4{0.f, 0.f, 0.f, 0.f};
#pragma unroll
    for (int ks = 0; ks < 4; ++ks) {
        const bf16x8 bf = *(const LAS bf16x8*)(lds + ST_BT + (16 * wid + j16) * SS_LD + (32 * ks + 8 * ig) * 2);
#pragma unroll
        for (int q = 0; q < 16; ++q) { const bf16x8 af = *(const LAS bf16x8*)(lds + ST_XTW + (16 * q + j16) * SS_LD + (32 * ks + 8 * ig) * 2);
            acc[q] = __builtin_amdgcn_mfma_f32_16x16x32_bf16(bf, af, acc[q], 0, 0, 0); } }
    float* SL = (float*)(ws + WS_SLOC);
#pragma unroll
    for (int q = 0; q < 16; ++q) { const int hh = q >> 2; const size_t sidx = (size_t)sidx0 + (SAMPLE ? hh : 16 * hh);
        *(f32x4*)(SL + (sidx * 64 + (16 * (q & 3) + j16)) * 128 + 16 * wid + 4 * ig) = acc[q]; }
}

constexpr int SO_CM = 0, SO_BM = 34816, SO_XT = 69632, SO_HB = 87040, SO_XS = 104448, SO_XS_LD = 144, SO_F = 122880;
template <bool SAMPLE>
__device__ __forceinline__ void ssd_out_unit(unsigned char* ws, float* outp, const float* alog, const float* dskip, const float* ssdnw, const float* ssm0, const float* sconv0, const float* convw, const float* convb,
                                         LAS unsigned char* lds, int bs, int c, int h) {
    int tid = threadIdx.x; asm volatile("" : "+v"(tid));
    const int wid = __builtin_amdgcn_readfirstlane(tid >> 6), lane = tid & 63, j16 = lane & 15, ig = lane >> 4;
    const int g = h >> 2;
    const int rowbase = SAMPLE ? MP + bs * DTOK : bs * SEQ + c * 128;
    constexpr int NTOK = SAMPLE ? DTOK : 128;
    const float a_h = -__expf(alog[h]), D_h = dskip[h];
    const bf16_t* PROJ = (const bf16_t*)(ws + WS_PROJ);
    const bool first_chunk = SAMPLE || c == 0;
    const float* DTS = (const float*)(ws + WS_DT); const float* SL = (const float*)(ws + WS_SLOC); const float* SUMDT = (const float*)(ws + WS_SUMDT);
    LAS float* csf = (LAS float*)(lds + SO_F); LAS float* dtf = csf + 128; LAS float* facf = csf + 256;
    const int sidx = SAMPLE ? 512 + bs * 8 + h : (bs * 8 + h) * 16 + c;
    __syncthreads();
    if (wid == 0) {
        float d0 = (lane < NTOK) ? DTS[(size_t)(rowbase + lane) * 8 + h] : 0.f, d1 = (lane + 64 < NTOK) ? DTS[(size_t)(rowbase + lane + 64) * 8 + h] : 0.f;
        float c0 = d0 * a_h, c1 = d1 * a_h;
        scan128(c0, c1, lane);
        csf[lane] = c0; csf[lane + 64] = c1; dtf[lane] = d0; dtf[lane + 64] = d1;
    } else if (wid == 1 && !SAMPLE) {
        if (lane < 16) { float sacc = 0.f; for (int q = lane + 1; q < c; ++q) sacc += SUMDT[(bs * 8 + h) * 16 + q]; facf[lane] = __expf(sacc); }
    }
    __syncthreads();
    const float cs_end = csf[127];
    {
        f32x4 hp[4];
#pragma unroll
        for (int pb = 0; pb < 4; ++pb) hp[pb] = f32x4{0.f, 0.f, 0.f, 0.f};
        if (SAMPLE) {
#pragma unroll
            for (int pb = 0; pb < 4; ++pb) hp[pb] = *(const f32x4*)(ssm0 + ((size_t)(bs * 8 + h) * 64 + 16 * pb + j16) * 128 + 16 * wid + 4 * ig);
        } else {
            const float* sp0 = SL + ((size_t)(sidx - c) * 64 + j16) * 128 + 16 * wid + 4 * ig;
#pragma unroll
            for (int q = 0; q < SEQ / 128 - 1; ++q) if (q < c) { const float f = facf[q];
#pragma unroll
                for (int pb = 0; pb < 4; ++pb) hp[pb] = hp[pb] + f * *(const f32x4*)(sp0 + ((size_t)q * 64 + 16 * pb) * 128); }
        }
#pragma unroll
        for (int pb = 0; pb < 4; ++pb) { u32x2 w; w.x = cvtpk(hp[pb].x, hp[pb].y); w.y = cvtpk(hp[pb].z, hp[pb].w);
            *(LAS u32x2*)(lds + SO_HB + (16 * pb + j16) * SS_LD + (16 * wid + 4 * ig) * 2) = w; }
        if (SAMPLE || c == SEQ / 128 - 1) {
            const float dec = __expf(cs_end); const float* sp = SL + ((size_t)sidx * 64 + j16) * 128 + 16 * wid + 4 * ig;
            float* So = outp + (SAMPLE ? O_SSSM : O_PSSM) + ((size_t)(bs * 8 + h) * 64 + j16) * 128 + 16 * wid + 4 * ig;
#pragma unroll
            for (int pb = 0; pb < 4; ++pb) *(f32x4*)(So + (16 * pb) * 128) = hp[pb] * dec + *(const f32x4*)(sp + (16 * pb) * 128);
        }
    }
    {
        const bf16_t* XA = (const bf16_t*)(ws + WS_XA);
        const int cc = tid & 15, l0 = 4 * (tid >> 4), cx = tid & 7, lx = 4 * ((tid & 255) >> 3);
        u32x4 wc[4], wb[4], wx[4];
#pragma unroll
        for (int r = 0; r < 4; ++r) { const bool lv = !SAMPLE || (l0 + r) < NTOK;
            wc[r] = lv ? *(const u32x4*)(XA + (size_t)(rowbase + l0 + r) * 1024 + 768 + g * 128 + 8 * cc) : u32x4{0u, 0u, 0u, 0u};
            wb[r] = lv ? *(const u32x4*)(XA + (size_t)(rowbase + l0 + r) * 1024 + 512 + g * 128 + 8 * cc) : u32x4{0u, 0u, 0u, 0u}; }
        if (tid < 256) {
#pragma unroll
            for (int r = 0; r < 4; ++r) wx[r] = (!SAMPLE || (lx + r) < NTOK) ? *(const u32x4*)(XA + (size_t)(rowbase + lx + r) * 1024 + h * 64 + 8 * cx) : u32x4{0u, 0u, 0u, 0u}; }
#pragma unroll
        for (int r = 0; r < 4; ++r) { *(LAS u32x4*)(lds + SO_CM + (l0 + r) * SS_LD + cc * 16) = wc[r]; *(LAS u32x4*)(lds + SO_BM + (l0 + r) * SS_LD + cc * 16) = wb[r]; }
        if (tid < 256) {
            float dl[4];
#pragma unroll
            for (int r = 0; r < 4; ++r) { dl[r] = dtf[lx + r]; *(LAS u32x4*)(lds + SO_XS + (lx + r) * SO_XS_LD + cx * 16) = wx[r]; }
#pragma unroll
            for (int k = 0; k < 8; ++k) { const int d = k >> 1; float v[4];
#pragma unroll
                for (int r = 0; r < 4; ++r) v[r] = ((k & 1) ? bf_hi(wx[r][d]) : bf_lo(wx[r][d])) * dl[r];
                u32x2 o; o.x = cvtpk(v[0], v[1]); o.y = cvtpk(v[2], v[3]);
                *(LAS u32x2*)(lds + SO_XT + (8 * cx + k) * SS_LD + lx * 2) = o; }
        }
    }
    __syncthreads();
    f32x4 cb[8];
#pragma unroll
    for (int sb = 0; sb < 8; ++sb) cb[sb] = f32x4{0.f, 0.f, 0.f, 0.f};
#pragma unroll
    for (int ks = 0; ks < 4; ++ks) {
        const bf16x8 cf = *(const LAS bf16x8*)(lds + SO_CM + (16 * wid + j16) * SS_LD + (32 * ks + 8 * ig) * 2);
#pragma unroll
        for (int sb = 0; sb < 8; ++sb) { const bf16x8 bf = *(const LAS bf16x8*)(lds + SO_BM + (16 * sb + j16) * SS_LD + (32 * ks + 8 * ig) * 2);
            cb[sb] = __builtin_amdgcn_mfma_f32_16x16x32_bf16(bf, cf, cb[sb], 0, 0, 0); } }
    __syncthreads();
    const int l = 16 * wid + j16;
    {
        const float csl = csf[l];
#pragma unroll
        for (int sb = 0; sb < 8; ++sb) { const int s0 = 16 * sb + 4 * ig; const f32x4 css = *(const LAS f32x4*)(csf + s0); float gv[4];
#pragma unroll
            for (int r = 0; r < 4; ++r) gv[r] = (s0 + r <= l) ? cb[sb][r] * __expf(csl - css[r]) : 0.f;
            u32x2 w; w.x = cvtpk(gv[0], gv[1]); w.y = cvtpk(gv[2], gv[3]);
            *(LAS u32x2*)(lds + SO_BM + l * SS_LD + s0 * 2) = w; }
    }
    f32x4 yd[4], yo[4];
#pragma unroll
    for (int pb = 0; pb < 4; ++pb) { yd[pb] = f32x4{0.f, 0.f, 0.f, 0.f}; yo[pb] = f32x4{0.f, 0.f, 0.f, 0.f}; }
#pragma unroll
    for (int ks = 0; ks < 4; ++ks) {
        const bf16x8 gf = *(const LAS bf16x8*)(lds + SO_BM + (16 * wid + j16) * SS_LD + (32 * ks + 8 * ig) * 2);
        const bf16x8 cf = *(const LAS bf16x8*)(lds + SO_CM + (16 * wid + j16) * SS_LD + (32 * ks + 8 * ig) * 2);
#pragma unroll
        for (int pb = 0; pb < 4; ++pb) {
            const bf16x8 xf = *(const LAS bf16x8*)(lds + SO_XT + (16 * pb + j16) * SS_LD + (32 * ks + 8 * ig) * 2);
            const bf16x8 hf = *(const LAS bf16x8*)(lds + SO_HB + (16 * pb + j16) * SS_LD + (32 * ks + 8 * ig) * 2);
            yd[pb] = __builtin_amdgcn_mfma_f32_16x16x32_bf16(xf, gf, yd[pb], 0, 0, 0);
            yo[pb] = __builtin_amdgcn_mfma_f32_16x16x32_bf16(hf, cf, yo[pb], 0, 0, 0); } }
    {
        bf16_t* MIX = (bf16_t*)(ws + WS_MIX); float* SSQ = (float*)(ws + WS_SSQ);
        const float el = __expf(csf[l]); float sq = 0.f;
        const bool live = l < NTOK; const size_t grow = (size_t)(rowbase + l);
        if (live) {
            u32x2 zw[4];
#pragma unroll
            for (int pb = 0; pb < 4; ++pb) zw[pb] = *(const u32x2*)(PROJ + grow * NPAD + PC_Z + h * 64 + 16 * pb + 4 * ig);
#pragma unroll
            for (int pb = 0; pb < 4; ++pb) { const int p0 = 16 * pb + 4 * ig;
                const u32x2 xw = *(const LAS u32x2*)(lds + SO_XS + l * SO_XS_LD + p0 * 2); const f32x4 gw = *(const f32x4*)(ssdnw + h * 64 + p0);
                const float xv[4] = {bf_lo(xw.x), bf_hi(xw.x), bf_lo(xw.y), bf_hi(xw.y)}, zv[4] = {bf_lo(zw[pb].x), bf_hi(zw[pb].x), bf_lo(zw[pb].y), bf_hi(zw[pb].y)};
                float y[4];
#pragma unroll
                for (int r = 0; r < 4; ++r) { y[r] = (yd[pb][r] + el * yo[pb][r] + D_h * xv[r]) * silu_f(zv[r]); sq += y[r] * y[r]; }
                u32x2 w; w.x = cvtpk(y[0] * gw.x, y[1] * gw.y); w.y = cvtpk(y[2] * gw.z, y[3] * gw.w);
                *(u32x2*)(MIX + grow * 2048 + h * 64 + p0) = w; }
        }
        sq += __shfl_xor(sq, 16); sq += __shfl_xor(sq, 32);
        if (live && ig == 0) SSQ[grow * 8 + h] = sq;
    }
}

constexpr int U_SSDP = NBATCH * 16 * 2, U_SSDSS = DSEQ * 2, U_SB = NBATCH * 8 * 16, U_MEMP = NBATCH * 16 * 4, U_MEMS = DSEQ * 4;
#ifndef PROBE_BLK
#define PROBE_BLK 0
#endif
#define PSTAMP(i) do { if (PROBE_SEG >= 20 && blockIdx.x == PROBE_BLK && threadIdx.x == 0) ((volatile LAS unsigned long long*)(ctlw + 32))[8 + (i)] = __builtin_amdgcn_s_memrealtime(); } while (0)
#define QUEUE_LOOP(qi, total, ...) for (;;) { __syncthreads(); if (threadIdx.x == 0) ctlw[16] = __hip_atomic_fetch_add(qbase + 64 * (qi), 1u, __ATOMIC_RELAXED, __HIP_MEMORY_SCOPE_AGENT); \
        __syncthreads(); const int u = (int)ctlw[16]; if (u >= (total)) break; __VA_ARGS__ }
#define GROUP_LOOP(qi, total, ...) for (int gi_ = 0;; ++gi_) { if (threadIdx.x == 0) ctlw[22 + (gi_ & 1)] = __hip_atomic_fetch_add(qbase + 64 * (qi), 1u, __ATOMIC_RELAXED, __HIP_MEMORY_SCOPE_AGENT); \
        group_bar(gb, lane); const int u = (int)ctlw[22 + (gi_ & 1)]; if (u >= (total)) break; __VA_ARGS__ }
template <int MASK> __device__ __forceinline__ void phase3(const Params& p, LAS unsigned char* lds, volatile LAS unsigned* ctlw, int qset) {
    unsigned* qbase = (unsigned*)(p.ws + WS_CTL) + CW_QUEUE + 1024 * qset;
    const bf16_t* PROJ = (const bf16_t*)(p.ws + WS_PROJ);
    bf16_t* MIX = (bf16_t*)(p.ws + WS_MIX);
    PSTAMP(4);
    QUEUE_LOOP(0, U_SSDP, { ssd_state_unit<false>(p.ws, p.in[I_ALOG], p.in[I_SCONV], p.in[I_CONVW], p.in[I_CONVB], lds, u >> 5, (u >> 1) & 15, u & 1); })
    QUEUE_LOOP(4, U_SSDSS, { ssd_state_unit<true>(p.ws, p.in[I_ALOG], p.in[I_SCONV], p.in[I_CONVW], p.in[I_CONVB], lds, u >> 1, 0, u & 1); })
    PSTAMP(5);
    const unsigned gb0 = __builtin_amdgcn_readfirstlane(ctlw[20]);
    __syncthreads();
    {
        int tid = threadIdx.x; asm volatile("" : "+v"(tid));
        const int wid = __builtin_amdgcn_readfirstlane(tid >> 6), lane = tid & 63;
        if (wid < 4) {
            GroupBar gb; gb.cnt = ctlw + 20; gb.gen = gb0;
            __builtin_amdgcn_s_setprio(1);
            GROUP_LOOP(2, U_SB, {
                const int i = 15 - (u >> 5), bh = u & 31, b = bh >> 3, h = bh & 7;
                attn_unit<0>(lds, gb, PROJ + (size_t)(b * SEQ + i * 128) * NPAD + PC_Q + h * 128, NPAD,
                             PROJ + (size_t)(b * SEQ) * NPAD + PC_K + h * 128, PROJ + (size_t)(b * SEQ) * NPAD + PC_V + h * 128, NPAD,
                             2 * (i + 1), i * 128, 128, p.in[I_SBBIAS][h] * LOG2E,
                             PROJ + (size_t)(b * SEQ + i * 128) * NPAD + PC_GSB + h * 128, NPAD, MIX + (size_t)(b * SEQ + i * 128) * 2048 + 512 + h * 128, 2048); })
            PSTAMP(6);
            GROUP_LOOP(3, U_MEMP + U_MEMS, {
                if (u < U_MEMP) { const int hm = u & 3, qb = (u >> 2) & 15, b = u >> 6; const size_t r0 = (size_t)(b * SEQ + qb * 128);
                    attn_unit<1>(lds, gb, PROJ + r0 * NPAD + PC_MQ + hm * 128, NPAD, (const bf16_t*)(p.ws + WS_MKN) + (size_t)(b * MEMT) * 512 + hm * 128, (const bf16_t*)(p.ws + WS_MVB) + (size_t)(b * MEMT) * 512 + hm * 128, 512,
                                 4, 0, 128, 0.f, PROJ + r0 * NPAD + PC_GM + hm * 128, NPAD, MIX + r0 * 2048 + 1536 + hm * 128, 2048); }
                else { const int v = u - U_MEMP, hm = v & 3, sq = v >> 2; const size_t r0 = (size_t)(MP + sq * DTOK);
                    attn_unit<1>(lds, gb, PROJ + r0 * NPAD + PC_MQ + hm * 128, NPAD, (const bf16_t*)(p.ws + WS_CMK) + (size_t)(sq * MEMT) * 512 + hm * 128, (const bf16_t*)(p.ws + WS_CMV) + (size_t)(sq * MEMT) * 512 + hm * 128, 512,
                                 4, 0, DTOK, 0.f, PROJ + r0 * NPAD + PC_GM + hm * 128, NPAD, MIX + r0 * 2048 + 1536 + hm * 128, 2048); } })
            group_bar(gb, lane);
            __builtin_amdgcn_s_setprio(0);
            PSTAMP(7);
        }
        LAS unsigned char* wlds = lds + (wid < 4 ? wid * 19456 : 77824 + (wid - 4) * 19456);
        decode_wave_loop((const int*)p.in[I_PT], p.in[I_CK], p.in[I_CV], p.in[I_SBBIAS], p.ws, wlds, qbase + 64 * 1, lane);
    }
    __syncthreads();
    PSTAMP(8);
}

__device__ __forceinline__ void phase4(const Params& p, LAS unsigned char* lds, volatile LAS unsigned* ctlw, int vcu, int G, int qset) {
    const int tid = threadIdx.x, lane = tid & 63, wave = __builtin_amdgcn_readfirstlane(tid >> 6);
    bf16_t* MIX = (bf16_t*)(p.ws + WS_MIX);
    const bf16_t* PROJ = (const bf16_t*)(p.ws + WS_PROJ);
    unsigned* qbase = (unsigned*)(p.ws + WS_CTL) + CW_QUEUE + 1024 * qset;
    PSTAMP(2);
    for (int u = G - 1 - (int)blockIdx.x; u < DSEQ * 8; u += G) {
        const int seq = u >> 3, head = u & 7, i = wave;
        const int row = MP + seq * DTOK + i;
        const float bias2 = p.in[I_SBBIAS][head] * LOG2E;
        const unsigned qw = *(const unsigned*)(PROJ + (size_t)row * NPAD + PC_Q + head * 128 + 2 * lane);
        const float q0 = bf_lo(qw), q1 = bf_hi(qw);
        float acc0 = 0.f, acc1 = 0.f, R = 1.f;
        for (int j = DTOK - 1; j >= 0; --j) {
            const f32x2 kv = *(const f32x2*)(p.out + O_SK + (size_t)(seq * DTOK + j) * 1024 + head * 128 + 2 * lane);
            const float kb0 = bf2f(f2bf(kv.x)), kb1 = bf2f(f2bf(kv.y));
            const float z = fmaxf(wave_sum(q0 * kb0 + q1 * kb1) + bias2, -100.f);
            if (j < i) {
                const float e = fast_exp2(-z), rc = fast_rcp(1.f + e);
                const f32x2 vv = *(const f32x2*)(p.out + O_SV + (size_t)(seq * DTOK + j) * 1024 + head * 128 + 2 * lane);
                const float w = rc * R; acc0 += w * vv.x; acc1 += w * vv.y; R *= e * rc;
            }
        }
        const float* Op = (const float*)(p.ws + WS_OPART) + (size_t)((seq * 8 + head) * NPAGES) * (DTOK * 128) + i * 128 + 2 * lane;
        const float* Fp = (const float*)(p.ws + WS_FPART) + (size_t)((seq * 8 + head) * NPAGES) * DTOK + i;
        const int pg_lo = decode_skip_old_pages<false>((const float*)(p.ws + WS_FPART), seq, head, lane) ? L0_FIRST : 0;
        for (int pg0 = NPAGES - 16; pg0 >= pg_lo; pg0 -= 16) {
            f32x2 ov[16]; float fv[16];
#pragma unroll
            for (int q = 0; q < 16; ++q) { ov[q] = *(const f32x2*)(Op + (size_t)(pg0 + q) * (DTOK * 128)); fv[q] = Fp[(size_t)(pg0 + q) * DTOK]; }
#pragma unroll
            for (int q = 15; q >= 0; --q) { acc0 += R * ov[q].x; acc1 += R * ov[q].y; R *= fv[q]; }
        }
        const unsigned gwd = *(const unsigned*)(PROJ + (size_t)row * NPAD + PC_GSB + head * 128 + 2 * lane);
        *(unsigned*)(MIX + (size_t)row * 2048 + 512 + head * 128 + 2 * lane) = cvtpk(acc0 * silu_f(bf_lo(gwd)), acc1 * silu_f(bf_hi(gwd)));
    }
    PSTAMP(3);
    PSTAMP(0);
    QUEUE_LOOP(5, NBATCH * 16 * 8, { const int v = NBATCH * 16 * 8 - 1 - u;
        ssd_out_unit<false>(p.ws, p.out, p.in[I_ALOG], p.in[I_DSKIP], p.in[I_SSDNW], p.in[I_SSM], p.in[I_SCONV], p.in[I_CONVW], p.in[I_CONVB], lds, (v >> 3) & 3, v >> 5, v & 7); })
    PSTAMP(1);
    QUEUE_LOOP(6, DSEQ * 8, { ssd_out_unit<true>(p.ws, p.out, p.in[I_ALOG], p.in[I_DSKIP], p.in[I_SSDNW], p.in[I_SSM], p.in[I_SCONV], p.in[I_CONVW], p.in[I_CONVB], lds, u >> 3, 0, u & 7); })
}

struct Epi5 {
    static constexpr int MID = 8;
    const float* xp; float* out; const float* SSQ;
    __device__ __forceinline__ void mid(pg8::Acc& acc, const pg8::Unit& u, int wr, int fr) const {
        int rl0 = wr * 64 + fr; asm volatile("" : "+v"(rl0));
#pragma unroll
        for (int ai = 0; ai < 2; ++ai)
#pragma unroll
            for (int m = 0; m < 4; ++m) { const size_t row = (size_t)u.pm * 256 + rl0 + ai * 128 + m * 16;
                const f32x4 s0 = *(const f32x4*)(SSQ + row * 8), s1 = *(const f32x4*)(SSQ + row * 8 + 4);
                const float rs = 1.f / sqrtf((((s0.x + s0.y) + (s0.z + s0.w)) + ((s1.x + s1.y) + (s1.z + s1.w))) * (1.f / 512.f) + EPS);
#pragma unroll
                for (int bj = 0; bj < 2; ++bj)
#pragma unroll
                    for (int n = 0; n < 2; ++n) acc[ai][bj][m][n] = acc[ai][bj][m][n] * rs; }
    }
    __device__ __forceinline__ void operator()(pg8::Acc& acc, const pg8::Unit& u, int wr, int wc, int fr, int fq) const {
        int rl0 = wr * 64 + fr, cl0 = u.pn * 256 + wc * 32 + 4 * fq;
        asm volatile("" : "+v"(rl0), "+v"(cl0));
        const float* xb = xp + (size_t)u.pm * 256 * DM; float* ob = out + O_YP + (size_t)u.pm * 256 * DM;
#pragma unroll
        for (int ai = 0; ai < 2; ++ai)
#pragma unroll
            for (int m = 0; m < 4; ++m) { const int row = rl0 + ai * 128 + m * 16; const float* xr = xb + (size_t)row * DM + cl0; float* orow = ob + (size_t)row * DM + cl0;
#pragma unroll
                for (int bj = 0; bj < 2; ++bj)
#pragma unroll
                    for (int n = 0; n < 2; ++n) *(f32x4*)(orow + bj * 128 + n * 16) = *(const f32x4*)(xr + bj * 128 + n * 16) + acc[ai][bj][m][n]; }
    }
};
__device__ __forceinline__ void sample_outproj(const Params& p, LAS unsigned char* lds, int c) {
    int tid = threadIdx.x; asm volatile("" : "+v"(tid));
    const int wid = __builtin_amdgcn_readfirstlane(tid >> 6), lane = tid & 63, j16 = lane & 15, ig = lane >> 4;
    const bf16_t* MIX = (const bf16_t*)(p.ws + WS_MIX) + (size_t)MP * 2048; const bf16_t* WT = (const bf16_t*)(p.ws + WS_WOUT) + (size_t)(16 * c) * 2048;
    const float* SSQ = (const float*)(p.ws + WS_SSQ) + (size_t)MP * 8;
    f32x4 acc[4];
#pragma unroll
    for (int rb = 0; rb < 4; ++rb) acc[rb] = f32x4{0.f, 0.f, 0.f, 0.f};
#pragma unroll
    for (int ks = 0; ks < 8; ++ks) { const int k = 256 * wid + 32 * ks + 8 * ig;
        const bf16x8 bf = *(const bf16x8*)(WT + (size_t)j16 * 2048 + k);
#pragma unroll
        for (int rb = 0; rb < 4; ++rb) { const bf16x8 af = *(const bf16x8*)(MIX + (size_t)(16 * rb + j16) * 2048 + k);
            acc[rb] = __builtin_amdgcn_mfma_f32_16x16x32_bf16(af, bf, acc[rb], 0, 0, 0); } }
    if (wid < 2) {
#pragma unroll
        for (int rb = 0; rb < 4; ++rb)
#pragma unroll
            for (int r = 0; r < 4; ++r) { const int row = 16 * rb + 4 * ig + r; const f32x4 s0 = *(const f32x4*)(SSQ + row * 8), s1 = *(const f32x4*)(SSQ + row * 8 + 4);
                acc[rb][r] *= 1.f / sqrtf((((s0.x + s0.y) + (s0.z + s0.w)) + ((s1.x + s1.y) + (s1.z + s1.w))) * (1.f / 512.f) + EPS); }
    }
    __syncthreads();
    LAS float* red = (LAS float*)lds;
#pragma unroll
    for (int rb = 0; rb < 4; ++rb)
#pragma unroll
        for (int r = 0; r < 4; ++r) red[(wid * 64 + 16 * rb + 4 * ig + r) * 16 + j16] = acc[rb][r];
    __syncthreads();
#pragma unroll
    for (int i = 0; i < 2; ++i) { const int e = tid + 512 * i, row = e >> 4, col = e & 15; float v = 0.f;
#pragma unroll
        for (int w = 0; w < 8; ++w) v += red[(w * 64 + row) * 16 + col];
        p.out[O_YS + (size_t)row * DM + 16 * c + col] = p.in[I_XS][(size_t)row * DM + 16 * c + col] + v; }
}

__device__ __forceinline__ void probe_flush(const Params& p, int vcu, int G) {
    const f32x4* src = (const f32x4*)p.in[I_CK]; const size_t n16 = (size_t)40 * 1024 * 1024; f32x4 a = f32x4{0.f, 0.f, 0.f, 0.f};
    for (size_t i = (size_t)vcu * 512 + threadIdx.x; i < n16; i += (size_t)G * 512) a = a + __builtin_nontemporal_load(src + i);
    if (a.x + a.y + a.z + a.w == 1.2345e-30f) ((float*)(p.ws + WS_CTL))[2048] = a.x;
}
constexpr int NPHASE = 6;
__global__ void __launch_bounds__(512, 2) hymba_fwd(Params p) {
    extern __shared__ __attribute__((aligned(16))) unsigned char lds_raw[];
    LAS unsigned char* lds = (LAS unsigned char*)lds_raw;
    const int tid = threadIdx.x;
    const int G = gridDim.x; const int bx = blockIdx.x; const int vcu = (G % 8 == 0) ? (bx % 8) * (G / 8) + bx / 8 : bx;
    volatile LAS unsigned* ctlw = (volatile LAS unsigned*)(lds + LDS_CTLW);
    if (tid < 128) ctlw[tid] = 0u;
    __syncthreads();
    unsigned* ctl = (unsigned*)(p.ws + WS_CTL);
    const int lo = p.ph_lo, hi = p.ph_hi;
    XcdBarrier bar; bar.bar = ctl + CW_BAR; bar.x = 0; bar.st = nullptr;
    if (hi - lo > 1) bar = xcd_barrier_post(ctl + CW_BAR, ctlw + 8);
    volatile LAS unsigned long long* tst = (volatile LAS unsigned long long*)(ctlw + 32); volatile LAS unsigned long long* tarr = tst + 32; int nst = 0, nbar = 0;
#define STAMP() do { if (PROBE_SEG >= 0 && bx == 0 && tid == 0) { tst[nst] = __builtin_amdgcn_s_memrealtime(); } ++nst; } while (0)
#define GBAR() do { if (PROBE_SEG >= 0) { if (tid == 0) __hip_atomic_fetch_max((unsigned long long*)(ctl + 200000) + 8 * nbar, (unsigned long long)__builtin_amdgcn_s_memrealtime(), __ATOMIC_RELAXED, __HIP_MEMORY_SCOPE_AGENT); } \
        xcd_barrier(bar); if (PROBE_SEG >= 0 && bx == 0 && tid == 0) tarr[nbar] = __hip_atomic_load((unsigned long long*)(ctl + 200000) + 8 * nbar, __ATOMIC_RELAXED, __HIP_MEMORY_SCOPE_AGENT); ++nbar; } while (0)
    STAMP();
#define IN(k) (lo <= (k) && (k) < hi)
#define BOTH(k) (IN(k) && IN((k) + 1))
    if (IN(0)) { phase0(p, lds, vcu, G, ctlw); if (BOTH(0)) GBAR(); STAMP(); }
    if (PROBE_DUP == 0) { phase0(p, lds, vcu, G, ctlw); xcd_barrier(bar); }
    if (PROBE_DUP == 100) { probe_flush(p, vcu, G); xcd_barrier(bar); }
    if (PROBE_DUP == 101) { probe_flush(p, vcu, G); xcd_barrier(bar); phase0(p, lds, vcu, G, ctlw); xcd_barrier(bar); }
    if (PROBE_DUP == 99) { for (int q = 0; q < 8; ++q) xcd_barrier(bar); }
    if (PROBE_DUP == 97) { for (int q = 0; q < 8; ++q) { __syncthreads(); if (threadIdx.x == 0) { const unsigned g = ctlw[12] + 1u; ctlw[12] = g; xb_add(&(ctl + CW_BAR + 4096)[XB_TOP], 1u); const unsigned target = g * gridDim.x; XB_SPIN(xb_ld(&(ctl + CW_BAR + 4096)[XB_TOP]) < target, (ctl + CW_BAR + 4096)); } __syncthreads(); } }
    if (PROBE_DUP == 96) { for (int q = 0; q < 8; ++q) { __syncthreads(); if (threadIdx.x == 0) { __builtin_amdgcn_fence(__ATOMIC_RELEASE, "agent"); asm volatile("s_waitcnt vmcnt(0)" ::: "memory"); __builtin_amdgcn_fence(__ATOMIC_ACQUIRE, "agent"); asm volatile("s_waitcnt vmcnt(0)" ::: "memory"); } __syncthreads(); } }
    if (PROBE_DUP == 95) { unsigned acc_ = 0; for (int q = 0; q < 64; ++q) { __syncthreads(); if (threadIdx.x == 0) acc_ += xb_add(&(ctl + 65536)[64 * blockIdx.x], 1u); __syncthreads(); } if (acc_ == 0xdeadbeefu) ctl[3] = acc_; }
    if (PROBE_DUP == 94) { unsigned acc_ = 0; for (int q = 0; q < 64; ++q) { __syncthreads(); if (threadIdx.x == 0) acc_ += xb_add(&(ctl + 65536)[0], 1u); __syncthreads(); } if (acc_ == 0xdeadbeefu) ctl[3] = acc_; }
    if (PROBE_DUP == 93) { unsigned acc_ = 0; for (int q = 0; q < 64; ++q) { __syncthreads(); if (threadIdx.x == 0) acc_ += xb_ld(&(ctl + 65536)[0]); __syncthreads(); } if (acc_ == 0xdeadbeefu) ctl[3] = acc_; }
    if (PROBE_DUP == 92) { for (int q = 0; q < 16; ++q) { __syncthreads(); if (threadIdx.x == 0) { __builtin_amdgcn_fence(__ATOMIC_ACQUIRE, "agent"); asm volatile("s_waitcnt vmcnt(0)" ::: "memory"); } __syncthreads(); } }
    if (PROBE_DUP == 91) { for (int q = 0; q < 16; ++q) { __syncthreads(); if (threadIdx.x == 0) { __builtin_amdgcn_fence(__ATOMIC_RELEASE, "agent"); asm volatile("s_waitcnt vmcnt(0)" ::: "memory"); } __syncthreads(); } }
    if (PROBE_DUP == 90) { for (int q = 0; q < 8; ++q) xcd_barrier_probe<0>(bar); }
    if (PROBE_DUP == 89) { for (int q = 0; q < 8; ++q) xcd_barrier_probe<1>(bar); }
    if (PROBE_DUP == 88) { XcdBarrier2 b2 = xcd_barrier2_post(ctl + 131072, ctlw + 20); for (int q = 0; q < 8; ++q) xcd_barrier2(b2); }
    if (PROBE_DUP == 98) { for (int q = 0; q < 8; ++q) flat_barrier(ctl + CW_BAR + 4096, ctlw + 12); }
    if (IN(1)) {
        pg8::Gemm g{(const bf16_t*)(p.ws + WS_H), (const bf16_t*)(p.ws + WS_WIN), (const bf16_t*)(p.ws + WS_HM), (const bf16_t*)(p.ws + WS_WM), DM};
        pg8::Order S; S.init(MROWS / 256, NPAD / 256, MMEM / 256, 1024 / 256, G, bx);
        Epi1 E{(bf16_t*)(p.ws + WS_PROJ), (float*)(p.ws + WS_DT), p.out, p.in[I_DTBIAS], p.in[I_QNORM], p.in[I_KNORM], p.in[I_MQNORM], p.in[I_MKNORM], (bf16_t*)(p.ws + WS_MKN), (bf16_t*)(p.ws + WS_MVB), (LAS float*)(lds + RING_BYTES)};
        pg8::gemm_phase<Epi1>(lds, g, S, E);
        {
            const int nfull = (MROWS / 256) * (NPAD / 256) + (MMEM / 256) * (1024 / 256) - ((MROWS / 256) * (NPAD / 256) + (MMEM / 256) * (1024 / 256)) / G * G;
            const int first_idle = (nfull == 0) ? 0 : nfull, nidle = G - first_idle;
            if (bx >= first_idle) {
                const int lane = tid & 63, wave = __builtin_amdgcn_readfirstlane(tid >> 6);
                tr_pipeline(p, (LAS float*)(lds + wave * 16896), lane, (bx - first_idle) * 8 + wave, nidle * 8, NITEMS_P0, NITEMS_ALL);
                cache_mem_convert(p, (bx - first_idle) * 512 + tid, nidle * 512);
            }
        }
        if (BOTH(1)) GBAR(); STAMP();
        if (PROBE_DUP == 1) { pg8::gemm_phase<Epi1>(lds, g, S, E); xcd_barrier(bar); }
    }
    if (IN(3)) { phase3<31>(p, lds, ctlw, 0); if (BOTH(3)) GBAR(); STAMP(); }
    if (PROBE_DUP >= 30) { phase3<31>(p, lds, ctlw, 1); xcd_barrier(bar); }
    if (IN(4)) { phase4(p, lds, ctlw, vcu, G, 0); if (BOTH(4)) GBAR(); STAMP(); }
    if (PROBE_DUP == 4) { phase4(p, lds, ctlw, vcu, G, 1); xcd_barrier(bar); }
    if (IN(5)) {
        pg8::Gemm g{(const bf16_t*)(p.ws + WS_MIX), (const bf16_t*)(p.ws + WS_WOUT), nullptr, nullptr, DM};
        pg8::Order S; S.init(MP / 256, DM / 256, 0, 1, G, bx);
        Epi5 E{p.in[I_XP], p.out, (const float*)(p.ws + WS_SSQ)};
        PSTAMP0(4);
        pg8::gemm_phase<Epi5>(lds, g, S, E);
        PSTAMP0(5);
        if (bx < 128) sample_outproj(p, lds, bx);
        PSTAMP0(6);
        STAMP();
        if (PROBE_DUP == 5) { xcd_barrier(bar); pg8::gemm_phase<Epi5>(lds, g, S, E); if (bx < 128) sample_outproj(p, lds, bx); }
    }
    if (PROBE_SEG >= 0 && bx == ((PROBE_SEG >= 20 && PROBE_SEG < 30) ? PROBE_BLK : 0) && tid == 0) {
        unsigned long long iv = 0;
        if (PROBE_SEG == 29) iv = tst[8 + 9] - tst[8 + 5];
        else if (PROBE_SEG == 28) iv = tst[8 + 6] - tst[8 + 9];
        else if (PROBE_SEG >= 40) iv = tst[20 + PROBE_SEG - 40 + 1] - tst[20 + PROBE_SEG - 40];
        else if (PROBE_SEG == 30) iv = tst[9] - tst[8];
        else if (PROBE_SEG >= 20) iv = tst[8 + PROBE_SEG - 20 + 1] - tst[8 + PROBE_SEG - 20];
        else if (PROBE_SEG < 10) iv = tst[PROBE_SEG + 1] - tst[PROBE_SEG];
        else iv = tst[PROBE_SEG - 10 + 1] - tarr[PROBE_SEG - 10];
        const unsigned long long t0 = __builtin_amdgcn_s_memrealtime();
        while (__builtin_amdgcn_s_memrealtime() - t0 < 8ull * iv) __builtin_amdgcn_s_sleep(8);
    }
    if (PROBE_DUP == 200) {
        xcd_barrier(bar);
        phase0(p, lds, vcu, G, ctlw); xcd_barrier(bar);
        { pg8::Gemm g{(const bf16_t*)(p.ws + WS_H), (const bf16_t*)(p.ws + WS_WIN), (const bf16_t*)(p.ws + WS_HM), (const bf16_t*)(p.ws + WS_WM), DM};
          pg8::Order S; S.init(MROWS / 256, NPAD / 256, MMEM / 256, 1024 / 256, G, bx);
          Epi1 E{(bf16_t*)(p.ws + WS_PROJ), (float*)(p.ws + WS_DT), p.out, p.in[I_DTBIAS], p.in[I_QNORM], p.in[I_KNORM], p.in[I_MQNORM], p.in[I_MKNORM], (bf16_t*)(p.ws + WS_MKN), (bf16_t*)(p.ws + WS_MVB), (LAS float*)(lds + RING_BYTES)};
          pg8::gemm_phase<Epi1>(lds, g, S, E); xcd_barrier(bar); }
        phase3<31>(p, lds, ctlw, 1); xcd_barrier(bar);
        phase4(p, lds, ctlw, vcu, G, 1); xcd_barrier(bar);
        { pg8::Gemm g{(const bf16_t*)(p.ws + WS_MIX), (const bf16_t*)(p.ws + WS_WOUT), nullptr, nullptr, DM};
          pg8::Order S; S.init(MP / 256, DM / 256, 0, 1, G, bx);
          Epi5 E{p.in[I_XP], p.out, (const float*)(p.ws + WS_SSQ)};
          pg8::gemm_phase<Epi5>(lds, g, S, E);
          if (bx < 128) sample_outproj(p, lds, bx); }
    }
#undef IN
#undef BOTH
}

extern "C" void kernel_launch(void* const* d_in, const int* in_sizes, int n_in, void* d_out, int out_size, void* d_ws, size_t ws_size, hipStream_t stream) {
    static int grid = 0;
    if (grid == 0) {
        if (n_in != 26 || ws_size < WS_END) { fprintf(stderr, "kernel_launch: unexpected n_in %d / ws %zu\n", n_in, ws_size); grid = -1; return; }
        int dev = 0, cus = 0, per_cu = 0;
        if (hipGetDevice(&dev) != hipSuccess || hipDeviceGetAttribute(&cus, hipDeviceAttributeMultiprocessorCount, dev) != hipSuccess) { grid = -1; return; }
        if (hipFuncSetAttribute((const void*)hymba_fwd, hipFuncAttributeMaxDynamicSharedMemorySize, LDS_BYTES) != hipSuccess) { fprintf(stderr, "kernel_launch: hipFuncSetAttribute failed\n"); grid = -1; return; }
        if (hipOccupancyMaxActiveBlocksPerMultiprocessor(&per_cu, (const void*)hymba_fwd, 512, LDS_BYTES) != hipSuccess || per_cu < 1) fprintf(stderr, "kernel_launch: occupancy query says %d\n", per_cu);
        (void)hipGetLastError();
        grid = cus;
    }
    if (grid < 0) return;
    (void)hipMemsetAsync((char*)d_ws + WS_CTL, 0, CTL_BYTES, stream);
    Params p{};
    for (int i = 0; i < 26; ++i) p.in[i] = (const float*)d_in[i];
    p.out = (float*)d_out; p.ws = (unsigned char*)d_ws;
    if (MK_N_LAUNCHES == 1) { p.ph_lo = 0; p.ph_hi = NPHASE; hipLaunchKernelGGL(hymba_fwd, dim3(grid), dim3(512), LDS_BYTES, stream, p); }
    else for (int ph = 0; ph < NPHASE; ++ph) { p.ph_lo = ph; p.ph_hi = ph + 1; hipLaunchKernelGGL(hymba_fwd, dim3(grid), dim3(512), LDS_BYTES, stream, p); }
    const hipError_t le = hipPeekAtLastError();
    if (le != hipSuccess) fprintf(stderr, "kernel_launch: launch failed: %s\n", hipGetErrorName(le));
}
```

```cpp
#include <hip/hip_runtime.h>
#include <cstdio>
#include <cstdint>

#ifndef PROBE_SEG
#define PROBE_SEG -1
#endif
#ifndef MK_N_LAUNCHES
#define MK_N_LAUNCHES 1
#endif

constexpr int DM = 2048, NBATCH = 4, SEQ = 2048, MP = NBATCH * SEQ;
constexpr int DSEQ = 8, DTOK = 8, MS = DSEQ * DTOK;
constexpr int MVALID = MP + MS, MROWS = 8448;
constexpr int NIN = 6664, NPAD = 6912;
constexpr int MEMT = 256, MMEM = NBATCH * MEMT;
constexpr int NPAGES = 128, PAGE = 128, PAST = NPAGES * PAGE;
constexpr float EPS = 1e-6f;
constexpr float LOG2E = 1.4426950408889634f;
constexpr float QSCALE = 0.08838834764831845f * LOG2E;

constexpr size_t O_YP = 0, O_YS = 16777216, O_PK = 16908288, O_PV = 25296896, O_PSSM = 33685504, O_PCONV = 33947648,
                 O_PMK = 33959936, O_PMV = 34484224, O_SK = 35008512, O_SV = 35074048, O_SSSM = 35139584, O_SCONV = 35663872;

constexpr size_t MiB = 1u << 20;
constexpr size_t WS_CTL = 0, CTL_BYTES = 65536;
constexpr size_t WS_WIN = 2 * MiB;
constexpr size_t WS_WM = 32 * MiB;
constexpr size_t WS_WOUT = 38 * MiB;
constexpr size_t WS_H = 48 * MiB;
constexpr size_t WS_HM = 84 * MiB;
constexpr size_t WS_PROJ = 90 * MiB;
constexpr int PC_Q = 0, PC_K = 1024, PC_V = 2048, PC_GSB = 3072, PC_Z = 4096, PC_XBC = 4608, PC_MQ = 5632, PC_GM = 6144;
constexpr size_t WS_DT = 210 * MiB;
constexpr size_t WS_MKN = 211 * MiB;
constexpr size_t WS_MVB = 213 * MiB;
constexpr size_t WS_CMK = 215 * MiB;
constexpr size_t WS_CMV = 218 * MiB;
constexpr size_t WS_SSQ = 221 * MiB;
constexpr size_t WS_FPART = 222 * MiB;
constexpr size_t WS_MIX = 224 * MiB;
constexpr size_t WS_YZ = 260 * MiB;
constexpr size_t WS_OPART = 280 * MiB;
constexpr size_t WS_XA = 316 * MiB;
constexpr size_t WS_SLOC = 334 * MiB;
constexpr size_t WS_SUMDT = 354 * MiB;
constexpr size_t WS_END = 355 * MiB;

constexpr int CW_BAR = 4096;
constexpr int CW_QUEUE = 64;

constexpr int LDS_BYTES = 163840;
constexpr int RING_BYTES = 131072;
constexpr int LDS_CTLW = LDS_BYTES - 512;

#define LAS __attribute__((address_space(3)))
typedef unsigned short bf16_t;
typedef short bf16x8 __attribute__((ext_vector_type(8)));
typedef short s16x4 __attribute__((ext_vector_type(4)));
typedef float f32x2 __attribute__((ext_vector_type(2)));
typedef float f32x4 __attribute__((ext_vector_type(4)));
typedef float f32x16 __attribute__((ext_vector_type(16)));
typedef unsigned u32x2 __attribute__((ext_vector_type(2)));
typedef unsigned u32x4 __attribute__((ext_vector_type(4)));

__device__ __forceinline__ unsigned cvtpk(float lo, float hi) { unsigned r; asm volatile("v_cvt_pk_bf16_f32 %0, %1, %2" : "=v"(r) : "v"(lo), "v"(hi)); return r; }
__device__ __forceinline__ float bf_lo(unsigned w) { return __uint_as_float(w << 16); }
__device__ __forceinline__ float bf_hi(unsigned w) { return __uint_as_float(w & 0xffff0000u); }
__device__ __forceinline__ float bf2f(bf16_t b) { return __uint_as_float(((unsigned)b) << 16); }
__device__ __forceinline__ bf16_t f2bf(float f) { return (bf16_t)(cvtpk(f, 0.f) & 0xffffu); }
__device__ __forceinline__ float wave_sum(float v) {
#pragma unroll
    for (int o = 1; o < 64; o <<= 1) v += __shfl_xor(v, o);
    return v;
}
__device__ __forceinline__ float fast_exp2(float x) { return __builtin_amdgcn_exp2f(x); }
__device__ __forceinline__ float fast_rcp(float x) { return __builtin_amdgcn_rcpf(x); }
__device__ __forceinline__ float silu_f(float x) { return x * fast_rcp(1.f + fast_exp2(-x * LOG2E)); }

#define XB_TMO      128
#define XB_XCNT(j)  (256  + 64 * (j))
#define XB_XSUB(j)  (1280 + 64 * (j))
#define XB_XGEN(j)  (2304 + 64 * (j))
#define XB_TOP      3328
#define XB_TOPGEN   3392
#define XCD_BAR_WORDS 3456
#define XB_SPIN_CAP (1u << 18)
#ifndef XB_SLEEP
#define XB_SLEEP 1
#endif

__device__ __forceinline__ unsigned xb_ld(unsigned* p)              { return __hip_atomic_load(p, __ATOMIC_RELAXED, __HIP_MEMORY_SCOPE_AGENT); }
__device__ __forceinline__ unsigned xb_add(unsigned* p, unsigned v) { return __hip_atomic_fetch_add(p, v, __ATOMIC_RELAXED, __HIP_MEMORY_SCOPE_AGENT); }
__device__ __forceinline__ unsigned xb_xcc_id() { return (unsigned)__builtin_amdgcn_s_getreg((3 << 11) | 20) & 0xFu; }
#define XB_SPIN(cond, bar) do { unsigned _sp = 0; while (cond) { __builtin_amdgcn_s_sleep(XB_SLEEP); \
    if ((++_sp & 255u) == 0u) { if (xb_ld(&(bar)[XB_TMO])) break; if (_sp > XB_SPIN_CAP) { atomicAdd(&(bar)[XB_TMO], 1u); break; } } } } while (0)

struct XcdBarrier { unsigned* bar; unsigned x; volatile LAS unsigned* st; };

__device__ __forceinline__ XcdBarrier xcd_barrier_post(unsigned* bar, volatile LAS unsigned* st) {
    XcdBarrier b; b.bar = bar; b.x = xb_xcc_id(); b.st = st;
    if (threadIdx.x == 0) (void)xb_add(&bar[XB_XCNT(b.x)], 1u);
    return b;
}
__device__ __forceinline__ void xcd_barrier_complete(unsigned* bar, unsigned x, unsigned& nloc, unsigned& nx) {
    const unsigned G = gridDim.x * gridDim.y * gridDim.z;
    unsigned sum, cnt, mine, sp = 0u;
    for (;;) {
        sum = 0u; cnt = 0u; mine = 0u;
#pragma unroll
        for (unsigned j = 0; j < 16; ++j) { const unsigned c = xb_ld(&bar[XB_XCNT(j)]); sum += c; cnt += (c > 0u) ? 1u : 0u; mine = (j == x) ? c : mine; }
        if (sum == G) break;
        __builtin_amdgcn_s_sleep(1);
        if ((++sp & 255u) == 0u) { if (xb_ld(&bar[XB_TMO])) break; if (sp > XB_SPIN_CAP) { atomicAdd(&bar[XB_TMO], 1u); break; } }
    }
    nloc = mine > 0u ? mine : 1u; nx = cnt > 0u ? cnt : 1u;
}
__device__ __forceinline__ void xcd_barrier(const XcdBarrier& b) {
    asm volatile("s_waitcnt vmcnt(0)" ::: "memory");
    __syncthreads();
    if (threadIdx.x == 0) {
        unsigned* bar = b.bar;
        __builtin_amdgcn_s_waitcnt(0);
        unsigned nloc = b.st[0], nx = b.st[1];
        if (nloc == 0u) { xcd_barrier_complete(bar, b.x, nloc, nx); b.st[0] = nloc; b.st[1] = nx; }
        const unsigned old = xb_add(&bar[XB_XSUB(b.x)], 1u);
        const unsigned gen = old / nloc;
        if (old + 1u == (gen + 1u) * nloc) {
            __builtin_amdgcn_fence(__ATOMIC_RELEASE, "agent");
            asm volatile("s_waitcnt vmcnt(0)" ::: "memory");
            const unsigned og = xb_add(&bar[XB_TOP], 1u);
            const unsigned tg = og / nx;
            if (og + 1u == (tg + 1u) * nx) xb_add(&bar[XB_TOPGEN], 1u);
            else XB_SPIN(xb_ld(&bar[XB_TOPGEN]) == tg, bar);
            __builtin_amdgcn_fence(__ATOMIC_ACQUIRE, "agent");
            xb_add(&bar[XB_XGEN(b.x)], 1u);
            asm volatile("s_waitcnt vmcnt(0)" ::: "memory");
        } else {
            XB_SPIN(xb_ld(&bar[XB_XGEN(b.x)]) == gen, bar);
            __builtin_amdgcn_fence(__ATOMIC_ACQUIRE, "agent");
            asm volatile("s_waitcnt vmcnt(0)" ::: "memory");
        }
    }
    __syncthreads();
}

namespace pg8 {
constexpr int BM = 256, BK = 64, HALF = 128, HTB = HALF * BK * 2, STAGE_BYTES = 8 * HTB, NXCD = 8, WGM = 8;
__host__ __device__ __forceinline__ int lds_byte(int r, int c) { const int st = (r >> 4) * 2 + (c >> 5), rr = r & 15, cc = c & 31, ob = rr * 64 + cc * 2; return st * 1024 + (ob ^ (((ob >> 9) & 1) << 5)); }
__host__ __device__ __forceinline__ void stage_rc(int b, int& R, int& C) { const int st = b / 1024, sb = b % 1024, swz = sb ^ (((sb >> 9) & 1) << 5); R = (st >> 1) * 16 + swz / 64; C = (st & 1) * 32 + (swz % 64) / 2; }

struct Unit { int pm, pn, sel; };
struct Gemm { const bf16_t* A0; const bf16_t* B0; const bf16_t* A1; const bf16_t* B1; int K; };

struct Order {
    int nM, nN, nwg, n1M, n1N, G, c, wgm;
    __device__ void init(int nM_, int nN_, int n1M_, int n1N_, int G_, int c_, int wgm_ = WGM) { nM = nM_; nN = nN_; nwg = nM * nN; n1M = n1M_; n1N = n1N_; G = G_; c = c_; wgm = wgm_; }
    __device__ bool next(int i, Unit& u) const {
        const long L = (long)i * G + c;
        if (L >= nwg + n1M * n1N) return false;
        if (L >= nwg) { const int r = (int)L - nwg; u.pm = r / n1N; u.pn = r % n1N; u.sel = 1; return true; }
        int wgid = (int)L; { const int q = nwg / NXCD, r = nwg % NXCD, xcd = wgid % NXCD, off = wgid / NXCD; wgid = (xcd < r ? xcd * (q + 1) : r * (q + 1) + (xcd - r) * q) + off; }
        const int nig = wgm * nN, gid = wgid / nig, fm = gid * wgm, gsz = (nM - fm) < wgm ? (nM - fm) : wgm;
        u.pm = fm + ((wgid % nig) % gsz); u.pn = (wgid % nig) / gsz; u.sel = 0; return true;
    }
};

template <class Epi>
__device__ __forceinline__ void gemm_phase(LAS unsigned char* lds, const Gemm g, const Order& S, const Epi& E) {
    const int tid = threadIdx.x, wid = __builtin_amdgcn_readfirstlane(tid >> 6), lane = tid & 63, wr = wid >> 2, wc = wid & 3, fr = lane & 15, fq = lane >> 4;
    const int K = g.K, nt = K / BK;
    unsigned voffA[2];
#pragma unroll
    for (int i = 0; i < 2; ++i) { int R, C; stage_rc(tid * 16 + i * 8192, R, C); voffA[i] = (unsigned)(R * K + C) * 2u; }
    const size_t kstep = (size_t)(BK * 2);
    const size_t hstep = (size_t)HALF * K * 2;
    const size_t tstep = 2 * hstep;
    const unsigned ldsw = (unsigned)wid * 1024u;
    const int aoff = lds_byte(wr * 64 + fr, fq * 8), boff = lds_byte(wc * 32 + fr, fq * 8);
#define PG8_SA(b, h) (((b) * 2 + (h)) * HTB)
#define PG8_SB(b, h) ((4 + (b) * 2 + (h)) * HTB)
#define PG8_STAGE(bufoff, gbase) do { _Pragma("unroll") for (int _i = 0; _i < 2; ++_i) \
        __builtin_amdgcn_global_load_lds((const unsigned*)((const char*)(gbase) + voffA[_i]), (LAS unsigned*)(lds + (bufoff) + ldsw + _i * 8192), 16, 0, 0); } while (0)
#define PG8_LDA(dst, b, h) do { _Pragma("unroll") for (int m = 0; m < 4; ++m) _Pragma("unroll") for (int k = 0; k < 2; ++k) dst[m][k] = *(const LAS bf16x8*)(lds + PG8_SA(b, h) + aoff + m * 2048 + k * 1024); } while (0)
#define PG8_LDB(dst, b, h) do { _Pragma("unroll") for (int n = 0; n < 2; ++n) _Pragma("unroll") for (int k = 0; k < 2; ++k) dst[n][k] = *(const LAS bf16x8*)(lds + PG8_SB(b, h) + boff + n * 2048 + k * 1024); } while (0)
#define PG8_MMA(ai, bj, At, Bt) do { __builtin_amdgcn_s_setprio(1); _Pragma("unroll") for (int m = 0; m < 4; ++m) _Pragma("unroll") for (int n = 0; n < 2; ++n) _Pragma("unroll") for (int k = 0; k < 2; ++k) \
        acc[ai][bj][m][n] = __builtin_amdgcn_mfma_f32_16x16x32_bf16(Bt[n][k], At[m][k], acc[ai][bj][m][n], 0, 0, 0); __builtin_amdgcn_s_setprio(0); } while (0)
#define PG8_WAIT_V(n) asm volatile("s_waitcnt vmcnt(" #n ")" ::: "memory")
#define PG8_WAIT_L(n) asm volatile("s_waitcnt lgkmcnt(" #n ")" ::: "memory")
#define PG8_BAR __builtin_amdgcn_s_barrier()
#define PG8_SCHED __builtin_amdgcn_sched_barrier(0)
    Unit cur, nxt; int ui = 0;
    if (!S.next(0, cur)) return;
    f32x4 acc[2][2][4][2];
#pragma unroll
    for (int a = 0; a < 2; ++a)
#pragma unroll
        for (int b = 0; b < 2; ++b)
#pragma unroll
            for (int m = 0; m < 4; ++m)
#pragma unroll
                for (int n = 0; n < 2; ++n) acc[a][b][m][n] = (f32x4){0.f, 0.f, 0.f, 0.f};
    bf16x8 At[4][2], B0[2][2], B1[2][2];
    const char* cA = (const char*)(cur.sel ? g.A1 : g.A0) + (size_t)cur.pm * tstep; const char* cB = (const char*)(cur.sel ? g.B1 : g.B0) + (size_t)cur.pn * tstep;
    PG8_STAGE(PG8_SB(0, 0), cB); PG8_STAGE(PG8_SB(0, 1), cB + hstep); PG8_STAGE(PG8_SA(0, 0), cA); PG8_STAGE(PG8_SA(0, 1), cA + hstep);
    if (wr == 1) PG8_BAR;
    PG8_WAIT_V(2); PG8_BAR;
    PG8_STAGE(PG8_SB(1, 0), cB + kstep); PG8_STAGE(PG8_SA(1, 0), cA + kstep); PG8_STAGE(PG8_SB(1, 1), cB + hstep + kstep);
    PG8_WAIT_V(6); PG8_BAR;
    for (;;) {
        const bool has_next = S.next(ui + 1, nxt);
        const char* nA = has_next ? (const char*)(nxt.sel ? g.A1 : g.A0) + (size_t)nxt.pm * tstep : cA; const char* nB = has_next ? (const char*)(nxt.sel ? g.B1 : g.B0) + (size_t)nxt.pn * tstep : cB;
        for (int t = 0; t < nt; t += 2) {
            const bool last = (t == nt - 2);
            const char* a1 = cA + (size_t)(t + 1) * kstep;
            const char* a2 = last ? nA : cA + (size_t)(t + 2) * kstep; const char* b2 = last ? nB : cB + (size_t)(t + 2) * kstep;
            const char* a3 = a2 + kstep; const char* b3 = b2 + kstep;
            if constexpr (Epi::MID > 0) { if (t == Epi::MID) E.mid(acc, cur, wr, fr); }
            PG8_LDB(B0, 0, 0); PG8_LDB(B1, 0, 1); PG8_SCHED; PG8_LDA(At, 0, 0); PG8_STAGE(PG8_SA(1, 1), a1 + hstep);
            PG8_WAIT_V(8); PG8_WAIT_L(0); PG8_BAR; PG8_MMA(0, 0, At, B0); PG8_MMA(0, 1, At, B1); PG8_BAR; PG8_SCHED;
            PG8_LDA(At, 0, 1); PG8_STAGE(PG8_SB(0, 0), b2); PG8_STAGE(PG8_SB(0, 1), b2 + hstep); PG8_STAGE(PG8_SA(0, 0), a2);
            PG8_WAIT_V(8); PG8_WAIT_L(0); PG8_BAR; PG8_MMA(1, 0, At, B0); PG8_MMA(1, 1, At, B1); PG8_BAR; PG8_SCHED;
            PG8_LDB(B0, 1, 0); PG8_LDB(B1, 1, 1); PG8_SCHED; PG8_LDA(At, 1, 0); PG8_STAGE(PG8_SA(0, 1), a2 + hstep);
            PG8_WAIT_V(8); PG8_WAIT_L(0); PG8_BAR; PG8_MMA(0, 0, At, B0); PG8_MMA(0, 1, At, B1); PG8_BAR; PG8_SCHED;
            PG8_LDA(At, 1, 1); PG8_STAGE(PG8_SB(1, 0), b3); PG8_STAGE(PG8_SB(1, 1), b3 + hstep); PG8_STAGE(PG8_SA(1, 0), a3);
            PG8_WAIT_V(8); PG8_WAIT_L(0); PG8_BAR; PG8_MMA(1, 0, At, B0); PG8_MMA(1, 1, At, B1); PG8_BAR; PG8_SCHED;
        }
        if (wr == 0) PG8_BAR;
        if (PROBE_SEG == 47 && blockIdx.x == 0 && threadIdx.x == 0) ((volatile LAS unsigned long long*)(lds + 163840 - 512 + 128))[27] = __builtin_amdgcn_s_memrealtime();
        E(acc, cur, wr, wc, fr, fq);
        if (!has_next) break;
#pragma unroll
        for (int a = 0; a < 2; ++a)
#pragma unroll
            for (int b = 0; b < 2; ++b)
#pragma unroll
                for (int m = 0; m < 4; ++m)
#pragma unroll
                    for (int n = 0; n < 2; ++n) acc[a][b][m][n] = (f32x4){0.f, 0.f, 0.f, 0.f};
        cur = nxt; cA = nA; cB = nB; ++ui;
        if (wr == 1) PG8_BAR;
    }
    PG8_WAIT_V(0);
    PG8_BAR;
    if (PROBE_SEG == 47 && blockIdx.x == 0 && threadIdx.x == 0) ((volatile LAS unsigned long long*)(lds + 163840 - 512 + 128))[28] = __builtin_amdgcn_s_memrealtime();
#undef PG8_SA
#undef PG8_SB
#undef PG8_STAGE
#undef PG8_LDA
#undef PG8_LDB
#undef PG8_MMA
#undef PG8_WAIT_V
#undef PG8_WAIT_L
#undef PG8_BAR
#undef PG8_SCHED
}
typedef f32x4 Acc[2][2][4][2];
__device__ __forceinline__ void store_f32(const Acc& acc, float* base, int ld, int rl0, int cl0, int valid) {
#pragma unroll
    for (int ai = 0; ai < 2; ++ai)
#pragma unroll
        for (int m = 0; m < 4; ++m) { const int row = rl0 + ai * HALF + m * 16; if (row < valid) { float* rp = base + (size_t)row * ld + cl0;
#pragma unroll
            for (int bj = 0; bj < 2; ++bj)
#pragma unroll
                for (int n = 0; n < 2; ++n) *(f32x4*)(rp + bj * HALF + n * 16) = acc[ai][bj][m][n]; } }
}
__device__ __forceinline__ void store_bf16(const Acc& acc, bf16_t* base, int ld, int rl0, int cl0) {
#pragma unroll
    for (int ai = 0; ai < 2; ++ai)
#pragma unroll
        for (int m = 0; m < 4; ++m) { const int row = rl0 + ai * HALF + m * 16; bf16_t* rp = base + (size_t)row * ld + cl0;
#pragma unroll
            for (int bj = 0; bj < 2; ++bj)
#pragma unroll
                for (int n = 0; n < 2; ++n) { const f32x4 a = acc[ai][bj][m][n]; u32x2 w; w.x = cvtpk(a[0], a[1]); w.y = cvtpk(a[2], a[3]); *(u32x2*)(rp + bj * HALF + n * 16) = w; } }
}
}

struct Params {
    const float* in[26];
    float* out;
    unsigned char* ws;
    int ph_lo, ph_hi;
};
enum { I_XP = 0, I_XS, I_CK, I_CV, I_SSM, I_SCONV, I_CMK, I_CMV, I_PT, I_MEM, I_NORMW, I_WIN, I_QNORM, I_KNORM, I_SBBIAS, I_CONVW, I_CONVB, I_DTBIAS, I_ALOG, I_DSKIP,
       I_SSDNW, I_MEMNW, I_WMEM, I_MQNORM, I_MKNORM, I_WOUT };

#define PSTAMP0(i) do { if (PROBE_SEG >= 40 && blockIdx.x == 0 && threadIdx.x == 0) ((volatile LAS unsigned long long*)(ctlw + 32))[20 + (i)] = __builtin_amdgcn_s_memrealtime(); } while (0)
struct TrItem { const float* src; bf16_t* dst; bool ok; };
__device__ __forceinline__ TrItem tr_item(const Params& p, int it, int lane) {
    constexpr int I_IN = (DM / 32) * (NPAD / 128), I_M = (DM / 32) * (1024 / 128);
    const float* W; bf16_t* WT; int Nsrc, N, map;
    if (it < I_IN) { W = p.in[I_WIN]; WT = (bf16_t*)(p.ws + WS_WIN); Nsrc = NIN; N = NPAD; map = 1; }
    else if (it < I_IN + I_M) { it -= I_IN; W = p.in[I_WMEM]; WT = (bf16_t*)(p.ws + WS_WM); Nsrc = 1024; N = 1024; map = 0; }
    else { it -= I_IN + I_M; W = p.in[I_WOUT]; WT = (bf16_t*)(p.ws + WS_WOUT); Nsrc = DM; N = DM; map = 2; }
    const int nblk = N / 128, kb = it / nblk, nb = it % nblk, k0 = 32 * kb, n0 = 128 * nb;
    const int ks0 = (map == 2) ? (k0 < 512 ? k0 + 1024 : (k0 < 1536 ? k0 - 512 : k0)) : k0;
    const int nd = n0 + 4 * (lane & 31);
    int ns = nd; bool ok = true;
    if (map == 1) { if (nd < 5632) ns = nd; else if (nd < 6656) ns = nd + 8; else if (nd < 6664) ns = nd - 1024; else { ns = 0; ok = false; } }
    TrItem t; t.src = W + (size_t)(ks0 + (lane >> 5)) * Nsrc + ns; t.dst = WT + (size_t)(n0 + (lane & 15)) * DM + k0 + 8 * (lane >> 4); t.ok = ok;
    return t;
}
__device__ __forceinline__ int tr_nsrc(int it) { constexpr int I_IN = (DM / 32) * (NPAD / 128), I_M = (DM / 32) * (1024 / 128); return it < I_IN ? NIN : (it < I_IN + I_M ? 1024 : DM); }
__device__ __forceinline__ void tr_load(const TrItem& t, int nsrc, f32x4 (&v)[16]) {
#pragma unroll
    for (int i = 0; i < 16; ++i) v[i] = t.ok ? __builtin_nontemporal_load((const f32x4*)(t.src + (size_t)(2 * i) * nsrc)) : f32x4{0.f, 0.f, 0.f, 0.f};
}
__device__ __forceinline__ void tr_finish(const TrItem& t, const f32x4 (&v)[16], LAS float* scr, int lane) {
#pragma unroll
    for (int i = 0; i < 16; ++i) { const int kk = 2 * i + (lane >> 5); *(LAS f32x4*)(scr + kk * 132 + 4 * (lane & 31)) = v[i]; }
    asm volatile("s_waitcnt lgkmcnt(0)" ::: "memory");
    const int nl = lane & 15, c = lane >> 4;
#pragma unroll
    for (int j = 0; j < 8; ++j) { const LAS float* sp = scr + (8 * c) * 132 + nl + 16 * j;
        u32x4 o; o.x = cvtpk(sp[0 * 132], sp[1 * 132]); o.y = cvtpk(sp[2 * 132], sp[3 * 132]); o.z = cvtpk(sp[4 * 132], sp[5 * 132]); o.w = cvtpk(sp[6 * 132], sp[7 * 132]);
        *(u32x4*)(t.dst + (size_t)(16 * j) * DM) = o; }
    asm volatile("s_waitcnt lgkmcnt(0)" ::: "memory");
}
__device__ __forceinline__ void tr_pipeline(const Params& p, LAS float* scr, int lane, int gw, int NGW, int first, int end) {
    f32x4 va[16], vb[16];
    int it = first + gw;
    TrItem ta{}, tb{};
    if (it < end) { ta = tr_item(p, it, lane); tr_load(ta, tr_nsrc(it), va); }
    while (it < end) {
        const int itb = it + NGW;
        if (itb < end) { tb = tr_item(p, itb, lane); tr_load(tb, tr_nsrc(itb), vb); }
        tr_finish(ta, va, scr, lane);
        if (itb >= end) break;
        const int ita = itb + NGW;
        if (ita < end) { ta = tr_item(p, ita, lane); tr_load(ta, tr_nsrc(ita), va); }
        tr_finish(tb, vb, scr, lane);
        it = ita;
    }
}
constexpr int NITEMS_P0 = (DM / 32) * (NPAD / 128) + (DM / 32) * (1024 / 128), NITEMS_ALL = NITEMS_P0 + (DM / 32) * (DM / 128);
__device__ __forceinline__ void cache_mem_convert(const Params& p, int gt, int NGT) {
    u32x4* cmk = (u32x4*)(p.ws + WS_CMK); u32x4* cmv = (u32x4*)(p.ws + WS_CMV);
    constexpr int N8 = DSEQ * MEMT * 512 / 8;
    for (int i = gt; i < 2 * N8; i += NGT) { const bool isk = i < N8; const int j = isk ? i : i - N8; const f32x4* s = (const f32x4*)(isk ? p.in[I_CMK] : p.in[I_CMV]) + 2 * (size_t)j;
        const f32x4 a = s[0], b = s[1]; u32x4 o; o.x = cvtpk(a.x, a.y); o.y = cvtpk(a.z, a.w); o.z = cvtpk(b.x, b.y); o.w = cvtpk(b.z, b.w); (isk ? cmk : cmv)[j] = o; }
}
__device__ __forceinline__ const float* p0_row_src(const Params& p, int m) { return m < MP ? p.in[I_XP] + (size_t)m * DM : (m < MVALID ? p.in[I_XS] + (size_t)(m - MP) * DM : p.in[I_MEM] + (size_t)(m - MVALID) * DM); }
__device__ __forceinline__ void p0_row_finish(const Params& p, int m, const f32x4 (&v)[8], int lane, const f32x4 (&gx)[8]) {
    float s = 0.f;
#pragma unroll
    for (int j = 0; j < 8; ++j) s += (v[j].x * v[j].x + v[j].y * v[j].y) + (v[j].z * v[j].z + v[j].w * v[j].w);
    const float rs = 1.f / sqrtf(wave_sum(s) * (1.f / DM) + EPS);
    bf16_t* orow = m < MVALID ? (bf16_t*)(p.ws + WS_H) + (size_t)m * DM : (bf16_t*)(p.ws + WS_HM) + (size_t)(m - MVALID) * DM;
    u32x2* o8 = (u32x2*)orow + lane;
    if (m < MVALID) {
#pragma unroll
        for (int j = 0; j < 8; ++j) { const f32x4 g = gx[j]; u32x2 w; w.x = cvtpk(v[j].x * rs * g.x, v[j].y * rs * g.y); w.y = cvtpk(v[j].z * rs * g.z, v[j].w * rs * g.w); o8[64 * j] = w; }
    } else {
        const f32x4* gr = (const f32x4*)p.in[I_MEMNW] + lane;
        f32x4 gm[8];
#pragma unroll
        for (int j = 0; j < 8; ++j) gm[j] = gr[64 * j];
#pragma unroll
        for (int j = 0; j < 8; ++j) { const f32x4 g = gm[j]; u32x2 w; w.x = cvtpk(v[j].x * rs * g.x, v[j].y * rs * g.y); w.y = cvtpk(v[j].z * rs * g.z, v[j].w * rs * g.w); o8[64 * j] = w; }
    }
}
__device__ __forceinline__ void phase0(const Params& p, LAS unsigned char* lds, int vcu, int G, volatile LAS unsigned* ctlw) {
    const int tid = threadIdx.x, lane = tid & 63, wave = __builtin_amdgcn_readfirstlane(tid >> 6);
    LAS float* scr = (LAS float*)(lds + wave * 16896);
    const int gw = vcu * 8 + wave, NGW = G * 8;
    PSTAMP0(0);
    {
        f32x4 va[8], vb[8], gx[8];
#pragma unroll
        for (int j = 0; j < 8; ++j) gx[j] = ((const f32x4*)p.in[I_NORMW])[lane + 64 * j];
        int m = gw;
        if (m < MVALID + MMEM) { const f32x4* xr = (const f32x4*)p0_row_src(p, m) + lane;
#pragma unroll
            for (int j = 0; j < 8; ++j) va[j] = __builtin_nontemporal_load(xr + 64 * j); }
        while (m < MVALID + MMEM) {
            const int mb = m + NGW;
            if (mb < MVALID + MMEM) { const f32x4* xr = (const f32x4*)p0_row_src(p, mb) + lane;
#pragma unroll
                for (int j = 0; j < 8; ++j) vb[j] = __builtin_nontemporal_load(xr + 64 * j); }
            p0_row_finish(p, m, va, lane, gx);
            if (mb >= MVALID + MMEM) break;
            const int ma = mb + NGW;
            if (ma < MVALID + MMEM) { const f32x4* xr = (const f32x4*)p0_row_src(p, ma) + lane;
#pragma unroll
                for (int j = 0; j < 8; ++j) va[j] = __builtin_nontemporal_load(xr + 64 * j); }
            p0_row_finish(p, mb, vb, lane, gx);
            m = ma;
        }
    }
    PSTAMP0(1);
    tr_pipeline(p, scr, lane, gw, NGW, 0, NITEMS_P0);
    PSTAMP0(2);
    PSTAMP0(3);
}

struct Epi1 {
    static constexpr int MID = 0;
    bf16_t* PROJ; float* DT; float* out; const float* dtbias; const float* qn; const float* kn; const float* mqn; const float* mkn; bf16_t* MKn; bf16_t* MVb; LAS float* T;
    __device__ __forceinline__ void head_norm(pg8::Acc& acc, const float* gain, float gscale, int wr, int wc, int fr, int fq) const {
        float part[2][4][2];
#pragma unroll
        for (int ai = 0; ai < 2; ++ai)
#pragma unroll
            for (int m = 0; m < 4; ++m)
#pragma unroll
                for (int bj = 0; bj < 2; ++bj) { const f32x4 a = acc[ai][bj][m][0], b = acc[ai][bj][m][1];
                    float s = ((a.x * a.x + a.y * a.y) + (a.z * a.z + a.w * a.w)) + ((b.x * b.x + b.y * b.y) + (b.z * b.z + b.w * b.w));
                    s += __shfl_xor(s, 16); s += __shfl_xor(s, 32); part[ai][m][bj] = s; }
        if (fq == 0) {
#pragma unroll
            for (int ai = 0; ai < 2; ++ai)
#pragma unroll
                for (int m = 0; m < 4; ++m)
#pragma unroll
                    for (int bj = 0; bj < 2; ++bj) T[(((wr * 128 + ai * 64 + m * 16 + fr) * 2 + bj) << 2) + wc] = part[ai][m][bj];
        }
        asm volatile("s_waitcnt lgkmcnt(0)" ::: "memory");
        __builtin_amdgcn_s_barrier();
        asm volatile("" ::: "memory");
        int cg = wc * 32 + 4 * fq; asm volatile("" : "+v"(cg));
        const f32x4 g0 = *(const f32x4*)(gain + cg) * gscale, g1 = *(const f32x4*)(gain + cg + 16) * gscale;
#pragma unroll
        for (int ai = 0; ai < 2; ++ai)
#pragma unroll
            for (int m = 0; m < 4; ++m)
#pragma unroll
                for (int bj = 0; bj < 2; ++bj) { const f32x4 t = *(const LAS f32x4*)(T + (((wr * 128 + ai * 64 + m * 16 + fr) * 2 + bj) << 2));
                    const float rs = 1.f / sqrtf(((t.x + t.y) + (t.z + t.w)) * (1.f / 128.f) + EPS);
                    acc[ai][bj][m][0] = acc[ai][bj][m][0] * rs * g0; acc[ai][bj][m][1] = acc[ai][bj][m][1] * rs * g1;
                    asm volatile("" ::: "memory"); }
    }
    __device__ __forceinline__ void operator()(pg8::Acc& acc, const pg8::Unit& u, int wr, int wc, int fr, int fq) const {
        int rl0 = wr * 64 + fr, cl0 = wc * 32 + 4 * fq;
        asm volatile("" : "+v"(rl0), "+v"(cl0));
        const int pn = u.pn; const size_t r0 = (size_t)u.pm * 256;
        const float* gain = nullptr; float gs = 1.f;
        float* fbase = nullptr; int fld = 1024, valid = 256;
        bf16_t* bbase = PROJ + r0 * NPAD + pn * 256; int bld = NPAD;
        if (u.sel == 1) { if (pn < 2) gain = mkn; fbase = out + (pn < 2 ? O_PMK : O_PMV) + r0 * 512 + (pn & 1) * 256; fld = 512; bbase = (pn < 2 ? MKn : MVb) + r0 * 512 + (pn & 1) * 256; bld = 512; }
        else {
            if (pn < 4) { gain = qn; gs = QSCALE; } else if (pn < 8) gain = kn; else if (pn == 22 || pn == 23) { gain = mqn; gs = QSCALE; }
            if (pn >= 4 && pn < 12) { if (u.pm < 32) fbase = out + (pn < 8 ? O_PK : O_PV) + r0 * 1024 + (pn & 3) * 256; else { fbase = out + (pn < 8 ? O_SK : O_SV) + (pn & 3) * 256; valid = MS; } }
        }
        if (gain) head_norm(acc, gain, gs, wr, wc, fr, fq);
        if (fbase) pg8::store_f32(acc, fbase, fld, rl0, cl0, valid);
        pg8::store_bf16(acc, bbase, bld, rl0, cl0);
        if (u.sel == 1) return;
        if (pn >= 18 && pn < 22) {
#pragma unroll
            for (int ai = 0; ai < 2; ++ai)
#pragma unroll
                for (int m = 0; m < 4; ++m) { const int row = rl0 + ai * 128 + m * 16; float* dst = nullptr;
                    if (u.pm < 32) { if ((u.pm & 7) == 7 && row >= 253) dst = out + O_PCONV + (size_t)((u.pm >> 3) * 3 + row - 253) * 1024; }
                    else if (row < MS && (row & 7) >= 5) dst = out + O_SCONV + (size_t)((row >> 3) * 3 + (row & 7) - 5) * 1024;
                    if (dst) { dst += (pn - 18) * 256 + cl0;
#pragma unroll
                        for (int bj = 0; bj < 2; ++bj)
#pragma unroll
                            for (int n = 0; n < 2; ++n) *(f32x4*)(dst + bj * 128 + n * 16) = acc[ai][bj][m][n]; } }
        }
        if (pn == 26 && wc == 0 && fq < 2) {
            const f32x4 db = *(const f32x4*)(dtbias + 4 * fq);
#pragma unroll
            for (int ai = 0; ai < 2; ++ai)
#pragma unroll
                for (int m = 0; m < 4; ++m) { const int row = rl0 + ai * 128 + m * 16; f32x4 v = acc[ai][0][m][0] + db;
#pragma unroll
                    for (int e = 0; e < 4; ++e) v[e] = (v[e] > 20.f) ? v[e] : log1pf(__expf(v[e]));
                    *(f32x4*)(DT + (r0 + row) * 8 + 4 * fq) = v; }
        }
    }
};

__device__ __forceinline__ float group16_sum(float v) { v += __shfl_xor(v, 1); v += __shfl_xor(v, 2); v += __shfl_xor(v, 4); v += __shfl_xor(v, 8); return v; }

#define KSWZ(row, colB) ((row) * 256 + ((colB) ^ (((row) & 7) << 4)))
#define SBAR() __builtin_amdgcn_sched_barrier(0)
__device__ __forceinline__ int crow(int r, int hi) { return (r & 3) + 8 * (r >> 2) + 4 * hi; }
__device__ __forceinline__ int v_st(int k, int c) { const int kk = (k & ~0xC) | ((k & 4) << 1) | ((k & 8) >> 1); return ((kk >> 3) * 4 + (c >> 5)) * 512 + ((kk & 7) * 32 + (c & 31)) * 2; }
__device__ __forceinline__ int v_rd_base(int lane) { return ((lane & 3) << 3) | (((lane >> 2) & 3) << 6) | (((lane >> 4) & 1) << 5) | (((lane >> 5) & 1) << 8); }
constexpr int v_rd_off(int d0, int ks, int half) { return d0 * 512 + ks * 4096 + half * 2048; }
template <int OFF> __device__ __forceinline__ s16x4 tr_read(int vb) {
    s16x4 r; asm volatile("ds_read_b64_tr_b16 %0, %1 offset:%2" : "=&v"(r) : "v"(vb), "i"(OFF) : "memory"); return r;
}
#define PKV(L, H) (bf16x8){L[0], L[1], L[2], L[3], H[0], H[1], H[2], H[3]}
template <int D0, int KS0> __device__ __forceinline__ void pv_one(f32x16& od, int vb, const bf16x8* pa) {
    const s16x4 l0 = tr_read<v_rd_off(D0, KS0, 0)>(vb), h0 = tr_read<v_rd_off(D0, KS0, 1)>(vb), l1 = tr_read<v_rd_off(D0, KS0 + 1, 0)>(vb), h1 = tr_read<v_rd_off(D0, KS0 + 1, 1)>(vb);
    asm volatile("s_waitcnt lgkmcnt(0)" ::: "memory"); SBAR();
    od = __builtin_amdgcn_mfma_f32_32x32x16_bf16(pa[0], PKV(l0, h0), od, 0, 0, 0);
    od = __builtin_amdgcn_mfma_f32_32x32x16_bf16(pa[1], PKV(l1, h1), od, 0, 0, 0);
}
template <int KS0> __device__ __forceinline__ void pv_blk(f32x16* o, int vb, const bf16x8* pa) {
    pv_one<0, KS0>(o[0], vb, pa); pv_one<1, KS0>(o[1], vb, pa); pv_one<2, KS0>(o[2], vb, pa); pv_one<3, KS0>(o[3], vb, pa);
}
__device__ __forceinline__ void pack_p(const f32x16& P, bf16x8& out0, bf16x8& out1) {
#define PK4(BASE, OUT) do { unsigned a0 = cvtpk(P[BASE + 0], P[BASE + 1]), a1 = cvtpk(P[BASE + 2], P[BASE + 3]);   \
    unsigned b0 = cvtpk(P[BASE + 4], P[BASE + 5]), b1 = cvtpk(P[BASE + 6], P[BASE + 7]);                              \
    auto r0 = __builtin_amdgcn_permlane32_swap(a0, b0, false, false); auto r1 = __builtin_amdgcn_permlane32_swap(a1, b1, false, false); \
    u32x4 w = {r0[0], r1[0], r0[1], r1[1]}; OUT = *reinterpret_cast<bf16x8*>(&w); } while (0)
    PK4(0, out0); PK4(8, out1);
#undef PK4
}
template <int NB, bool MASK> __device__ __forceinline__ void sb_transform(f32x16* P, float& R, int hi, int kpos0, int qpos) {
    float T[NB][4];
#pragma unroll
    for (int b = 0; b < NB; ++b)
#pragma unroll
        for (int g = 0; g < 4; ++g) {
            float be[4], f[4];
#pragma unroll
            for (int i = 0; i < 4; ++i) {
                const float z = fmaxf(P[b][4 * g + i], -100.f);
                const float e = fast_exp2(-z), rc = fast_rcp(1.f + e);
                be[i] = rc; f[i] = e * rc;
                if (MASK) { const bool ok = (kpos0 + 32 * b + 8 * g + 4 * hi + i) < qpos; be[i] = ok ? be[i] : 0.f; f[i] = ok ? f[i] : 1.f; }
            }
            const float e2 = f[3], e1 = f[2] * f[3], e0 = f[1] * e1;
            T[b][g] = f[0] * e0;
            P[b][4 * g + 0] = be[0] * e0; P[b][4 * g + 1] = be[1] * e1; P[b][4 * g + 2] = be[2] * e2; P[b][4 * g + 3] = be[3];
        }
    float E = R;
#pragma unroll
    for (int b = NB - 1; b >= 0; --b)
#pragma unroll
        for (int g = 3; g >= 0; --g) {
            const float To = __shfl_xor(T[b][g], 32);
            const float Eg = hi ? E : E * To;
#pragma unroll
            for (int i = 0; i < 4; ++i) P[b][4 * g + i] *= Eg;
            E = E * T[b][g] * To;
        }
    R = E;
}

struct AttnArgs {
    const bf16_t* Q; int qstride;
    const bf16_t* K; const bf16_t* V; int kvstride;
    int ntiles;
    int qpos0;
    int nvalid;
    float bias2;
    const bf16_t* gate; int gstride;
    bf16_t* out; int ostride;
};
struct GroupBar { volatile LAS unsigned* cnt; unsigned gen; };
__device__ __forceinline__ void group_bar(GroupBar& gb, int lane) {
    asm volatile("s_waitcnt lgkmcnt(0)" ::: "memory");
    gb.gen += 4u;
    if (lane == 0) (void)__hip_atomic_fetch_add((LAS unsigned*)gb.cnt, 1u, __ATOMIC_RELAXED, __HIP_MEMORY_SCOPE_WORKGROUP);
    while (__hip_atomic_load((LAS unsigned*)gb.cnt, __ATOMIC_RELAXED, __HIP_MEMORY_SCOPE_WORKGROUP) < gb.gen) __builtin_amdgcn_s_sleep(0);
    asm volatile("" ::: "memory");
}
template <int MODE>
__device__ __forceinline__ void attn_unit(LAS unsigned char* lds, GroupBar& gb, const bf16_t* aQ, int aqstride, const bf16_t* aK, const bf16_t* aV, int akvstride, int antiles, int aqpos0, int anvalid, float abias2,
                                      const bf16_t* agate, int agstride, bf16_t* aout, int aostride) {
    AttnArgs a; a.Q = aQ; a.qstride = aqstride; a.K = aK; a.V = aV; a.kvstride = akvstride; a.ntiles = antiles; a.qpos0 = aqpos0; a.nvalid = anvalid; a.bias2 = abias2;
    a.gate = agate; a.gstride = agstride; a.out = aout; a.ostride = aostride;
    int tid = threadIdx.x; asm volatile("" : "+v"(tid));
    const int wid = __builtin_amdgcn_readfirstlane(tid >> 6), lane = tid & 63, r32 = lane & 31, hi = lane >> 5;
    constexpr int SHM_V = 16384, SHM_K = 16384;
    LAS unsigned char* V_lds = lds; LAS unsigned char* K_lds = lds + 2 * SHM_V;
    LAS float* wsf = (LAS float*)(lds + 73728) + wid * 64;
    f32x16 o[4];
#pragma unroll
    for (int d = 0; d < 4; ++d) o[d] = f32x16{};
    bf16x8 qr[8];
    { int qrow = wid * 32 + r32; qrow = qrow < a.nvalid ? qrow : a.nvalid - 1;
      const bf16_t* Qw = a.Q + (size_t)qrow * a.qstride + hi * 8;
#pragma unroll
      for (int d0 = 0; d0 < 8; ++d0) qr[d0] = *(const bf16x8*)(Qw + d0 * 16); }
    const int sr = tid >> 4, sc = (tid & 15) * 8;
    const int vb0 = (int)(uintptr_t)V_lds + v_rd_base(lane);
    bf16x8 sv[4], sk[4];
#define SLOAD(k0) do { _Pragma("unroll") for (int j_ = 0; j_ < 4; ++j_) { sv[j_] = *(const bf16x8*)(a.V + (size_t)((k0) + sr + 16 * j_) * a.kvstride + sc); \
        sk[j_] = *(const bf16x8*)(a.K + (size_t)((k0) + sr + 16 * j_) * a.kvstride + sc); } } while (0)
#define SWRITE(b) do { _Pragma("unroll") for (int j_ = 0; j_ < 4; ++j_) { *(LAS bf16x8*)(V_lds + (b) * SHM_V + v_st(sr + 16 * j_, sc)) = sv[j_]; \
        *(LAS bf16x8*)(K_lds + (b) * SHM_K + KSWZ(sr + 16 * j_, sc * 2)) = sk[j_]; } } while (0)
    const int nt = a.ntiles;
    float R = 1.f, lsum = 0.f;
    const int qpos = a.qpos0 + wid * 32 + r32;
    const int qmax_w = a.qpos0 + wid * 32 + 31;
    group_bar(gb, lane);
    { const int t0 = (MODE == 0) ? nt - 1 : 0; SLOAD(t0 * 64); SWRITE(0); }
    group_bar(gb, lane);
    for (int j = 0; j < nt; ++j) {
        const int cur = j & 1, t = (MODE == 0) ? nt - 1 - j : j;
        if (j + 1 < nt) { const int tn = (MODE == 0) ? t - 1 : t + 1; SLOAD(tn * 64); }
        const bool active = (MODE == 1) || (t * 64 < qmax_w);
        if (active) {
            const LAS unsigned char* Ks = K_lds + cur * SHM_K;
            const bool diag = (MODE == 0) && (t * 64 + 63 >= a.qpos0);
#define ATT_BLOCK(B) do { f32x16 pb_[1]; { const float init = (MODE == 0) ? a.bias2 : 0.f; _Pragma("unroll") for (int r = 0; r < 16; ++r) pb_[0][r] = init; } \
            _Pragma("unroll") for (int d0 = 0; d0 < 8; ++d0) { const int cb = (d0 * 16 + hi * 8) * 2; \
                const bf16x8 kf = *(const LAS bf16x8*)(Ks + KSWZ(32 * (B) + r32, cb)); \
                pb_[0] = __builtin_amdgcn_mfma_f32_32x32x16_bf16(kf, qr[d0], pb_[0], 0, 0, 0); } \
            if (MODE == 0) { if (diag) sb_transform<1, true>(pb_, R, hi, t * 64 + 32 * (B), qpos); else sb_transform<1, false>(pb_, R, hi, 0, 0); } \
            else { float ps = 0.f; _Pragma("unroll") for (int r = 0; r < 16; ++r) { pb_[0][r] = fast_exp2(pb_[0][r]); ps += pb_[0][r]; } lsum += ps; } \
            bf16x8 pa_[2]; pack_p(pb_[0], pa_[0], pa_[1]); SBAR(); \
            pv_blk<2 * (B)>(o, vb0 + cur * SHM_V, pa_); } while (0)
            ATT_BLOCK(1);
            ATT_BLOCK(0);
#undef ATT_BLOCK
        }
        if (j + 1 < nt) SWRITE(cur ^ 1);
        group_bar(gb, lane);
    }
#undef SLOAD
#undef SWRITE
    float rl[16];
    if (MODE == 1) {
        lsum += __shfl_xor(lsum, 32);
        if (hi == 0) wsf[r32] = lsum;
        asm volatile("s_waitcnt lgkmcnt(0)" ::: "memory");
#pragma unroll
        for (int r = 0; r < 16; ++r) rl[r] = fast_rcp(wsf[crow(r, hi)]);
    }
    LAS unsigned char* ost = lds + wid * (32 * 272);
#pragma unroll
    for (int r = 0; r < 16; ++r)
#pragma unroll
        for (int d0 = 0; d0 < 4; ++d0) { float v = o[d0][r]; if (MODE == 1) v *= rl[r];
            *(LAS bf16_t*)(ost + crow(r, hi) * 272 + (d0 * 32 + r32) * 2) = f2bf(v); }
    asm volatile("s_waitcnt lgkmcnt(0)" ::: "memory");
    {
        const int row = wid * 32 + (lane >> 1), c0 = (lane & 1) * 64;
        if (row < a.nvalid) {
            const bf16_t* gp = a.gate + (size_t)row * a.gstride + c0; bf16_t* op = a.out + (size_t)row * a.ostride + c0;
            u32x4 gv[8];
#pragma unroll
            for (int j = 0; j < 8; ++j) gv[j] = *(const u32x4*)(gp + 8 * j);
#pragma unroll
            for (int j = 0; j < 8; ++j) { const u32x4 ov = *(const LAS u32x4*)(ost + (lane >> 1) * 272 + (c0 + 8 * j) * 2); u32x4 w;
#pragma unroll
                for (int e = 0; e < 4; ++e) w[e] = cvtpk(bf_lo(ov[e]) * silu_f(bf_lo(gv[j][e])), bf_hi(ov[e]) * silu_f(bf_hi(gv[j][e])));
                *(u32x4*)(op + 8 * j) = w; }
        }
    }
}

__device__ __forceinline__ void sb_transform16(f32x4 (&st)[2], float& R, int lane, int kg) {
    float T[2];
#pragma unroll
    for (int rb = 0; rb < 2; ++rb) {
        float be[4], f[4];
#pragma unroll
        for (int i = 0; i < 4; ++i) { const float z = fmaxf(st[rb][i], -100.f); const float e = fast_exp2(-z), rc = fast_rcp(1.f + e); be[i] = rc; f[i] = e * rc; }
        const float e2 = f[3], e1 = f[2] * f[3], e0 = f[1] * e1;
        T[rb] = f[0] * e0;
        st[rb][0] = be[0] * e0; st[rb][1] = be[1] * e1; st[rb][2] = be[2] * e2; st[rb][3] = be[3];
    }
    float Tg[8];
#pragma unroll
    for (int k2 = 0; k2 < 4; ++k2) { const int src = ((lane & 15) + 16 * k2) * 4;
        Tg[k2] = __builtin_bit_cast(float, __builtin_amdgcn_ds_bpermute(src, __builtin_bit_cast(int, T[0])));
        Tg[4 + k2] = __builtin_bit_cast(float, __builtin_amdgcn_ds_bpermute(src, __builtin_bit_cast(int, T[1]))); }
    float S[8]; S[7] = R;
#pragma unroll
    for (int G = 6; G >= 0; --G) S[G] = S[G + 1] * Tg[G + 1];
    const float E0 = kg == 0 ? S[0] : kg == 1 ? S[1] : kg == 2 ? S[2] : S[3];
    const float E1 = kg == 0 ? S[4] : kg == 1 ? S[5] : kg == 2 ? S[6] : S[7];
    st[0] = st[0] * E0; st[1] = st[1] * E1;
    R = S[0] * Tg[0];
}

constexpr int L0_FIRST = 96, L0_PAGES = NPAGES - L0_FIRST;
constexpr float SKIP_THR = 1.4551915e-11f;
constexpr int CW_L0CNT = 8192;
constexpr int N_DEC_L0 = DSEQ * 8 * L0_PAGES, N_DEC_ITEMS = N_DEC_L0 + DSEQ * 8 * (L0_FIRST / 2);
template <bool SC1>
__device__ __forceinline__ bool decode_skip_old_pages(const float* FPARTp, int seq, int head, int lane) {
    const float* Fp = FPARTp + ((size_t)((seq * 8 + head) * NPAGES + L0_FIRST)) * DTOK;
    const int q = lane & 7, grp = lane >> 3;
    float f[4];
#pragma unroll
    for (int k = 0; k < 4; ++k) { const float* a = Fp + (grp * 4 + k) * DTOK + q;
        f[k] = SC1 ? __builtin_bit_cast(float, __hip_atomic_load((const unsigned*)a, __ATOMIC_RELAXED, __HIP_MEMORY_SCOPE_AGENT)) : *a; }
    float pr = (f[0] * f[1]) * (f[2] * f[3]);
    pr *= __shfl_xor(pr, 8); pr *= __shfl_xor(pr, 16); pr *= __shfl_xor(pr, 32);
    float m = pr; m = fmaxf(m, __shfl_xor(m, 1)); m = fmaxf(m, __shfl_xor(m, 2)); m = fmaxf(m, __shfl_xor(m, 4));
    return m < SKIP_THR;
}

__device__ __forceinline__ void decode_page(const int* ptab, const float* ck, const float* cv, const float* sbbias, unsigned char* ws, LAS unsigned char* wlds, int seq, int page, int head, int lane) {
    const int j16 = lane & 15, kg = lane >> 4;
    constexpr int VLD = 272;
    LAS unsigned char* K_lds = wlds; LAS unsigned char* V_lds = wlds + 8192; LAS unsigned char* Q_lds = wlds + 8192 + 8704;
    const bf16_t* PROJ = (const bf16_t*)(ws + WS_PROJ);
    const int phys = __builtin_amdgcn_readfirstlane(ptab[seq * NPAGES + page]);
    const float bias2 = sbbias[head] * LOG2E;
    f32x4 o[8];
#pragma unroll
    for (int d = 0; d < 8; ++d) o[d] = f32x4{0.f, 0.f, 0.f, 0.f};
    float R = 1.f;
    const int srow = lane >> 4, scol = (lane & 15) * 8;
    const int vtr = (int)(uintptr_t)V_lds + (4 * kg + (j16 >> 2)) * VLD + 8 * (j16 & 3);
#pragma unroll
    for (int i = 0; i < 2; ++i) { const int c = lane + 64 * i, qrw = c >> 4, qc = (c & 15) * 8;
        *(LAS bf16x8*)(Q_lds + KSWZ(qrw, qc * 2)) = *(const bf16x8*)(PROJ + (size_t)(MP + seq * DTOK + qrw) * NPAD + PC_Q + head * 128 + qc); }
    f32x4 sk[16], sv[16];
    const __amdgpu_buffer_rsrc_t rK = __builtin_amdgcn_make_buffer_rsrc((void*)(ck + (size_t)phys * (PAGE * 1024)), 0, PAGE * 1024 * 4, 0x00020000);
    const __amdgpu_buffer_rsrc_t rV = __builtin_amdgcn_make_buffer_rsrc((void*)(cv + (size_t)phys * (PAGE * 1024)), 0, PAGE * 1024 * 4, 0x00020000);
    const int voff = (srow * 1024 + head * 128 + scol) * 4;
#define DLOAD(dst, rs, kb) do { _Pragma("unroll") for (int i = 0; i < 8; ++i) { const int so_ = ((kb) * 32 + 4 * i) * 4096; \
        dst[2 * i] = __builtin_bit_cast(f32x4, __builtin_amdgcn_raw_buffer_load_b128(rs, voff, so_, 2)); dst[2 * i + 1] = __builtin_bit_cast(f32x4, __builtin_amdgcn_raw_buffer_load_b128(rs, voff + 16, so_, 2)); } } while (0)
    DLOAD(sk, rK, 3); DLOAD(sv, rV, 3);
#pragma unroll 1
    for (int kb = 3; kb >= 0; --kb) {
#pragma unroll
        for (int i = 0; i < 8; ++i) { u32x4 w; w.x = cvtpk(sk[2 * i].x, sk[2 * i].y); w.y = cvtpk(sk[2 * i].z, sk[2 * i].w); w.z = cvtpk(sk[2 * i + 1].x, sk[2 * i + 1].y); w.w = cvtpk(sk[2 * i + 1].z, sk[2 * i + 1].w);
            *(LAS u32x4*)(K_lds + KSWZ(srow + 4 * i, scol * 2)) = w; }
        if (kb > 0) DLOAD(sk, rK, kb - 1);
        f32x4 st[2];
        st[0] = f32x4{bias2, bias2, bias2, bias2}; st[1] = st[0];
#pragma unroll
        for (int ks = 0; ks < 4; ++ks) { const int cb = (32 * ks + 8 * kg) * 2;
            const bf16x8 qf = *(const LAS bf16x8*)(Q_lds + KSWZ(j16 & 7, cb));
            const bf16x8 k0 = *(const LAS bf16x8*)(K_lds + KSWZ(j16, cb)), k1 = *(const LAS bf16x8*)(K_lds + KSWZ(16 + j16, cb));
            st[0] = __builtin_amdgcn_mfma_f32_16x16x32_bf16(k0, qf, st[0], 0, 0, 0);
            st[1] = __builtin_amdgcn_mfma_f32_16x16x32_bf16(k1, qf, st[1], 0, 0, 0); }
        sb_transform16(st, R, lane, kg);
        u32x4 af; af.x = cvtpk(st[0][0], st[0][1]); af.y = cvtpk(st[0][2], st[0][3]); af.z = cvtpk(st[1][0], st[1][1]); af.w = cvtpk(st[1][2], st[1][3]);
        const bf16x8 pfrag = __builtin_bit_cast(bf16x8, af);
#pragma unroll
        for (int i = 0; i < 8; ++i) { u32x4 w; w.x = cvtpk(sv[2 * i].x, sv[2 * i].y); w.y = cvtpk(sv[2 * i].z, sv[2 * i].w); w.z = cvtpk(sv[2 * i + 1].x, sv[2 * i + 1].y); w.w = cvtpk(sv[2 * i + 1].z, sv[2 * i + 1].w);
            *(LAS u32x4*)(V_lds + (srow + 4 * i) * VLD + scol * 2) = w; }
        if (kb > 0) DLOAD(sv, rV, kb - 1);
        SBAR();
#define DPV4(D0) do { const s16x4 l0_ = tr_read<(D0) * 32>(vtr), h0_ = tr_read<(D0) * 32 + 16 * VLD>(vtr), l1_ = tr_read<(D0 + 1) * 32>(vtr), h1_ = tr_read<(D0 + 1) * 32 + 16 * VLD>(vtr); \
        const s16x4 l2_ = tr_read<(D0 + 2) * 32>(vtr), h2_ = tr_read<(D0 + 2) * 32 + 16 * VLD>(vtr), l3_ = tr_read<(D0 + 3) * 32>(vtr), h3_ = tr_read<(D0 + 3) * 32 + 16 * VLD>(vtr); \
        asm volatile("s_waitcnt lgkmcnt(0)" ::: "memory"); SBAR(); \
        o[D0] = __builtin_amdgcn_mfma_f32_16x16x32_bf16(pfrag, PKV(l0_, h0_), o[D0], 0, 0, 0); o[D0 + 1] = __builtin_amdgcn_mfma_f32_16x16x32_bf16(pfrag, PKV(l1_, h1_), o[D0 + 1], 0, 0, 0); \
        o[D0 + 2] = __builtin_amdgcn_mfma_f32_16x16x32_bf16(pfrag, PKV(l2_, h2_), o[D0 + 2], 0, 0, 0); o[D0 + 3] = __builtin_amdgcn_mfma_f32_16x16x32_bf16(pfrag, PKV(l3_, h3_), o[D0 + 3], 0, 0, 0); } while (0)
        DPV4(0); DPV4(4);
#undef DPV4
    }
#undef DLOAD
    if (kg < 2) {
        float* Op = (float*)(ws + WS_OPART) + ((size_t)((seq * 8 + head) * NPAGES + page)) * (DTOK * 128);
#pragma unroll
        for (int db = 0; db < 8; ++db)
#pragma unroll
            for (int r = 0; r < 4; ++r) Op[(4 * kg + r) * 128 + 16 * db + j16] = o[db][r];
    }
    if (lane < 8) __hip_atomic_store((unsigned*)(ws + WS_FPART) + ((size_t)((seq * 8 + head) * NPAGES + page)) * DTOK + lane, __builtin_bit_cast(unsigned, R), __ATOMIC_RELAXED, __HIP_MEMORY_SCOPE_AGENT);
}
__device__ __forceinline__ void decode_wave_loop(const int* ptab, const float* ck, const float* cv, const float* sbbias, unsigned char* ws, LAS unsigned char* wlds, unsigned* qhead, int lane) {
    int ckey = -1; bool cskip = false;
    unsigned* l0cnt = (unsigned*)(ws + WS_CTL) + CW_L0CNT;
    for (;;) {
        unsigned it = 0; if (lane == 0) it = __hip_atomic_fetch_add(qhead, 1u, __ATOMIC_RELAXED, __HIP_MEMORY_SCOPE_AGENT);
        it = __builtin_amdgcn_readfirstlane(it);
        if (it >= (unsigned)N_DEC_ITEMS) break;
        int seq, head, page0, npages;
        if (it < (unsigned)N_DEC_L0) { head = it & 7; page0 = L0_FIRST + ((it >> 3) & 31); seq = it >> 8; npages = 1; }
        else {
            const int j = (int)it - N_DEC_L0, rem = j % (DSEQ * (L0_FIRST / 2));
            head = 7 - j / (DSEQ * (L0_FIRST / 2)); seq = rem / (L0_FIRST / 2); page0 = 2 * (rem % (L0_FIRST / 2)); npages = 2;
            const int key = seq * 8 + head;
            if (key != ckey) {
                unsigned ok = 1u, sp = 0u;
                while (__builtin_amdgcn_readfirstlane(__hip_atomic_load(l0cnt + 64 * key, __ATOMIC_RELAXED, __HIP_MEMORY_SCOPE_AGENT)) < (unsigned)L0_PAGES) { __builtin_amdgcn_s_sleep(8); if (++sp > (1u << 20)) { ok = 0u; break; } }
                cskip = ok ? decode_skip_old_pages<true>((const float*)(ws + WS_FPART), seq, head, lane) : false; ckey = key;
            }
            if (cskip) continue;
        }
#pragma unroll 1
        for (int pg = 0; pg < npages; ++pg) decode_page(ptab, ck, cv, sbbias, ws, wlds, seq, page0 + pg, head, lane);
        if (npages == 1) {
            asm volatile("s_waitcnt vmcnt(0)" ::: "memory");
            if (lane == 0) __hip_atomic_fetch_add(l0cnt + 64 * (seq * 8 + head), 1u, __ATOMIC_RELAXED, __HIP_MEMORY_SCOPE_AGENT);
        }
    }
}

constexpr int SS_LD = 272;
__device__ __forceinline__ void scan128(float& v0, float& v1, int lane) {
#pragma unroll
    for (int o = 1; o < 64; o <<= 1) { const float t0 = __shfl_up(v0, o), t1 = __shfl_up(v1, o); if (lane >= o) { v0 += t0; v1 += t1; } }
    v1 += __shfl(v0, 63);
}
template <bool SAMPLE>
__device__ __forceinline__ void conv_load(const bf16_t* PROJ, const float* sconv0, int rowbase, int bs, bool first_chunk, int l0, int ch0, u32x4 (&rw)[7]) {
#pragma unroll
    for (int r = 0; r < 7; ++r) { const int l = l0 - 3 + r;
        if (l >= 0 || !first_chunk) rw[r] = *(const u32x4*)(PROJ + (size_t)(rowbase + l) * NPAD + PC_XBC + ch0);
        else if (SAMPLE) { const f32x4* sp = (const f32x4*)(sconv0 + ((size_t)bs * 3 + (3 + l)) * 1024 + ch0); const f32x4 u0 = sp[0], u1 = sp[1];
            rw[r].x = cvtpk(u0.x, u0.y); rw[r].y = cvtpk(u0.z, u0.w); rw[r].z = cvtpk(u1.x, u1.y); rw[r].w = cvtpk(u1.z, u1.w); }
        else rw[r] = u32x4{0u, 0u, 0u, 0u}; }
}
__device__ __forceinline__ void conv_apply(const float* convw, const float* convb, int ch0, const u32x4 (&rw)[7], float (&ov)[4][8]) {
    float cw[4][8], cbv[8];
#pragma unroll
    for (int jj = 0; jj < 4; ++jj) { const f32x4* sp = (const f32x4*)(convw + jj * 1024 + ch0); const f32x4 u0 = sp[0], u1 = sp[1];
        cw[jj][0] = u0.x; cw[jj][1] = u0.y; cw[jj][2] = u0.z; cw[jj][3] = u0.w; cw[jj][4] = u1.x; cw[jj][5] = u1.y; cw[jj][6] = u1.z; cw[jj][7] = u1.w; }
    { const f32x4* sp = (const f32x4*)(convb + ch0); const f32x4 u0 = sp[0], u1 = sp[1];
        cbv[0] = u0.x; cbv[1] = u0.y; cbv[2] = u0.z; cbv[3] = u0.w; cbv[4] = u1.x; cbv[5] = u1.y; cbv[6] = u1.z; cbv[7] = u1.w; }
#pragma unroll
    for (int r = 0; r < 4; ++r)
#pragma unroll
        for (int k = 0; k < 8; ++k) { float t = cbv[k];
#pragma unroll
            for (int jj = 0; jj < 4; ++jj) { const unsigned w = rw[r + jj][k >> 1]; t = fmaf((k & 1) ? bf_hi(w) : bf_lo(w), cw[jj][k], t); }
            ov[r][k] = silu_f(t); }
}
constexpr int ST_BT = 0, ST_XTW = 34816, ST_F = 104448;
template <bool SAMPLE>
__device__ __forceinline__ void ssd_state_unit(unsigned char* ws, const float* alog, const float* sconv0, const float* convw, const float* convb, LAS unsigned char* lds, int bs, int c, int g) {
    int tid = threadIdx.x; asm volatile("" : "+v"(tid));
    const int wid = __builtin_amdgcn_readfirstlane(tid >> 6), lane = tid & 63, j16 = lane & 15, ig = lane >> 4;
    const int rowbase = SAMPLE ? MP + bs * DTOK : bs * SEQ + c * 128;
    constexpr int NTOK = SAMPLE ? DTOK : 128;
    const bf16_t* PROJ = (const bf16_t*)(ws + WS_PROJ);
    const bool first_chunk = SAMPLE || c == 0;
    const float* DTS = (const float*)(ws + WS_DT);
    LAS float* xwf = (LAS float*)(lds + ST_F);
    const int sidx0 = SAMPLE ? 512 + bs * 8 + 4 * g : (bs * 8 + 4 * g) * 16 + c;
    __syncthreads();
    if (wid < 4) {
        const int h = 4 * g + wid; const float a_h = -__expf(alog[h]);
        float d0 = (lane < NTOK) ? DTS[(size_t)(rowbase + lane) * 8 + h] : 0.f, d1 = (lane + 64 < NTOK) ? DTS[(size_t)(rowbase + lane + 64) * 8 + h] : 0.f;
        float c0 = d0 * a_h, c1 = d1 * a_h;
        scan128(c0, c1, lane);
        const float cs_end = __shfl(c1, 63);
        xwf[wid * 128 + lane] = d0 * __expf(cs_end - c0); xwf[wid * 128 + 64 + lane] = d1 * __expf(cs_end - c1);
        if (lane == 0) ((float*)(ws + WS_SUMDT))[sidx0 + (SAMPLE ? wid : 16 * wid)] = cs_end;
    }
    __syncthreads();
    {
        const int ccb = tid & 15, lb = 4 * (tid >> 4);
        const int hx0 = tid >> 8, cx0 = tid & 7, lx0 = 4 * ((tid & 255) >> 3);
        bf16_t* XA = (bf16_t*)(ws + WS_XA);
        u32x4 rb[7], rc[7], rx0[7], rx1[7];
        conv_load<SAMPLE>(PROJ, sconv0, rowbase, bs, first_chunk, lb, 512 + g * 128 + 8 * ccb, rb);
        conv_load<SAMPLE>(PROJ, sconv0, rowbase, bs, first_chunk, lb, 768 + g * 128 + 8 * ccb, rc);
        conv_load<SAMPLE>(PROJ, sconv0, rowbase, bs, first_chunk, lx0, (4 * g + hx0) * 64 + 8 * cx0, rx0);
        conv_load<SAMPLE>(PROJ, sconv0, rowbase, bs, first_chunk, lx0, (4 * g + hx0 + 2) * 64 + 8 * cx0, rx1);
        float ov[4][8];
        conv_apply(convw, convb, 512 + g * 128 + 8 * ccb, rb, ov);
#pragma unroll
        for (int k = 0; k < 8; ++k) { u32x2 o; o.x = cvtpk(ov[0][k], ov[1][k]); o.y = cvtpk(ov[2][k], ov[3][k]);
            *(LAS u32x2*)(lds + ST_BT + (8 * ccb + k) * SS_LD + lb * 2) = o; }
#pragma unroll
        for (int r = 0; r < 4; ++r) { u32x4 w; w.x = cvtpk(ov[r][0], ov[r][1]); w.y = cvtpk(ov[r][2], ov[r][3]); w.z = cvtpk(ov[r][4], ov[r][5]); w.w = cvtpk(ov[r][6], ov[r][7]);
            if (!SAMPLE || lb + r < NTOK) *(u32x4*)(XA + (size_t)(rowbase + lb + r) * 1024 + 512 + g * 128 + 8 * ccb) = w; }
        conv_apply(convw, convb, 768 + g * 128 + 8 * ccb, rc, ov);
#pragma unroll
        for (int r = 0; r < 4; ++r) { u32x4 w; w.x = cvtpk(ov[r][0], ov[r][1]); w.y = cvtpk(ov[r][2], ov[r][3]); w.z = cvtpk(ov[r][4], ov[r][5]); w.w = cvtpk(ov[r][6], ov[r][7]);
            if (!SAMPLE || lb + r < NTOK) *(u32x4*)(XA + (size_t)(rowbase + lb + r) * 1024 + 768 + g * 128 + 8 * ccb) = w; }
#pragma unroll
        for (int i = 0; i < 2; ++i) { const int hh = hx0 + 2 * i;
            float xw[4];
#pragma unroll
            for (int r = 0; r < 4; ++r) xw[r] = xwf[hh * 128 + lx0 + r];
            conv_apply(convw, convb, (4 * g + hh) * 64 + 8 * cx0, i ? rx1 : rx0, ov);
#pragma unroll
            for (int r = 0; r < 4; ++r) { u32x4 w; w.x = cvtpk(ov[r][0], ov[r][1]); w.y = cvtpk(ov[r][2], ov[r][3]); w.z = cvtpk(ov[r][4], ov[r][5]); w.w = cvtpk(ov[r][6], ov[r][7]);
                if (!SAMPLE || lx0 + r < NTOK) *(u32x4*)(XA + (size_t)(rowbase + lx0 + r) * 1024 + (4 * g + hh) * 64 + 8 * cx0) = w; }
#pragma unroll
            for (int k = 0; k < 8; ++k) { u32x2 o; o.x = cvtpk(ov[0][k] * xw[0], ov[1][k] * xw[1]); o.y = cvtpk(ov[2][k] * xw[2], ov[3][k] * xw[3]);
                *(LAS u32x2*)(lds + ST_XTW + (hh * 64 + 8 * cx0 + k) * SS_LD + lx0 * 2) = o; } }
    }
    __syncthreads();
    f32x4 acc[16];
#pragma unroll
    for (int q = 0; q < 16; ++q) acc[q] = f32x4{0.f, 0.f, 0.f, 0.f};
#pragma unroll
    for (int ks = 0; ks < 4; ++ks) {
        const bf16x8 bf = *(const LAS bf16x8*)(lds + ST_BT + (16 * wid + j16) * SS_LD + (32 * ks + 8 * ig) * 2);
#pragma unroll
        for (int q = 0; q < 16; ++q) { const bf16x8 af = *(const LAS bf16x8*)(lds + ST_XTW + (16 * q + j16) * SS_LD + (32 * ks + 8 * ig) * 2);
            acc[q] = __builtin_amdgcn_mfma_f32_16x16x32_bf16(bf, af, acc[q], 0, 0, 0); } }
    float* SL = (float*)(ws + WS_SLOC);
#pragma unroll
    for (int q = 0; q < 16; ++q) { const int hh = q >> 2; const size_t sidx = (size_t)sidx0 + (SAMPLE ? hh : 16 * hh);
        *(f32x4*)(SL + (sidx * 64 + (16 * (q & 3) + j16)) * 128 + 16 * wid + 4 * ig) = acc[q]; }
}

constexpr int SO_CM = 0, SO_BM = 34816, SO_XT = 69632, SO_HB = 87040, SO_XS = 104448, SO_XS_LD = 144, SO_F = 122880;
template <bool SAMPLE>
__device__ __forceinline__ void ssd_out_unit(unsigned char* ws, float* outp, const float* alog, const float* dskip, const float* ssdnw, const float* ssm0, const float* sconv0, const float* convw, const float* convb,
                                         LAS unsigned char* lds, int bs, int c, int h) {
    int tid = threadIdx.x; asm volatile("" : "+v"(tid));
    const int wid = __builtin_amdgcn_readfirstlane(tid >> 6), lane = tid & 63, j16 = lane & 15, ig = lane >> 4;
    const int g = h >> 2;
    const int rowbase = SAMPLE ? MP + bs * DTOK : bs * SEQ + c * 128;
    constexpr int NTOK = SAMPLE ? DTOK : 128;
    const float a_h = -__expf(alog[h]), D_h = dskip[h];
    const bf16_t* PROJ = (const bf16_t*)(ws + WS_PROJ);
    const bool first_chunk = SAMPLE || c == 0;
    const float* DTS = (const float*)(ws + WS_DT); const float* SL = (const float*)(ws + WS_SLOC); const float* SUMDT = (const float*)(ws + WS_SUMDT);
    LAS float* csf = (LAS float*)(lds + SO_F); LAS float* dtf = csf + 128; LAS float* facf = csf + 256;
    const int sidx = SAMPLE ? 512 + bs * 8 + h : (bs * 8 + h) * 16 + c;
    __syncthreads();
    if (wid == 0) {
        float d0 = (lane < NTOK) ? DTS[(size_t)(rowbase + lane) * 8 + h] : 0.f, d1 = (lane + 64 < NTOK) ? DTS[(size_t)(rowbase + lane + 64) * 8 + h] : 0.f;
        float c0 = d0 * a_h, c1 = d1 * a_h;
        scan128(c0, c1, lane);
        csf[lane] = c0; csf[lane + 64] = c1; dtf[lane] = d0; dtf[lane + 64] = d1;
    } else if (wid == 1 && !SAMPLE) {
        if (lane < 16) { float sacc = 0.f; for (int q = lane + 1; q < c; ++q) sacc += SUMDT[(bs * 8 + h) * 16 + q]; facf[lane] = __expf(sacc); }
    }
    __syncthreads();
    const float cs_end = csf[127];
    {
        f32x4 hp[4];
#pragma unroll
        for (int pb = 0; pb < 4; ++pb) hp[pb] = f32x4{0.f, 0.f, 0.f, 0.f};
        if (SAMPLE) {
#pragma unroll
            for (int pb = 0; pb < 4; ++pb) hp[pb] = *(const f32x4*)(ssm0 + ((size_t)(bs * 8 + h) * 64 + 16 * pb + j16) * 128 + 16 * wid + 4 * ig);
        } else {
            const float* sp0 = SL + ((size_t)(sidx - c) * 64 + j16) * 128 + 16 * wid + 4 * ig;
#pragma unroll
            for (int q0 = 0; q0 < SEQ / 128 - 1; q0 += 4) if (q0 < c) {
                f32x4 tq[4][4]; float fq4[4];
#pragma unroll
                for (int qq = 0; qq < 4; ++qq) { const bool on = q0 + qq < c; const int qe = on ? q0 + qq : 0; fq4[qq] = on ? facf[qe] : 0.f;
#pragma unroll
                    for (int pb = 0; pb < 4; ++pb) tq[qq][pb] = *(const f32x4*)(sp0 + ((size_t)qe * 64 + 16 * pb) * 128); }
#pragma unroll
                for (int qq = 0; qq < 4; ++qq)
#pragma unroll
                    for (int pb = 0; pb < 4; ++pb) hp[pb] = hp[pb] + fq4[qq] * tq[qq][pb];
            }
        }
#pragma unroll
        for (int pb = 0; pb < 4; ++pb) { u32x2 w; w.x = cvtpk(hp[pb].x, hp[pb].y); w.y = cvtpk(hp[pb].z, hp[pb].w);
            *(LAS u32x2*)(lds + SO_HB + (16 * pb + j16) * SS_LD + (16 * wid + 4 * ig) * 2) = w; }
        if (SAMPLE || c == SEQ / 128 - 1) {
            const float dec = __expf(cs_end); const float* sp = SL + ((size_t)sidx * 64 + j16) * 128 + 16 * wid + 4 * ig;
            float* So = outp + (SAMPLE ? O_SSSM : O_PSSM) + ((size_t)(bs * 8 + h) * 64 + j16) * 128 + 16 * wid + 4 * ig;
            f32x4 sl[4];
#pragma unroll
            for (int pb = 0; pb < 4; ++pb) sl[pb] = *(const f32x4*)(sp + (16 * pb) * 128);
#pragma unroll
            for (int pb = 0; pb < 4; ++pb) *(f32x4*)(So + (16 * pb) * 128) = hp[pb] * dec + sl[pb];
        }
    }
    {
        const bf16_t* XA = (const bf16_t*)(ws + WS_XA);
        const int cc = tid & 15, l0 = 4 * (tid >> 4), cx = tid & 7, lx = 4 * ((tid & 255) >> 3);
        u32x4 wc[4], wb[4], wx[4];
#pragma unroll
        for (int r = 0; r < 4; ++r) { const bool lv = !SAMPLE || (l0 + r) < NTOK;
            wc[r] = lv ? *(const u32x4*)(XA + (size_t)(rowbase + l0 + r) * 1024 + 768 + g * 128 + 8 * cc) : u32x4{0u, 0u, 0u, 0u};
            wb[r] = lv ? *(const u32x4*)(XA + (size_t)(rowbase + l0 + r) * 1024 + 512 + g * 128 + 8 * cc) : u32x4{0u, 0u, 0u, 0u}; }
        if (tid < 256) {
#pragma unroll
            for (int r = 0; r < 4; ++r) wx[r] = (!SAMPLE || (lx + r) < NTOK) ? *(const u32x4*)(XA + (size_t)(rowbase + lx + r) * 1024 + h * 64 + 8 * cx) : u32x4{0u, 0u, 0u, 0u}; }
#pragma unroll
        for (int r = 0; r < 4; ++r) { *(LAS u32x4*)(lds + SO_CM + (l0 + r) * SS_LD + cc * 16) = wc[r]; *(LAS u32x4*)(lds + SO_BM + (l0 + r) * SS_LD + cc * 16) = wb[r]; }
        if (tid < 256) {
            float dl[4];
#pragma unroll
            for (int r = 0; r < 4; ++r) { dl[r] = dtf[lx + r]; *(LAS u32x4*)(lds + SO_XS + (lx + r) * SO_XS_LD + cx * 16) = wx[r]; }
#pragma unroll
            for (int k = 0; k < 8; ++k) { const int d = k >> 1; float v[4];
#pragma unroll
                for (int r = 0; r < 4; ++r) v[r] = ((k & 1) ? bf_hi(wx[r][d]) : bf_lo(wx[r][d])) * dl[r];
                u32x2 o; o.x = cvtpk(v[0], v[1]); o.y = cvtpk(v[2], v[3]);
                *(LAS u32x2*)(lds + SO_XT + (8 * cx + k) * SS_LD + lx * 2) = o; }
        }
    }
    __syncthreads();
    f32x4 cb[8];
#pragma unroll
    for (int sb = 0; sb < 8; ++sb) cb[sb] = f32x4{0.f, 0.f, 0.f, 0.f};
#pragma unroll
    for (int ks = 0; ks < 4; ++ks) {
        const bf16x8 cf = *(const LAS bf16x8*)(lds + SO_CM + (16 * wid + j16) * SS_LD + (32 * ks + 8 * ig) * 2);
#pragma unroll
        for (int sb = 0; sb < 8; ++sb) { const bf16x8 bf = *(const LAS bf16x8*)(lds + SO_BM + (16 * sb + j16) * SS_LD + (32 * ks + 8 * ig) * 2);
            cb[sb] = __builtin_amdgcn_mfma_f32_16x16x32_bf16(bf, cf, cb[sb], 0, 0, 0); } }
    __syncthreads();
    const int l = 16 * wid + j16;
    {
        const float csl = csf[l];
#pragma unroll
        for (int sb = 0; sb < 8; ++sb) { const int s0 = 16 * sb + 4 * ig; const f32x4 css = *(const LAS f32x4*)(csf + s0); float gv[4];
#pragma unroll
            for (int r = 0; r < 4; ++r) gv[r] = (s0 + r <= l) ? cb[sb][r] * __expf(csl - css[r]) : 0.f;
            u32x2 w; w.x = cvtpk(gv[0], gv[1]); w.y = cvtpk(gv[2], gv[3]);
            *(LAS u32x2*)(lds + SO_BM + l * SS_LD + s0 * 2) = w; }
    }
    f32x4 yd[4], yo[4];
#pragma unroll
    for (int pb = 0; pb < 4; ++pb) { yd[pb] = f32x4{0.f, 0.f, 0.f, 0.f}; yo[pb] = f32x4{0.f, 0.f, 0.f, 0.f}; }
#pragma unroll
    for (int ks = 0; ks < 4; ++ks) {
        const bf16x8 gf = *(const LAS bf16x8*)(lds + SO_BM + (16 * wid + j16) * SS_LD + (32 * ks + 8 * ig) * 2);
        const bf16x8 cf = *(const LAS bf16x8*)(lds + SO_CM + (16 * wid + j16) * SS_LD + (32 * ks + 8 * ig) * 2);
#pragma unroll
        for (int pb = 0; pb < 4; ++pb) {
            const bf16x8 xf = *(const LAS bf16x8*)(lds + SO_XT + (16 * pb + j16) * SS_LD + (32 * ks + 8 * ig) * 2);
            const bf16x8 hf = *(const LAS bf16x8*)(lds + SO_HB + (16 * pb + j16) * SS_LD + (32 * ks + 8 * ig) * 2);
            yd[pb] = __builtin_amdgcn_mfma_f32_16x16x32_bf16(xf, gf, yd[pb], 0, 0, 0);
            yo[pb] = __builtin_amdgcn_mfma_f32_16x16x32_bf16(hf, cf, yo[pb], 0, 0, 0); } }
    {
        bf16_t* MIX = (bf16_t*)(ws + WS_MIX); float* SSQ = (float*)(ws + WS_SSQ);
        const float el = __expf(csf[l]); float sq = 0.f;
        const bool live = l < NTOK; const size_t grow = (size_t)(rowbase + l);
        if (live) {
            u32x2 zw[4];
#pragma unroll
            for (int pb = 0; pb < 4; ++pb) zw[pb] = *(const u32x2*)(PROJ + grow * NPAD + PC_Z + h * 64 + 16 * pb + 4 * ig);
#pragma unroll
            for (int pb = 0; pb < 4; ++pb) { const int p0 = 16 * pb + 4 * ig;
                const u32x2 xw = *(const LAS u32x2*)(lds + SO_XS + l * SO_XS_LD + p0 * 2); const f32x4 gw = *(const f32x4*)(ssdnw + h * 64 + p0);
                const float xv[4] = {bf_lo(xw.x), bf_hi(xw.x), bf_lo(xw.y), bf_hi(xw.y)}, zv[4] = {bf_lo(zw[pb].x), bf_hi(zw[pb].x), bf_lo(zw[pb].y), bf_hi(zw[pb].y)};
                float y[4];
#pragma unroll
                for (int r = 0; r < 4; ++r) { y[r] = (yd[pb][r] + el * yo[pb][r] + D_h * xv[r]) * silu_f(zv[r]); sq += y[r] * y[r]; }
                u32x2 w; w.x = cvtpk(y[0] * gw.x, y[1] * gw.y); w.y = cvtpk(y[2] * gw.z, y[3] * gw.w);
                *(u32x2*)(MIX + grow * 2048 + h * 64 + p0) = w; }
        }
        sq += __shfl_xor(sq, 16); sq += __shfl_xor(sq, 32);
        if (live && ig == 0) SSQ[grow * 8 + h] = sq;
    }
}

constexpr int U_SSDP = NBATCH * 16 * 2, U_SSDSS = DSEQ * 2, U_SB = NBATCH * 8 * 16, U_MEMP = NBATCH * 16 * 4, U_MEMS = DSEQ * 4;
#ifndef PROBE_BLK
#define PROBE_BLK 0
#endif
#define PSTAMP(i) do { if (PROBE_SEG >= 20 && blockIdx.x == PROBE_BLK && threadIdx.x == 0) ((volatile LAS unsigned long long*)(ctlw + 32))[8 + (i)] = __builtin_amdgcn_s_memrealtime(); } while (0)
#define QUEUE_LOOP(qi, total, ...) for (;;) { __syncthreads(); if (threadIdx.x == 0) ctlw[16] = __hip_atomic_fetch_add(qbase + 64 * (qi), 1u, __ATOMIC_RELAXED, __HIP_MEMORY_SCOPE_AGENT); \
        __syncthreads(); const int u = (int)ctlw[16]; if (u >= (total)) break; __VA_ARGS__ }
#define GROUP_LOOP(qi, total, ...) for (int gi_ = 0;; ++gi_) { if (threadIdx.x == 0) ctlw[22 + (gi_ & 1)] = __hip_atomic_fetch_add(qbase + 64 * (qi), 1u, __ATOMIC_RELAXED, __HIP_MEMORY_SCOPE_AGENT); \
        group_bar(gb, lane); const int u = (int)ctlw[22 + (gi_ & 1)]; if (u >= (total)) break; __VA_ARGS__ }
template <int MASK> __device__ __forceinline__ void phase3(const Params& p, LAS unsigned char* lds, volatile LAS unsigned* ctlw, int qset) {
    unsigned* qbase = (unsigned*)(p.ws + WS_CTL) + CW_QUEUE + 1024 * qset;
    const bf16_t* PROJ = (const bf16_t*)(p.ws + WS_PROJ);
    bf16_t* MIX = (bf16_t*)(p.ws + WS_MIX);
    PSTAMP(4);
    QUEUE_LOOP(0, U_SSDP, { ssd_state_unit<false>(p.ws, p.in[I_ALOG], p.in[I_SCONV], p.in[I_CONVW], p.in[I_CONVB], lds, u >> 5, (u >> 1) & 15, u & 1); })
    QUEUE_LOOP(4, U_SSDSS, { ssd_state_unit<true>(p.ws, p.in[I_ALOG], p.in[I_SCONV], p.in[I_CONVW], p.in[I_CONVB], lds, u >> 1, 0, u & 1);
        for (int hh = 0; hh < 4; ++hh)
            ssd_out_unit<true>(p.ws, p.out, p.in[I_ALOG], p.in[I_DSKIP], p.in[I_SSDNW], p.in[I_SSM], p.in[I_SCONV], p.in[I_CONVW], p.in[I_CONVB], lds, u >> 1, 0, (u & 1) * 4 + hh); })
    PSTAMP(5);
    const unsigned gb0 = __builtin_amdgcn_readfirstlane(ctlw[20]);
    __syncthreads();
    {
        int tid = threadIdx.x; asm volatile("" : "+v"(tid));
        const int wid = __builtin_amdgcn_readfirstlane(tid >> 6), lane = tid & 63;
        if (wid < 4) {
            GroupBar gb; gb.cnt = ctlw + 20; gb.gen = gb0;
            __builtin_amdgcn_s_setprio(1);
            GROUP_LOOP(2, U_SB, {
                const int i = 15 - (u >> 5), bh = u & 31, b = bh >> 3, h = bh & 7;
                attn_unit<0>(lds, gb, PROJ + (size_t)(b * SEQ + i * 128) * NPAD + PC_Q + h * 128, NPAD,
                             PROJ + (size_t)(b * SEQ) * NPAD + PC_K + h * 128, PROJ + (size_t)(b * SEQ) * NPAD + PC_V + h * 128, NPAD,
                             2 * (i + 1), i * 128, 128, p.in[I_SBBIAS][h] * LOG2E,
                             PROJ + (size_t)(b * SEQ + i * 128) * NPAD + PC_GSB + h * 128, NPAD, MIX + (size_t)(b * SEQ + i * 128) * 2048 + 512 + h * 128, 2048); })
            PSTAMP(6);
            GROUP_LOOP(3, U_MEMP + U_MEMS, {
                if (u < U_MEMP) { const int hm = u & 3, qb = (u >> 2) & 15, b = u >> 6; const size_t r0 = (size_t)(b * SEQ + qb * 128);
                    attn_unit<1>(lds, gb, PROJ + r0 * NPAD + PC_MQ + hm * 128, NPAD, (const bf16_t*)(p.ws + WS_MKN) + (size_t)(b * MEMT) * 512 + hm * 128, (const bf16_t*)(p.ws + WS_MVB) + (size_t)(b * MEMT) * 512 + hm * 128, 512,
                                 4, 0, 128, 0.f, PROJ + r0 * NPAD + PC_GM + hm * 128, NPAD, MIX + r0 * 2048 + 1536 + hm * 128, 2048); }
                else { const int v = u - U_MEMP, hm = v & 3, sq = v >> 2; const size_t r0 = (size_t)(MP + sq * DTOK);
                    attn_unit<1>(lds, gb, PROJ + r0 * NPAD + PC_MQ + hm * 128, NPAD, (const bf16_t*)(p.ws + WS_CMK) + (size_t)(sq * MEMT) * 512 + hm * 128, (const bf16_t*)(p.ws + WS_CMV) + (size_t)(sq * MEMT) * 512 + hm * 128, 512,
                                 4, 0, DTOK, 0.f, PROJ + r0 * NPAD + PC_GM + hm * 128, NPAD, MIX + r0 * 2048 + 1536 + hm * 128, 2048); } })
            group_bar(gb, lane);
            __builtin_amdgcn_s_setprio(0);
            PSTAMP(7);
        }
        LAS unsigned char* wlds = lds + (wid < 4 ? wid * 19456 : 77824 + (wid - 4) * 19456);
        decode_wave_loop((const int*)p.in[I_PT], p.in[I_CK], p.in[I_CV], p.in[I_SBBIAS], p.ws, wlds, qbase + 64 * 1, lane);
    }
    __syncthreads();
    PSTAMP(8);
}

__device__ __forceinline__ void phase4(const Params& p, LAS unsigned char* lds, volatile LAS unsigned* ctlw, int vcu, int G, int qset) {
    const int tid = threadIdx.x, lane = tid & 63, wave = __builtin_amdgcn_readfirstlane(tid >> 6);
    bf16_t* MIX = (bf16_t*)(p.ws + WS_MIX);
    const bf16_t* PROJ = (const bf16_t*)(p.ws + WS_PROJ);
    unsigned* qbase = (unsigned*)(p.ws + WS_CTL) + CW_QUEUE + 1024 * qset;
    PSTAMP(2);
    for (int u = G - 1 - (int)blockIdx.x; u < DSEQ * 8; u += G) {
        const int seq = u >> 3, head = u & 7, i = wave;
        const int row = MP + seq * DTOK + i;
        const float bias2 = p.in[I_SBBIAS][head] * LOG2E;
        const unsigned qw = *(const unsigned*)(PROJ + (size_t)row * NPAD + PC_Q + head * 128 + 2 * lane);
        const unsigned gwd = *(const unsigned*)(PROJ + (size_t)row * NPAD + PC_GSB + head * 128 + 2 * lane);
        f32x2 kvs[DTOK], vvs[DTOK];
#pragma unroll
        for (int j = 0; j < DTOK; ++j) { kvs[j] = *(const f32x2*)(p.out + O_SK + (size_t)(seq * DTOK + j) * 1024 + head * 128 + 2 * lane);
            vvs[j] = *(const f32x2*)(p.out + O_SV + (size_t)(seq * DTOK + j) * 1024 + head * 128 + 2 * lane); }
        const float* Op = (const float*)(p.ws + WS_OPART) + (size_t)((seq * 8 + head) * NPAGES) * (DTOK * 128) + i * 128 + 2 * lane;
        const float* Fp = (const float*)(p.ws + WS_FPART) + (size_t)((seq * 8 + head) * NPAGES) * DTOK + i;
        f32x2 ov[32]; float fv[32];
#pragma unroll
        for (int q = 0; q < 32; ++q) { ov[q] = *(const f32x2*)(Op + (size_t)(NPAGES - 32 + q) * (DTOK * 128)); fv[q] = Fp[(size_t)(NPAGES - 32 + q) * DTOK]; }
        const int pg_lo = decode_skip_old_pages<false>((const float*)(p.ws + WS_FPART), seq, head, lane) ? L0_FIRST : 0;
        const float q0 = bf_lo(qw), q1 = bf_hi(qw);
        float acc0 = 0.f, acc1 = 0.f, R = 1.f;
#pragma unroll
        for (int j = DTOK - 1; j >= 0; --j) {
            const float kb0 = bf2f(f2bf(kvs[j].x)), kb1 = bf2f(f2bf(kvs[j].y));
            const float z = fmaxf(wave_sum(q0 * kb0 + q1 * kb1) + bias2, -100.f);
            if (j < i) {
                const float e = fast_exp2(-z), rc = fast_rcp(1.f + e);
                const float w = rc * R; acc0 += w * vvs[j].x; acc1 += w * vvs[j].y; R *= e * rc;
            }
        }
#pragma unroll
        for (int q = 31; q >= 0; --q) { acc0 += R * ov[q].x; acc1 += R * ov[q].y; R *= fv[q]; }
        for (int pg0 = NPAGES - 64; pg0 >= pg_lo; pg0 -= 32) {
#pragma unroll
            for (int q = 0; q < 32; ++q) { ov[q] = *(const f32x2*)(Op + (size_t)(pg0 + q) * (DTOK * 128)); fv[q] = Fp[(size_t)(pg0 + q) * DTOK]; }
#pragma unroll
            for (int q = 31; q >= 0; --q) { acc0 += R * ov[q].x; acc1 += R * ov[q].y; R *= fv[q]; }
        }
        *(unsigned*)(MIX + (size_t)row * 2048 + 512 + head * 128 + 2 * lane) = cvtpk(acc0 * silu_f(bf_lo(gwd)), acc1 * silu_f(bf_hi(gwd)));
    }
    PSTAMP(3);
    PSTAMP(0);
    QUEUE_LOOP(5, NBATCH * 16 * 8, { const int v = NBATCH * 16 * 8 - 1 - u;
        ssd_out_unit<false>(p.ws, p.out, p.in[I_ALOG], p.in[I_DSKIP], p.in[I_SSDNW], p.in[I_SSM], p.in[I_SCONV], p.in[I_CONVW], p.in[I_CONVB], lds, (v >> 3) & 3, v >> 5, v & 7); })
    PSTAMP(1);
}

struct Epi5 {
    static constexpr int MID = 8;
    const float* xp; float* out; const float* SSQ;
    __device__ __forceinline__ void mid(pg8::Acc& acc, const pg8::Unit& u, int wr, int fr) const {
        int rl0 = wr * 64 + fr; asm volatile("" : "+v"(rl0));
#pragma unroll
        for (int ai = 0; ai < 2; ++ai)
#pragma unroll
            for (int m = 0; m < 4; ++m) { const size_t row = (size_t)u.pm * 256 + rl0 + ai * 128 + m * 16;
                const f32x4 s0 = *(const f32x4*)(SSQ + row * 8), s1 = *(const f32x4*)(SSQ + row * 8 + 4);
                const float rs = 1.f / sqrtf((((s0.x + s0.y) + (s0.z + s0.w)) + ((s1.x + s1.y) + (s1.z + s1.w))) * (1.f / 512.f) + EPS);
#pragma unroll
                for (int bj = 0; bj < 2; ++bj)
#pragma unroll
                    for (int n = 0; n < 2; ++n) acc[ai][bj][m][n] = acc[ai][bj][m][n] * rs; }
    }
    __device__ __forceinline__ void operator()(pg8::Acc& acc, const pg8::Unit& u, int wr, int wc, int fr, int fq) const {
        int rl0 = wr * 64 + fr, cl0 = u.pn * 256 + wc * 32 + 4 * fq;
        asm volatile("" : "+v"(rl0), "+v"(cl0));
        const float* xb = xp + (size_t)u.pm * 256 * DM + cl0; float* ob = out + O_YP + (size_t)u.pm * 256 * DM + cl0;
        f32x4 xa[2][2][2], xc[2][2][2];
#define E5_LOAD(dst, b) do { _Pragma("unroll") for (int mm = 0; mm < 2; ++mm) { const float* xr = xb + (size_t)(rl0 + ((b) >> 1) * 128 + (((b) & 1) * 2 + mm) * 16) * DM; \
        _Pragma("unroll") for (int bj = 0; bj < 2; ++bj) _Pragma("unroll") for (int n = 0; n < 2; ++n) dst[mm][bj][n] = *(const f32x4*)(xr + bj * 128 + n * 16); } } while (0)
#define E5_STORE(src, b) do { _Pragma("unroll") for (int mm = 0; mm < 2; ++mm) { float* orow = ob + (size_t)(rl0 + ((b) >> 1) * 128 + (((b) & 1) * 2 + mm) * 16) * DM; \
        _Pragma("unroll") for (int bj = 0; bj < 2; ++bj) _Pragma("unroll") for (int n = 0; n < 2; ++n) *(f32x4*)(orow + bj * 128 + n * 16) = src[mm][bj][n] + acc[(b) >> 1][bj][((b) & 1) * 2 + mm][n]; } } while (0)
        E5_LOAD(xa, 0); E5_LOAD(xc, 1);
        E5_STORE(xa, 0); E5_LOAD(xa, 2);
        E5_STORE(xc, 1); E5_LOAD(xc, 3);
        E5_STORE(xa, 2); E5_STORE(xc, 3);
#undef E5_LOAD
#undef E5_STORE
    }
};
__device__ __forceinline__ void sample_outproj(const Params& p, LAS unsigned char* lds, int c) {
    int tid = threadIdx.x; asm volatile("" : "+v"(tid));
    const int wid = __builtin_amdgcn_readfirstlane(tid >> 6), lane = tid & 63, j16 = lane & 15, ig = lane >> 4;
    const bf16_t* MIX = (const bf16_t*)(p.ws + WS_MIX) + (size_t)MP * 2048; const bf16_t* WT = (const bf16_t*)(p.ws + WS_WOUT) + (size_t)(16 * c) * 2048;
    const float* SSQ = (const float*)(p.ws + WS_SSQ) + (size_t)MP * 8;
    f32x4 acc[4];
#pragma unroll
    for (int rb = 0; rb < 4; ++rb) acc[rb] = f32x4{0.f, 0.f, 0.f, 0.f};
    float xin[2];
#pragma unroll
    for (int i = 0; i < 2; ++i) { const int e = tid + 512 * i; xin[i] = p.in[I_XS][(size_t)(e >> 4) * DM + 16 * c + (e & 15)]; }
    LAS float* rsl = (LAS float*)(lds + 32768);
    f32x4 sq0 = f32x4{0.f, 0.f, 0.f, 0.f}, sq1 = sq0;
    if (tid < 64) { sq0 = *(const f32x4*)(SSQ + tid * 8); sq1 = *(const f32x4*)(SSQ + tid * 8 + 4); }
    bf16x8 bfr[8], afr[8][4];
#pragma unroll
    for (int ks = 0; ks < 8; ++ks) { const int k = 256 * wid + 32 * ks + 8 * ig;
        bfr[ks] = *(const bf16x8*)(WT + (size_t)j16 * 2048 + k);
#pragma unroll
        for (int rb = 0; rb < 4; ++rb) afr[ks][rb] = *(const bf16x8*)(MIX + (size_t)(16 * rb + j16) * 2048 + k); }
#pragma unroll
    for (int ks = 0; ks < 8; ++ks)
#pragma unroll
        for (int rb = 0; rb < 4; ++rb) acc[rb] = __builtin_amdgcn_mfma_f32_16x16x32_bf16(afr[ks][rb], bfr[ks], acc[rb], 0, 0, 0);
    if (tid < 64) rsl[tid] = 1.f / sqrtf((((sq0.x + sq0.y) + (sq0.z + sq0.w)) + ((sq1.x + sq1.y) + (sq1.z + sq1.w))) * (1.f / 512.f) + EPS);
    __syncthreads();
    if (wid < 2) {
#pragma unroll
        for (int rb = 0; rb < 4; ++rb)
#pragma unroll
            for (int r = 0; r < 4; ++r) acc[rb][r] *= rsl[16 * rb + 4 * ig + r];
    }
    LAS float* red = (LAS float*)lds;
#pragma unroll
    for (int rb = 0; rb < 4; ++rb)
#pragma unroll
        for (int r = 0; r < 4; ++r) red[(wid * 64 + 16 * rb + 4 * ig + r) * 16 + j16] = acc[rb][r];
    __syncthreads();
#pragma unroll
    for (int i = 0; i < 2; ++i) { const int e = tid + 512 * i, row = e >> 4, col = e & 15; float v = 0.f;
#pragma unroll
        for (int w = 0; w < 8; ++w) v += red[(w * 64 + row) * 16 + col];
        p.out[O_YS + (size_t)row * DM + 16 * c + col] = xin[i] + v; }
}

constexpr int NPHASE = 6;
__global__ void __launch_bounds__(512, 2) hymba_fwd(Params p) {
    extern __shared__ __attribute__((aligned(16))) unsigned char lds_raw[];
    LAS unsigned char* lds = (LAS unsigned char*)lds_raw;
    const int tid = threadIdx.x;
    const int G = gridDim.x; const int bx = blockIdx.x; const int vcu = (G % 8 == 0) ? (bx % 8) * (G / 8) + bx / 8 : bx;
    volatile LAS unsigned* ctlw = (volatile LAS unsigned*)(lds + LDS_CTLW);
    if (tid < 128) ctlw[tid] = 0u;
    __syncthreads();
    unsigned* ctl = (unsigned*)(p.ws + WS_CTL);
    const int lo = p.ph_lo, hi = p.ph_hi;
    XcdBarrier bar; bar.bar = ctl + CW_BAR; bar.x = 0; bar.st = nullptr;
    if (hi - lo > 1) bar = xcd_barrier_post(ctl + CW_BAR, ctlw + 8);
    volatile LAS unsigned long long* tst = (volatile LAS unsigned long long*)(ctlw + 32); volatile LAS unsigned long long* tarr = tst + 32; int nst = 0, nbar = 0;
#define STAMP() do { if (PROBE_SEG >= 0 && bx == 0 && tid == 0) { tst[nst] = __builtin_amdgcn_s_memrealtime(); } ++nst; } while (0)
#define GBAR() do { if (PROBE_SEG >= 0) { if (tid == 0) __hip_atomic_fetch_max((unsigned long long*)(ctl + 14000) + 8 * nbar, (unsigned long long)__builtin_amdgcn_s_memrealtime(), __ATOMIC_RELAXED, __HIP_MEMORY_SCOPE_AGENT); } \
        xcd_barrier(bar); if (PROBE_SEG >= 0 && bx == 0 && tid == 0) tarr[nbar] = __hip_atomic_load((unsigned long long*)(ctl + 14000) + 8 * nbar, __ATOMIC_RELAXED, __HIP_MEMORY_SCOPE_AGENT); ++nbar; } while (0)
    STAMP();
#define IN(k) (lo <= (k) && (k) < hi)
#define BOTH(k) (IN(k) && IN((k) + 1))
    if (IN(0)) { phase0(p, lds, vcu, G, ctlw); if (BOTH(0)) GBAR(); STAMP(); }
    if (IN(1)) {
        pg8::Gemm g{(const bf16_t*)(p.ws + WS_H), (const bf16_t*)(p.ws + WS_WIN), (const bf16_t*)(p.ws + WS_HM), (const bf16_t*)(p.ws + WS_WM), DM};
        pg8::Order S; S.init(MROWS / 256, NPAD / 256, MMEM / 256, 1024 / 256, G, bx, 4);
        Epi1 E{(bf16_t*)(p.ws + WS_PROJ), (float*)(p.ws + WS_DT), p.out, p.in[I_DTBIAS], p.in[I_QNORM], p.in[I_KNORM], p.in[I_MQNORM], p.in[I_MKNORM], (bf16_t*)(p.ws + WS_MKN), (bf16_t*)(p.ws + WS_MVB), (LAS float*)(lds + RING_BYTES)};
        pg8::gemm_phase<Epi1>(lds, g, S, E);
        {
            const int nfull = (MROWS / 256) * (NPAD / 256) + (MMEM / 256) * (1024 / 256) - ((MROWS / 256) * (NPAD / 256) + (MMEM / 256) * (1024 / 256)) / G * G;
            const int first_idle = (nfull == 0) ? 0 : nfull, nidle = G - first_idle;
            if (bx >= first_idle) {
                const int lane = tid & 63, wave = __builtin_amdgcn_readfirstlane(tid >> 6);
                tr_pipeline(p, (LAS float*)(lds + wave * 16896), lane, (bx - first_idle) * 8 + wave, nidle * 8, NITEMS_P0, NITEMS_ALL);
                cache_mem_convert(p, (bx - first_idle) * 512 + tid, nidle * 512);
            }
        }
        if (BOTH(1)) GBAR(); STAMP();
    }
    if (IN(3)) { phase3<31>(p, lds, ctlw, 0); if (BOTH(3)) GBAR(); STAMP(); }
    if (IN(4)) { phase4(p, lds, ctlw, vcu, G, 0); if (BOTH(4)) GBAR(); STAMP(); }
    if (IN(5)) {
        pg8::Gemm g{(const bf16_t*)(p.ws + WS_MIX), (const bf16_t*)(p.ws + WS_WOUT), nullptr, nullptr, DM};
        pg8::Order S; S.init(MP / 256, DM / 256, 0, 1, G, bx);
        Epi5 E{p.in[I_XP], p.out, (const float*)(p.ws + WS_SSQ)};
        PSTAMP0(4);
        if (bx < 128) { sample_outproj(p, lds, bx); __syncthreads(); }
        PSTAMP0(5);
        pg8::gemm_phase<Epi5>(lds, g, S, E);
        PSTAMP0(6);
        STAMP();
    }
    if (PROBE_SEG >= 0 && bx == ((PROBE_SEG >= 20 && PROBE_SEG < 30) ? PROBE_BLK : 0) && tid == 0) {
        unsigned long long iv = 0;
        if (PROBE_SEG == 29) iv = tst[8 + 9] - tst[8 + 5];
        else if (PROBE_SEG == 28) iv = tst[8 + 6] - tst[8 + 9];
        else if (PROBE_SEG >= 40) iv = tst[20 + PROBE_SEG - 40 + 1] - tst[20 + PROBE_SEG - 40];
        else if (PROBE_SEG == 30) iv = tst[9] - tst[8];
        else if (PROBE_SEG >= 20) iv = tst[8 + PROBE_SEG - 20 + 1] - tst[8 + PROBE_SEG - 20];
        else if (PROBE_SEG < 10) iv = tst[PROBE_SEG + 1] - tst[PROBE_SEG];
        else iv = tst[PROBE_SEG - 10 + 1] - tarr[PROBE_SEG - 10];
        const unsigned long long t0 = __builtin_amdgcn_s_memrealtime();
        while (__builtin_amdgcn_s_memrealtime() - t0 < 8ull * iv) __builtin_amdgcn_s_sleep(8);
    }
#undef IN
#undef BOTH
}

extern "C" void kernel_launch(void* const* d_in, const int* in_sizes, int n_in, void* d_out, int out_size, void* d_ws, size_t ws_size, hipStream_t stream) {
    static int grid = 0;
    if (grid == 0) {
        if (n_in != 26 || ws_size < WS_END) { fprintf(stderr, "kernel_launch: unexpected n_in %d / ws %zu\n", n_in, ws_size); grid = -1; return; }
        int dev = 0, cus = 0, per_cu = 0;
        if (hipGetDevice(&dev) != hipSuccess || hipDeviceGetAttribute(&cus, hipDeviceAttributeMultiprocessorCount, dev) != hipSuccess) { grid = -1; return; }
        if (hipFuncSetAttribute((const void*)hymba_fwd, hipFuncAttributeMaxDynamicSharedMemorySize, LDS_BYTES) != hipSuccess) { fprintf(stderr, "kernel_launch: hipFuncSetAttribute failed\n"); grid = -1; return; }
        if (hipOccupancyMaxActiveBlocksPerMultiprocessor(&per_cu, (const void*)hymba_fwd, 512, LDS_BYTES) != hipSuccess || per_cu < 1) fprintf(stderr, "kernel_launch: occupancy query says %d\n", per_cu);
        (void)hipGetLastError();
        grid = cus;
    }
    if (grid < 0) return;
    (void)hipMemsetAsync((char*)d_ws + WS_CTL, 0, CTL_BYTES, stream);
    Params p{};
    for (int i = 0; i < 26; ++i) p.in[i] = (const float*)d_in[i];
    p.out = (float*)d_out; p.ws = (unsigned char*)d_ws;
    if (MK_N_LAUNCHES == 1) { p.ph_lo = 0; p.ph_hi = NPHASE; hipLaunchKernelGGL(hymba_fwd, dim3(grid), dim3(512), LDS_BYTES, stream, p); }
    else for (int ph = 0; ph < NPHASE; ++ph) { p.ph_lo = ph; p.ph_hi = ph + 1; hipLaunchKernelGGL(hymba_fwd, dim3(grid), dim3(512), LDS_BYTES, stream, p); }
    const hipError_t le = hipPeekAtLastError();
    if (le != hipSuccess) fprintf(stderr, "kernel_launch: launch failed: %s\n", hipGetErrorName(le));
}
```
